# Optimizing an MI355X kernel written in HIP

```python
import math
import jax, jax.numpy as jnp
from jax import lax
import numpy as np

D_MODEL = 1024
BATCH = 4
SEQ = 4096
DEPTH = 1

CONV_WIDTH = D_MODEL // 2
CONV_KERNEL = 31
SSM_WIDTH = D_MODEL // 2
SSM_GROUP = 16
SSM_GROUPS = SSM_WIDTH // SSM_GROUP
SSM_STATE = 64
FFN_HIDDEN = ((8 * D_MODEL + 3 * 256 - 1) // (3 * 256)) * 256
IN_COLS = 2 * CONV_WIDTH + SSM_WIDTH + 2 * D_MODEL
N_MOD = 6
EPS = 1e-6
DT_MIN = 1e-3
DT_MAX = 1e-1

kernel_name = "hybrid_conv_s5_gated_block"


def rmsnorm(x, g):
    x32 = x.astype(jnp.float32)
    y = x32 * lax.rsqrt(jnp.mean(x32 * x32, axis=-1, keepdims=True) + EPS)
    return (y * g.astype(jnp.float32)).astype(x.dtype)


def layernorm(x, g, b):
    x32 = x.astype(jnp.float32)
    mu = jnp.mean(x32, axis=-1, keepdims=True)
    var = jnp.mean(jnp.square(x32 - mu), axis=-1, keepdims=True)
    y = (x32 - mu) * lax.rsqrt(var + EPS)
    return (y * g.astype(jnp.float32) + b.astype(jnp.float32)).astype(x.dtype)


def conformer_conv(u_glu, conv_w, conv_b, ln_g, ln_b, w_proj):
    a, gate = jnp.split(u_glu, 2, axis=-1)
    u = a * jax.nn.sigmoid(gate)
    y = lax.conv_general_dilated(
        u, conv_w[:, None, :].astype(u.dtype), window_strides=(1,),
        padding=[(CONV_KERNEL - 1, 0)],
        dimension_numbers=("NWC", "WIO", "NWC"),
        feature_group_count=CONV_WIDTH) + conv_b
    y = jax.nn.silu(layernorm(y, ln_g, ln_b))
    return y @ w_proj


def _scan_combine(e1, e2):
    a1r, a1i, b1r, b1i = e1
    a2r, a2i, b2r, b2i = e2
    ar = a2r * a1r - a2i * a1i
    ai = a2r * a1i + a2i * a1r
    br = a2r * b1r - a2i * b1i + b2r
    bi = a2r * b1i + a2i * b1r + b2i
    return (ar, ai, br, bi)


def s5_mixer(u, a_re, a_im, b_re, b_im, c_re, c_im, d, log_dt, w_glu):
    bsz, seq, _ = u.shape
    f32 = jnp.float32
    u32 = u.astype(f32).reshape(bsz, seq, SSM_GROUPS, SSM_GROUP)
    ar, ai = a_re.astype(f32), a_im.astype(f32)
    dt = jnp.exp(log_dt.astype(f32))[:, None]
    mag = jnp.exp(dt * ar)
    e_re, e_im = mag * jnp.cos(dt * ai), mag * jnp.sin(dt * ai)
    n_re, n_im = e_re - 1.0, e_im
    den = ar * ar + ai * ai
    q_re = (n_re * ar + n_im * ai) / den
    q_im = (n_im * ar - n_re * ai) / den
    br32, bi32 = b_re.astype(f32), b_im.astype(f32)
    bb_re = q_re[..., None] * br32 - q_im[..., None] * bi32
    bb_im = q_re[..., None] * bi32 + q_im[..., None] * br32
    bu_re = jnp.einsum("bsgh,gph->bsgp", u32, bb_re)
    bu_im = jnp.einsum("bsgh,gph->bsgp", u32, bb_im)
    abar_re = jnp.broadcast_to(e_re, bu_re.shape)
    abar_im = jnp.broadcast_to(e_im, bu_re.shape)
    _, _, x_re, x_im = lax.associative_scan(
        _scan_combine, (abar_re, abar_im, bu_re, bu_im), axis=1)
    y = (jnp.einsum("bsgp,ghp->bsgh", x_re, c_re.astype(f32))
         - jnp.einsum("bsgp,ghp->bsgh", x_im, c_im.astype(f32)))
    y = y.reshape(bsz, seq, SSM_WIDTH) + d.astype(f32) * u.astype(f32)
    y = jax.nn.gelu(y).astype(u.dtype)
    za, zb = jnp.split(y @ w_glu, 2, axis=-1)
    return za * jax.nn.sigmoid(zb)


def setup_inputs(seed: int = 0) -> dict:
    key = jax.random.key(seed)
    ks = jax.random.split(key, 32)
    f32 = jnp.float32
    L, D, G, P, H = DEPTH, D_MODEL, SSM_GROUPS, SSM_STATE, SSM_GROUP

    def nrm(k, shape, fan_in):
        return jax.random.normal(k, shape, f32) * fan_in ** -0.5

    def gain(k, shape):
        return 1.0 + 0.05 * jax.random.normal(k, shape, f32)

    n_idx = jnp.arange(P, dtype=f32)
    a_re = -0.5 + 0.01 * jax.random.normal(ks[8], (L, G, P), f32)
    a_im = math.pi * n_idx[None, None, :] + 0.01 * jax.random.normal(ks[9], (L, G, P), f32)
    log_dt = jax.random.uniform(ks[10], (L, G), f32, math.log(DT_MIN), math.log(DT_MAX))
    return {
        "x": jax.random.normal(ks[0], (BATCH, SEQ, D), f32),
        "c": jax.random.normal(ks[1], (BATCH, D), f32),
        "w_ada": nrm(ks[2], (L, D, N_MOD * D), D) * 0.5,
        "b_ada": 0.02 * jax.random.normal(ks[3], (L, N_MOD * D), f32),
        "norm1_g": gain(ks[4], (L, D)),
        "w_in": nrm(ks[5], (L, D, IN_COLS), D),
        "conv_w": nrm(ks[6], (L, CONV_KERNEL, CONV_WIDTH), CONV_KERNEL),
        "conv_b": 0.02 * jax.random.normal(ks[7], (L, CONV_WIDTH), f32),
        "conv_ln_g": gain(ks[11], (L, CONV_WIDTH)),
        "conv_ln_b": 0.02 * jax.random.normal(ks[12], (L, CONV_WIDTH), f32),
        "conv_proj": nrm(ks[13], (L, CONV_WIDTH, D), CONV_WIDTH),
        "ssm_a_re": a_re,
        "ssm_a_im": a_im,
        "ssm_b_re": nrm(ks[14], (L, G, P, H), 2 * H),
        "ssm_b_im": nrm(ks[15], (L, G, P, H), 2 * H),
        "ssm_c_re": nrm(ks[16], (L, G, H, P), P),
        "ssm_c_im": nrm(ks[17], (L, G, H, P), P),
        "ssm_d": jax.random.normal(ks[18], (L, SSM_WIDTH), f32),
        "ssm_log_dt": log_dt,
        "ssm_glu": nrm(ks[19], (L, SSM_WIDTH, 2 * D), SSM_WIDTH),
        "w_out": nrm(ks[20], (L, D, D), D),
        "norm2_g": gain(ks[21], (L, D)),
        "w_ffn_in": nrm(ks[22], (L, D, 2 * FFN_HIDDEN), D),
        "w_ffn_out": nrm(ks[23], (L, FFN_HIDDEN, D), FFN_HIDDEN),
        "final_g": gain(ks[24], (D,)),
    }


def reference(x, c, w_ada, b_ada, norm1_g, w_in, conv_w, conv_b, conv_ln_g, conv_ln_b,
              conv_proj, ssm_a_re, ssm_a_im, ssm_b_re, ssm_b_im, ssm_c_re, ssm_c_im,
              ssm_d, ssm_log_dt, ssm_glu, w_out, norm2_g, w_ffn_in, w_ffn_out, final_g):
    c_act = jax.nn.silu(c)
    split_pts = [2 * CONV_WIDTH, 2 * CONV_WIDTH + SSM_WIDTH, 2 * CONV_WIDTH + SSM_WIDTH + D_MODEL]
    for l in range(DEPTH):
        mod = (c_act @ w_ada[l] + b_ada[l])[:, None, :]
        sh1, sc1, g1, sh2, sc2, g2 = jnp.split(mod, N_MOD, axis=-1)

        h = rmsnorm(x, norm1_g[l]) * (1.0 + sc1) + sh1
        z = h @ w_in[l]
        u_conv, u_ssm, gl_conv, gl_ssm = jnp.split(z, split_pts, axis=-1)
        y_conv = conformer_conv(u_conv, conv_w[l], conv_b[l], conv_ln_g[l],
                                conv_ln_b[l], conv_proj[l])
        y_ssm = s5_mixer(u_ssm, ssm_a_re[l], ssm_a_im[l], ssm_b_re[l], ssm_b_im[l],
                         ssm_c_re[l], ssm_c_im[l], ssm_d[l], ssm_log_dt[l], ssm_glu[l])
        merged = jax.nn.sigmoid(gl_conv) * y_conv + jax.nn.sigmoid(gl_ssm) * y_ssm
        x = x + g1 * (merged @ w_out[l])

        h = rmsnorm(x, norm2_g[l]) * (1.0 + sc2) + sh2
        f_gate, f_up = jnp.split(h @ w_ffn_in[l], 2, axis=-1)
        x = x + g2 * ((jax.nn.silu(f_gate) * f_up) @ w_ffn_out[l])
    return rmsnorm(x, final_g)
```

```cpp
#include <hip/hip_runtime.h>
#include <hip/hip_cooperative_groups.h>
#include <cstdio>
#include <cstdint>
namespace cg = cooperative_groups;
#define PG8_ALIGN true
#define PG8_SP2 true
#ifndef DUP_MASK
#define DUP_MASK 0x000
#endif
#ifndef EXTRA_SYNCS
#define EXTRA_SYNCS 0
#endif
#ifndef GEMM_SIMPLE
#define GEMM_SIMPLE 0
#endif
#if GEMM_SIMPLE
#define GEMM_CALL(E_, S_) pg8::gemm_simple<E_, S_>
#else
#define GEMM_CALL(E_, S_) pg8::gemm_phase<E_, S_, PG8_ALIGN, PG8_SP2>
#endif
#ifndef MK_PER_PHASE
#define MK_PER_PHASE 0
#endif
namespace pg8 {
#define PG8_LAS __attribute__((address_space(3)))
typedef unsigned short bf16_t;
typedef short bf16x8 __attribute__((ext_vector_type(8)));
typedef float f32x4 __attribute__((ext_vector_type(4)));
typedef unsigned u32x4 __attribute__((ext_vector_type(4)));
constexpr int BM = 256, BK = 64, HALF = 128, HTB = HALF * BK * 2  , STAGE_BYTES = 8 * HTB, NXCD = 8, WGM = 8;

__host__ __device__ __forceinline__ int lds_byte(int r, int c) { const int st = (r >> 4) * 2 + (c >> 5), rr = r & 15, cc = c & 31, ob = rr * 64 + cc * 2; return st * 1024 + (ob ^ (((ob >> 9) & 1) << 5)); }
__host__ __device__ __forceinline__ void stage_rc(int b, int& R, int& C) { const int st = b / 1024, sb = b % 1024, swz = sb ^ (((sb >> 9) & 1) << 5); R = (st >> 1) * 16 + swz / 64; C = (st & 1) * 32 + (swz % 64) / 2; }
__host__ __device__ __forceinline__ int perm32(int rho) { const int n = rho >> 4, i = rho & 15; return 8 * (i >> 2) + 4 * n + (i & 3); }

struct Unit { int pm, pn, z; };
struct Gemm { int K, lda, ldb; };

struct StaticOrder {
    int nM, nN, nwg, G, c; const char* A; const char* B; size_t tsA, tsB;
    __host__ __device__ void init(int M, int N, int G_, int c_, const void* A_, int lda, const void* B_, int ldb) { nM = M / BM; nN = N / BM; nwg = nM * nN; G = G_; c = c_; A = (const char*)A_; B = (const char*)B_; tsA = (size_t)BM * lda * 2; tsB = (size_t)BM * ldb * 2; }
    __device__ __forceinline__ const char* pa(const Unit& u) const { return A + (size_t)u.pm * tsA; }
    __device__ __forceinline__ const char* pb(const Unit& u) const { return B + (size_t)u.pn * tsB; }
    __host__ __device__ bool next(int i, Unit& u) const {
        const long L = (long)i * G + c; if (L >= nwg) return false;
        int wgid = (int)L; { const int q = nwg / NXCD, r = nwg % NXCD, xcd = wgid % NXCD, off = wgid / NXCD; wgid = (xcd < r ? xcd * (q + 1) : r * (q + 1) + (xcd - r) * q) + off; }
        const int nig = WGM * nN, gid = wgid / nig, fm = gid * WGM, gsz = (nM - fm) < WGM ? (nM - fm) : WGM;
        u.pm = fm + ((wgid % nig) % gsz); u.pn = (wgid % nig) / gsz; u.z = 0; return true;
    }
    __device__ __forceinline__ void a_ready(const Unit&) const {}
    __device__ __forceinline__ void done(const Unit&) const {}
};

__device__ __forceinline__ unsigned cvt_pk_bf16(float lo, float hi) { unsigned r; asm volatile("s_nop 1\n\tv_cvt_pk_bf16_f32 %0, %1, %2" : "=v"(r) : "v"(lo), "v"(hi)); return r; }
template <class Epi, class Sched, bool ALIGN_EPI = false, bool SP2 = false>
__device__ __forceinline__ void gemm_phase(PG8_LAS unsigned char* lds, const Gemm g, const Sched& S, const Epi& E) {
    const int tid = threadIdx.x, wid = __builtin_amdgcn_readfirstlane(tid >> 6), lane = tid & 63, wr = wid >> 2, wc = wid & 3, fr = lane & 15, fq = lane >> 4;
    const int K = g.K, nt = K / BK;
    unsigned voffA[2], voffB[2];
#pragma unroll
    for (int i = 0; i < 2; ++i) { int R, C; stage_rc(tid * 16 + i * 8192, R, C); const int Rb = Epi::PERM ? ((R & ~31) + perm32(R & 31)) : R;
        voffA[i] = (unsigned)(R * g.lda + C) * 2u; voffB[i] = (unsigned)(Rb * g.ldb + C) * 2u; }
    const size_t kstep = (size_t)(BK * 2);
    const size_t hstepA = (size_t)HALF * g.lda * 2, hstepB = (size_t)HALF * g.ldb * 2;
    const unsigned ldsw = (unsigned)wid * 1024u;
    const int aoff = lds_byte(wr * 64 + fr, fq * 8), boff = lds_byte(wc * 32 + fr, fq * 8);
#define PG8_SA(b, h) (((b) * 2 + (h)) * HTB)
#define PG8_SB(b, h) ((4 + (b) * 2 + (h)) * HTB)
#define PG8_STAGE(bufoff, gbase, voff) do { _Pragma("unroll") for (int _i = 0; _i < 2; ++_i) \
        __builtin_amdgcn_global_load_lds((const unsigned*)((const char*)(gbase) + (voff)[_i]), (PG8_LAS unsigned*)(lds + (bufoff) + ldsw + _i * 8192), 16, 0, 0); } while (0)
#define PG8_LDA(dst, b, h) do { _Pragma("unroll") for (int m = 0; m < 4; ++m) _Pragma("unroll") for (int k = 0; k < 2; ++k) dst[m][k] = *(const PG8_LAS bf16x8*)(lds + PG8_SA(b, h) + aoff + m * 2048 + k * 1024); } while (0)
#define PG8_LDB(dst, b, h) do { _Pragma("unroll") for (int n = 0; n < 2; ++n) _Pragma("unroll") for (int k = 0; k < 2; ++k) dst[n][k] = *(const PG8_LAS bf16x8*)(lds + PG8_SB(b, h) + boff + n * 2048 + k * 1024); } while (0)
#define PG8_MMA(ai, bj, At, Bt) do { __builtin_amdgcn_s_setprio(1); _Pragma("unroll") for (int m = 0; m < 4; ++m) _Pragma("unroll") for (int n = 0; n < 2; ++n) _Pragma("unroll") for (int k = 0; k < 2; ++k) \
        acc[ai][bj][m][n] = __builtin_amdgcn_mfma_f32_16x16x32_bf16(Bt[n][k], At[m][k], acc[ai][bj][m][n], 0, 0, 0); __builtin_amdgcn_s_setprio(0); } while (0)
#define PG8_WAIT_V(n) asm volatile("s_waitcnt vmcnt(" #n ")" ::: "memory")
#define PG8_WAIT_L(n) asm volatile("s_waitcnt lgkmcnt(" #n ")" ::: "memory")
#define PG8_BAR __builtin_amdgcn_s_barrier()
#define PG8_SCHED __builtin_amdgcn_sched_barrier(0)
    Unit cur, nxt; int ui = 0;
    if (!S.next(0, cur)) return;
    f32x4 acc[2][2][4][2];
#pragma unroll
    for (int a = 0; a < 2; ++a)
#pragma unroll
        for (int b = 0; b < 2; ++b)
#pragma unroll
            for (int m = 0; m < 4; ++m)
#pragma unroll
                for (int n = 0; n < 2; ++n) acc[a][b][m][n] = (f32x4){0.f, 0.f, 0.f, 0.f};
    bf16x8 At[4][2], B0[2][2], B1[2][2];
    const char* cA = S.pa(cur); const char* cB = S.pb(cur);
    S.a_ready(cur);
    if constexpr (SP2) {
        PG8_STAGE(PG8_SB(0, 0), cB, voffB); PG8_STAGE(PG8_SB(0, 1), cB + hstepB, voffB); PG8_STAGE(PG8_SA(0, 0), cA, voffA); PG8_STAGE(PG8_SA(0, 1), cA + hstepA, voffA);
        if (wr == 1) PG8_BAR;
        PG8_WAIT_V(2); PG8_BAR;
        PG8_STAGE(PG8_SB(1, 0), cB + kstep, voffB); PG8_STAGE(PG8_SA(1, 0), cA + kstep, voffA); PG8_STAGE(PG8_SB(1, 1), cB + hstepB + kstep, voffB);
        PG8_WAIT_V(6); PG8_BAR;
    } else {
        PG8_STAGE(PG8_SB(0, 0), cB, voffB); PG8_STAGE(PG8_SA(0, 0), cA, voffA); PG8_STAGE(PG8_SB(0, 1), cB + hstepB, voffB); PG8_STAGE(PG8_SA(0, 1), cA + hstepA, voffA);
        if (wr == 1) PG8_BAR;
        PG8_WAIT_V(4); PG8_BAR;
        PG8_STAGE(PG8_SB(1, 0), cB + kstep, voffB); PG8_STAGE(PG8_SA(1, 0), cA + kstep, voffA); PG8_STAGE(PG8_SB(1, 1), cB + hstepB + kstep, voffB);
        PG8_WAIT_V(6); PG8_BAR;
    }
    for (;;) {
        const bool has_next = S.next(ui + 1, nxt);
        const char* nA = has_next ? S.pa(nxt) : cA; const char* nB = has_next ? S.pb(nxt) : cB;
#pragma unroll 1
        for (int t = 0; t < nt; t += 2) {
            const bool last = (t == nt - 2);
            const char* a1 = cA + (size_t)(t + 1) * kstep;
            const char* a2 = last ? nA : cA + (size_t)(t + 2) * kstep; const char* b2 = last ? nB : cB + (size_t)(t + 2) * kstep;
            const char* a3 = a2 + kstep; const char* b3 = b2 + kstep;
            if (last && has_next) S.a_ready(nxt);
            if constexpr (SP2) {
            PG8_LDB(B0, 0, 0); PG8_LDB(B1, 0, 1); PG8_SCHED; PG8_LDA(At, 0, 0); PG8_STAGE(PG8_SA(1, 1), a1 + hstepA, voffA);
            PG8_WAIT_V(8); PG8_WAIT_L(0); PG8_BAR; PG8_MMA(0, 0, At, B0); PG8_MMA(0, 1, At, B1); PG8_BAR; PG8_SCHED;
            PG8_LDA(At, 0, 1); PG8_STAGE(PG8_SB(0, 0), b2, voffB); PG8_STAGE(PG8_SB(0, 1), b2 + hstepB, voffB); PG8_STAGE(PG8_SA(0, 0), a2, voffA);
            PG8_WAIT_V(8); PG8_WAIT_L(0); PG8_BAR; PG8_MMA(1, 0, At, B0); PG8_MMA(1, 1, At, B1); PG8_BAR; PG8_SCHED;
            PG8_LDB(B0, 1, 0); PG8_LDB(B1, 1, 1); PG8_SCHED; PG8_LDA(At, 1, 0); PG8_STAGE(PG8_SA(0, 1), a2 + hstepA, voffA);
            PG8_WAIT_V(8); PG8_WAIT_L(0); PG8_BAR; PG8_MMA(0, 0, At, B0); PG8_MMA(0, 1, At, B1); PG8_BAR; PG8_SCHED;
            PG8_LDA(At, 1, 1); PG8_STAGE(PG8_SB(1, 0), b3, voffB); PG8_STAGE(PG8_SB(1, 1), b3 + hstepB, voffB); PG8_STAGE(PG8_SA(1, 0), a3, voffA);
            PG8_WAIT_V(8); PG8_WAIT_L(0); PG8_BAR; PG8_MMA(1, 0, At, B0); PG8_MMA(1, 1, At, B1); PG8_BAR; PG8_SCHED;
            } else {
            PG8_LDB(B0, 0, 0); PG8_SCHED; PG8_LDA(At, 0, 0); PG8_STAGE(PG8_SA(1, 1), a1 + hstepA, voffA);
            PG8_WAIT_L(8); PG8_BAR; PG8_WAIT_L(0); PG8_MMA(0, 0, At, B0); PG8_BAR; PG8_SCHED;
            PG8_LDB(B1, 0, 1); PG8_STAGE(PG8_SB(0, 0), b2, voffB);
            PG8_BAR; PG8_WAIT_L(0); PG8_MMA(0, 1, At, B1); PG8_BAR;
            PG8_LDA(At, 0, 1); PG8_STAGE(PG8_SA(0, 0), a2, voffA);
            PG8_BAR; PG8_WAIT_L(0); PG8_MMA(1, 0, At, B0); PG8_BAR; PG8_SCHED;
            PG8_STAGE(PG8_SB(0, 1), b2 + hstepB, voffB);
            PG8_WAIT_V(6); PG8_BAR; PG8_MMA(1, 1, At, B1); PG8_BAR;
            PG8_LDB(B0, 1, 0); PG8_SCHED; PG8_LDA(At, 1, 0); PG8_STAGE(PG8_SA(0, 1), a2 + hstepA, voffA);
            PG8_WAIT_L(8); PG8_BAR; PG8_WAIT_L(0); PG8_MMA(0, 0, At, B0); PG8_BAR; PG8_SCHED;
            PG8_LDB(B1, 1, 1); PG8_STAGE(PG8_SB(1, 0), b3, voffB);
            PG8_BAR; PG8_WAIT_L(0); PG8_MMA(0, 1, At, B1); PG8_BAR;
            PG8_LDA(At, 1, 1); PG8_STAGE(PG8_SA(1, 0), a3, voffA);
            PG8_BAR; PG8_WAIT_L(0); PG8_MMA(1, 0, At, B0); PG8_BAR; PG8_SCHED;
            PG8_STAGE(PG8_SB(1, 1), b3 + hstepB, voffB);
            PG8_WAIT_V(6); PG8_BAR; PG8_MMA(1, 1, At, B1); PG8_BAR;
            }
        }
        if constexpr (ALIGN_EPI) { if (wr == 0) PG8_BAR; }
        if constexpr (!Epi::AFTER_DRAIN) { E(acc, cur, wr, wc, fr, fq); S.done(cur); }
        if (!has_next) break;
#pragma unroll
        for (int a = 0; a < 2; ++a)
#pragma unroll
            for (int b = 0; b < 2; ++b)
#pragma unroll
                for (int m = 0; m < 4; ++m)
#pragma unroll
                    for (int n = 0; n < 2; ++n) acc[a][b][m][n] = (f32x4){0.f, 0.f, 0.f, 0.f};
        cur = nxt; cA = nA; cB = nB; ++ui;
        if constexpr (ALIGN_EPI) { if (wr == 1) PG8_BAR; }
    }
    PG8_WAIT_V(0);
    if constexpr (!ALIGN_EPI) { if (wr == 0) PG8_BAR; }
    PG8_BAR;
    if constexpr (Epi::AFTER_DRAIN) { E.fused(acc, cur, wr, wc, fr, fq, lds, wid, lane); S.done(cur); }
#undef PG8_SA
#undef PG8_SB
#undef PG8_STAGE
#undef PG8_LDA
#undef PG8_LDB
#undef PG8_MMA
#undef PG8_WAIT_V
#undef PG8_WAIT_L
#undef PG8_BAR
#undef PG8_SCHED
}

template <class Epi, class Sched>
__device__ __forceinline__ void gemm_simple(PG8_LAS unsigned char* lds, const Gemm g, const Sched& S, const Epi& E) {
    const int tid = threadIdx.x, wid = __builtin_amdgcn_readfirstlane(tid >> 6), lane = tid & 63, wr = wid >> 2, wc = wid & 3, fr = lane & 15, fq = lane >> 4;
    const int nt = g.K / BK;
    unsigned voffA[2], voffB[2];
#pragma unroll
    for (int i = 0; i < 2; ++i) { int R, C; stage_rc(tid * 16 + i * 8192, R, C); const int Rb = Epi::PERM ? ((R & ~31) + perm32(R & 31)) : R;
        voffA[i] = (unsigned)(R * g.lda + C) * 2u; voffB[i] = (unsigned)(Rb * g.ldb + C) * 2u; }
    const size_t kstep = (size_t)(BK * 2), hstepA = (size_t)HALF * g.lda * 2, hstepB = (size_t)HALF * g.ldb * 2;
    const unsigned ldst = (unsigned)tid * 16u;
    const int aoff = lds_byte(wr * 64 + fr, fq * 8), boff = lds_byte(wc * 32 + fr, fq * 8);
#define SG_SA(b, h) (((b) * 2 + (h)) * HTB)
#define SG_SB(b, h) ((4 + (b) * 2 + (h)) * HTB)
#define SG_LDB(dst, b, h) do { _Pragma("unroll") for (int n = 0; n < 2; ++n) _Pragma("unroll") for (int k = 0; k < 2; ++k) dst[n][k] = *(const PG8_LAS bf16x8*)(lds + SG_SB(b, h) + boff + n * 2048 + k * 1024); } while (0)
#define SG_AFRAG(b, st, k) (*(const PG8_LAS bf16x8*)(lds + SG_SA(b, (st) >> 2) + aoff + ((st) & 3) * 2048 + (k) * 1024))
#define SG_AHALF(b, ai) do { bf16x8 c0 = SG_AFRAG(b, (ai) * 4, 0), c1 = SG_AFRAG(b, (ai) * 4, 1); \
        _Pragma("unroll") for (int m = 0; m < 4; ++m) { bf16x8 n0 = c0, n1 = c1; \
            if (m < 3) { n0 = SG_AFRAG(b, (ai) * 4 + m + 1, 0); n1 = SG_AFRAG(b, (ai) * 4 + m + 1, 1); } \
            __builtin_amdgcn_sched_barrier(0); \
            _Pragma("unroll") for (int n = 0; n < 2; ++n) { \
                acc[ai][0][m][n] = __builtin_amdgcn_mfma_f32_16x16x32_bf16(B0[n][0], c0, acc[ai][0][m][n], 0, 0, 0); acc[ai][0][m][n] = __builtin_amdgcn_mfma_f32_16x16x32_bf16(B0[n][1], c1, acc[ai][0][m][n], 0, 0, 0); \
                acc[ai][1][m][n] = __builtin_amdgcn_mfma_f32_16x16x32_bf16(B1[n][0], c0, acc[ai][1][m][n], 0, 0, 0); acc[ai][1][m][n] = __builtin_amdgcn_mfma_f32_16x16x32_bf16(B1[n][1], c1, acc[ai][1][m][n], 0, 0, 0); } \
            __builtin_amdgcn_sched_barrier(0); c0 = n0; c1 = n1; } } while (0)
#define SG_LOADA(t) do { _Pragma("unroll") for (int h = 0; h < 2; ++h) _Pragma("unroll") for (int i = 0; i < 2; ++i) rr[h][i] = *(const u32x4*)(cA + h * hstepA + (size_t)(t) * kstep + voffA[i]); } while (0)
#define SG_LOADB(t) do { _Pragma("unroll") for (int h = 0; h < 2; ++h) _Pragma("unroll") for (int i = 0; i < 2; ++i) rr[h][i] = *(const u32x4*)(cB + h * hstepB + (size_t)(t) * kstep + voffB[i]); } while (0)
#define SG_STOREA(b) do { _Pragma("unroll") for (int h = 0; h < 2; ++h) _Pragma("unroll") for (int i = 0; i < 2; ++i) *(PG8_LAS u32x4*)(lds + SG_SA(b, h) + i * 8192 + ldst) = rr[h][i]; } while (0)
#define SG_STOREB(b) do { _Pragma("unroll") for (int h = 0; h < 2; ++h) _Pragma("unroll") for (int i = 0; i < 2; ++i) *(PG8_LAS u32x4*)(lds + SG_SB(b, h) + i * 8192 + ldst) = rr[h][i]; } while (0)
#define SG_KTILE(b, tn, more) do { bf16x8 B0[2][2], B1[2][2]; if (more) SG_LOADA(tn); SG_LDB(B0, b, 0); SG_LDB(B1, b, 1); SG_AHALF(b, 0); \
        if (more) { SG_STOREA((b) ^ 1); SG_LOADB(tn); } SG_AHALF(b, 1); if (more) SG_STOREB((b) ^ 1); __syncthreads(); } while (0)
    Unit cur;
    for (int ui = 0; S.next(ui, cur); ++ui) {
        f32x4 acc[2][2][4][2];
#pragma unroll
        for (int a = 0; a < 2; ++a)
#pragma unroll
            for (int b = 0; b < 2; ++b)
#pragma unroll
                for (int m = 0; m < 4; ++m)
#pragma unroll
                    for (int n = 0; n < 2; ++n) acc[a][b][m][n] = (f32x4){0.f, 0.f, 0.f, 0.f};
        const char* cA = S.pa(cur); const char* cB = S.pb(cur);
        u32x4 rr[2][2];
        __syncthreads();
        SG_LOADA(0); SG_STOREA(0); SG_LOADB(0); SG_STOREB(0);
        __syncthreads();
#pragma unroll 1
        for (int t = 0; t < nt; t += 2) {
            SG_KTILE(0, t + 1, true);
            const bool more = (t + 2 < nt);
            SG_KTILE(1, t + 2, more);
        }
        E(acc, cur, wr, wc, fr, fq);
    }
#undef SG_SA
#undef SG_SB
#undef SG_LDB
#undef SG_AFRAG
#undef SG_AHALF
#undef SG_LOADA
#undef SG_LOADB
#undef SG_STOREA
#undef SG_STOREB
#undef SG_KTILE
}
}

constexpr int BATCH = 4, SEQ = 4096, D = 1024, M = BATCH * SEQ;
constexpr int CW = 512, CK = 31, SW = 512, NG = 32, SP = 64, FH = 2816, INC = 3584, NMOD6 = 6 * D;
constexpr int LC = 16, NCH = M / LC, CPB = SEQ / LC, KA2 = 384;
constexpr float EPS = 1e-6f;
constexpr int NWAVES = 8, NTHR = 512;
constexpr int NPHASE = 8;

constexpr size_t MiB = 1u << 20;
constexpr size_t WS_CTL = 0, CTL_ZERO_BYTES = 1 * MiB;
constexpr size_t WS_BAR = 512 * 1024, WS_PCNT = 512 * 1024 + 16384, WS_GCNT = 512 * 1024 + 32768, BAR_BYTES = 32768 + 256;
constexpr size_t WS_MOD = 0, WS_RSS1 = 30 * MiB, WS_RSS2 = 31 * MiB;
constexpr size_t WS_WIN = 1 * MiB, WS_WCP = 8 * MiB, WS_WGLU = 9 * MiB, WS_WOUT = 11 * MiB, WS_WFI = 13 * MiB, WS_WFO = 24 * MiB;
constexpr size_t WS_SHW = 29 * MiB + 512 * 1024;
constexpr size_t WS_W1 = 30 * MiB, WS_B2 = 34 * MiB;
constexpr size_t WS_H1 = 40 * MiB;
constexpr size_t WS_UCONV = 72 * MiB, WS_A2S = 88 * MiB, WS_SGC = 112 * MiB, WS_SGS = 144 * MiB, WS_ACONV = 176 * MiB, WS_ASSM = 192 * MiB, WS_S = 208 * MiB, WS_MERGED = 224 * MiB;
constexpr size_t WS_X1B = 72 * MiB;
constexpr size_t WS_HID = 136 * MiB;
constexpr size_t WS_END = 256 * MiB;
static_assert(WS_HID + (size_t)M * FH * 2 <= WS_MERGED && WS_WFO + (size_t)D * FH * 2 <= WS_SHW && WS_B2 + (size_t)NG * 256 * KA2 * 2 <= WS_H1, "ws map");

constexpr int RING_BYTES = 131072, LDS_BYTES = 147456;

#define GAS __attribute__((address_space(1)))
#define LAS __attribute__((address_space(3)))
typedef unsigned short bf16;
typedef unsigned v4u __attribute__((ext_vector_type(4)));
typedef unsigned v2u __attribute__((ext_vector_type(2)));
typedef float f32x4 __attribute__((ext_vector_type(4)));
typedef float f32x2 __attribute__((ext_vector_type(2)));
using pg8::cvt_pk_bf16;
__device__ __forceinline__ float bf_lo(unsigned w) { return __uint_as_float(w << 16); }
__device__ __forceinline__ float bf_hi(unsigned w) { return __uint_as_float(w & 0xffff0000u); }
__device__ __forceinline__ float sigm(float x) { return __builtin_amdgcn_rcpf(1.0f + __expf(-x)); }
__device__ __forceinline__ float silu_f(float x) { return x * sigm(x); }
__device__ __forceinline__ float gelu_tanh(float x) { return x * sigm(1.5957691216057308f * (x + 0.044715f * x * x * x)); }
__device__ __forceinline__ float wave_sum(float v) {
#pragma unroll
    for (int o = 1; o < 64; o <<= 1) v += __shfl_xor(v, o);
    return v;
}
__device__ __forceinline__ v4u pack8(const f32x4 a, const f32x4 b) { v4u w; w.x = cvt_pk_bf16(a[0], a[1]); w.y = cvt_pk_bf16(a[2], a[3]); w.z = cvt_pk_bf16(b[0], b[1]); w.w = cvt_pk_bf16(b[2], b[3]); return w; }
__device__ __forceinline__ void unpack8(const v4u w, f32x4& a, f32x4& b) { a = (f32x4){bf_lo(w.x), bf_hi(w.x), bf_lo(w.y), bf_hi(w.y)}; b = (f32x4){bf_lo(w.z), bf_hi(w.z), bf_lo(w.w), bf_hi(w.w)}; }

struct BatchOrder {
    int nM, nwg, G, c; const char* A; const char* B; size_t zsA, tsA, zsB;
    __device__ __forceinline__ bool next(int i, pg8::Unit& u) const { const int L = i * G + c; if (L >= nwg) return false; u.z = L / nM; u.pm = L % nM; u.pn = 0; return true; }
    __device__ __forceinline__ const char* pa(const pg8::Unit& u) const { return A + (size_t)u.z * zsA + (size_t)u.pm * tsA; }
    __device__ __forceinline__ const char* pb(const pg8::Unit& u) const { return B + (size_t)u.z * zsB; }
    __device__ __forceinline__ void a_ready(const pg8::Unit&) const {}
    __device__ __forceinline__ void done(const pg8::Unit&) const {}
};

#define EPI_HEAD static constexpr bool PERM = true, AFTER_DRAIN = false
typedef f32x4 AccT[2][2][4][2];

struct EpiIn {
    EPI_HEAD; bf16* uconv; bf16* a2s; bf16* sgc; bf16* sgs;
    __device__ __forceinline__ void operator()(const AccT& acc, const pg8::Unit& u, int wr, int wc, int fr, int fq) const {
        const int row0 = u.pm * 256 + wr * 64 + fr;
        if (u.pn < 4) {
            const int col = u.pn * 128 + wc * 32 + 8 * fq;
#pragma unroll
            for (int ai = 0; ai < 2; ++ai)
#pragma unroll
                for (int m = 0; m < 4; ++m) { const int row = row0 + ai * 128 + m * 16; f32x4 o0, o1;
#pragma unroll
                    for (int e = 0; e < 4; ++e) { o0[e] = acc[ai][0][m][0][e] * sigm(acc[ai][1][m][0][e]); o1[e] = acc[ai][0][m][1][e] * sigm(acc[ai][1][m][1][e]); }
                    *(v4u*)(uconv + (size_t)row * CW + col) = pack8(o0, o1); }
        } else if (u.pn < 6) {
#pragma unroll
            for (int bj = 0; bj < 2; ++bj) { const int cc = (u.pn - 4) * 256 + bj * 128 + wc * 32 + 8 * fq, g = cc >> 4, h0 = cc & 15;
#pragma unroll
                for (int ai = 0; ai < 2; ++ai)
#pragma unroll
                    for (int m = 0; m < 4; ++m) { const int row = row0 + ai * 128 + m * 16;
                        *(v4u*)(a2s + ((size_t)(g * NCH + (row >> 4)) * KA2 + (row & 15) * 16 + h0)) = pack8(acc[ai][bj][m][0], acc[ai][bj][m][1]); } }
        } else {
#pragma unroll
            for (int bj = 0; bj < 2; ++bj) { const int gc = (u.pn - 6) * 256 + bj * 128 + wc * 32 + 8 * fq; bf16* dst = gc < D ? sgc + gc : sgs + (gc - D);
#pragma unroll
                for (int ai = 0; ai < 2; ++ai)
#pragma unroll
                    for (int m = 0; m < 4; ++m) { const int row = row0 + ai * 128 + m * 16; f32x4 o0, o1;
#pragma unroll
                        for (int e = 0; e < 4; ++e) { o0[e] = sigm(acc[ai][bj][m][0][e]); o1[e] = sigm(acc[ai][bj][m][1][e]); }
                        *(v4u*)(dst + (size_t)row * D) = pack8(o0, o1); } }
        }
    }
};
struct EpiState {
    EPI_HEAD; float* S;
    __device__ __forceinline__ void operator()(const AccT& acc, const pg8::Unit& u, int wr, int wc, int fr, int fq) const {
        const int col = wc * 32 + 8 * fq;
#pragma unroll
        for (int ai = 0; ai < 2; ++ai)
#pragma unroll
            for (int m = 0; m < 4; ++m) { const int rr = u.pm * 256 + ai * 128 + wr * 64 + m * 16 + fr; float* p = S + ((size_t)(u.z * NCH + rr)) * 128 + col;
                *(f32x4*)p = acc[ai][0][m][0]; *(f32x4*)(p + 4) = acc[ai][0][m][1]; }
    }
};
struct EpiSsmOut {
    EPI_HEAD; const bf16* a2s; const float* dvec; bf16* assm;
    __device__ __forceinline__ void operator()(const AccT& acc, const pg8::Unit& u, int wr, int wc, int fr, int fq) const {
        const int g = u.z; asm volatile("" : "+v"(fq), "+v"(fr));
#pragma unroll
        for (int bj = 0; bj < 2; ++bj) { const int c = bj * 128 + wc * 32 + 8 * fq, t = c >> 4, h0 = c & 15;
            const f32x4 d0 = *(const f32x4*)(dvec + g * 16 + h0), d1 = *(const f32x4*)(dvec + g * 16 + h0 + 4);
            v4u uu[2][4];
#pragma unroll
            for (int ai = 0; ai < 2; ++ai)
#pragma unroll
                for (int m = 0; m < 4; ++m) uu[ai][m] = *(const v4u*)(a2s + ((size_t)(g * NCH + u.pm * 256 + ai * 128 + wr * 64 + m * 16 + fr) * KA2 + c));
#pragma unroll
            for (int ai = 0; ai < 2; ++ai)
#pragma unroll
                for (int m = 0; m < 4; ++m) { const int rr = u.pm * 256 + ai * 128 + wr * 64 + m * 16 + fr;
                    f32x4 u0, u1; unpack8(uu[ai][m], u0, u1);
                    f32x4 y0 = acc[ai][bj][m][0] + d0 * u0, y1 = acc[ai][bj][m][1] + d1 * u1;
#pragma unroll
                    for (int e = 0; e < 4; ++e) { y0[e] = gelu_tanh(y0[e]); y1[e] = gelu_tanh(y1[e]); }
                    *(v4u*)(assm + ((size_t)(rr * LC + t) * SW + g * 16 + h0)) = pack8(y0, y1); }
            asm volatile("" ::: "memory"); }
    }
};
struct EpiConvProj {
    EPI_HEAD; const bf16* sgc; bf16* mg;
    __device__ __forceinline__ void operator()(const AccT& acc, const pg8::Unit& u, int wr, int wc, int fr, int fq) const {
#pragma unroll
        for (int bj = 0; bj < 2; ++bj) { const int col = u.pn * 256 + bj * 128 + wc * 32 + 8 * fq;
            v4u gg[2][4];
#pragma unroll
            for (int ai = 0; ai < 2; ++ai)
#pragma unroll
                for (int m = 0; m < 4; ++m) gg[ai][m] = *(const v4u*)(sgc + (size_t)(u.pm * 256 + ai * 128 + wr * 64 + m * 16 + fr) * D + col);
#pragma unroll
            for (int ai = 0; ai < 2; ++ai)
#pragma unroll
                for (int m = 0; m < 4; ++m) { const size_t off = (size_t)(u.pm * 256 + ai * 128 + wr * 64 + m * 16 + fr) * D + col;
                    f32x4 g0, g1; unpack8(gg[ai][m], g0, g1);
                    *(v4u*)(mg + off) = pack8(g0 * acc[ai][bj][m][0], g1 * acc[ai][bj][m][1]); }
            asm volatile("" ::: "memory"); }
    }
};
struct EpiSsmGlu {
    EPI_HEAD; const bf16* sgs; bf16* mg;
    __device__ __forceinline__ void operator()(const AccT& acc, const pg8::Unit& u, int wr, int wc, int fr, int fq) const {
        const int col = u.pn * 128 + wc * 32 + 8 * fq;
#pragma unroll
        for (int ai = 0; ai < 2; ++ai) {
            v4u gg[4], pp[4];
#pragma unroll
            for (int m = 0; m < 4; ++m) { const size_t off = (size_t)(u.pm * 256 + ai * 128 + wr * 64 + m * 16 + fr) * D + col; gg[m] = *(const v4u*)(sgs + off); pp[m] = *(const v4u*)(mg + off); }
#pragma unroll
            for (int m = 0; m < 4; ++m) { const size_t off = (size_t)(u.pm * 256 + ai * 128 + wr * 64 + m * 16 + fr) * D + col;
                f32x4 g0, g1, p0, p1; unpack8(gg[m], g0, g1); unpack8(pp[m], p0, p1);
#pragma unroll
                for (int e = 0; e < 4; ++e) { p0[e] += g0[e] * acc[ai][0][m][0][e] * sigm(acc[ai][1][m][0][e]); p1[e] += g1[e] * acc[ai][0][m][1][e] * sigm(acc[ai][1][m][1][e]); }
                *(v4u*)(mg + off) = pack8(p0, p1); }
            asm volatile("" ::: "memory"); }
    }
};
struct EpiOut {
    EPI_HEAD; const float* x; const float* mod; const float* n2g; bf16* x1; bf16* a2; float* rss;
    __device__ __forceinline__ void operator()(const AccT& acc, const pg8::Unit& u, int wr, int wc, int fr, int fq) const {
        const float* mb = mod + (u.pm >> 4) * NMOD6;
        float ss[2][4];
#pragma unroll
        for (int ai = 0; ai < 2; ++ai)
#pragma unroll
            for (int m = 0; m < 4; ++m) ss[ai][m] = 0.f;
#pragma unroll
        for (int bj = 0; bj < 2; ++bj) { const int col = u.pn * 256 + bj * 128 + wc * 32 + 8 * fq;
            const f32x4 gv0 = *(const f32x4*)(mb + 2 * D + col), gv1 = *(const f32x4*)(mb + 2 * D + col + 4);
            const f32x4 cs0 = *(const f32x4*)(n2g + col) * (*(const f32x4*)(mb + 4 * D + col) + 1.0f), cs1 = *(const f32x4*)(n2g + col + 4) * (*(const f32x4*)(mb + 4 * D + col + 4) + 1.0f);
#pragma unroll
            for (int ai = 0; ai < 2; ++ai) {
                f32x4 xx[4][2];
#pragma unroll
                for (int m = 0; m < 4; ++m) { const size_t off = (size_t)(u.pm * 256 + ai * 128 + wr * 64 + m * 16 + fr) * D + col;
                    xx[m][0] = __builtin_nontemporal_load((const f32x4*)(x + off)); xx[m][1] = __builtin_nontemporal_load((const f32x4*)(x + off + 4)); }
#pragma unroll
                for (int m = 0; m < 4; ++m) { const size_t off = (size_t)(u.pm * 256 + ai * 128 + wr * 64 + m * 16 + fr) * D + col;
                    const f32x4 v0 = xx[m][0] + gv0 * acc[ai][bj][m][0], v1 = xx[m][1] + gv1 * acc[ai][bj][m][1];
                    *(v4u*)(a2 + off) = pack8(v0 * cs0, v1 * cs1);
                    ss[ai][m] += (v0[0] * v0[0] + v0[1] * v0[1]) + (v0[2] * v0[2] + v0[3] * v0[3]) + (v1[0] * v1[0] + v1[1] * v1[1]) + (v1[2] * v1[2] + v1[3] * v1[3]); }
                asm volatile("" ::: "memory"); } }
#pragma unroll
        for (int ai = 0; ai < 2; ++ai)
#pragma unroll
            for (int m = 0; m < 4; ++m) { float t = ss[ai][m]; t += __shfl_xor(t, 16); t += __shfl_xor(t, 32);
                if (fq == 0) rss[(u.pm * 256 + ai * 128 + wr * 64 + m * 16 + fr) * 16 + u.pn * 4 + wc] = t; }
    }
};
struct EpiFfnIn {
    EPI_HEAD; const float* rss; const float* shw; bf16* hid;
    __device__ __forceinline__ void operator()(const AccT& acc, const pg8::Unit& u, int wr, int wc, int fr, int fq) const {
        const float* sb = shw + (u.pm >> 4) * (2 * FH) + u.pn * 256 + wc * 32 + 8 * fq;
        const f32x4 sg0 = *(const f32x4*)sb, sg1 = *(const f32x4*)(sb + 4), su0 = *(const f32x4*)(sb + 128), su1 = *(const f32x4*)(sb + 132);
        f32x4 qq[2][4];
#pragma unroll
        for (int ai = 0; ai < 2; ++ai)
#pragma unroll
            for (int m = 0; m < 4; ++m) qq[ai][m] = *(const f32x4*)(rss + (u.pm * 256 + ai * 128 + wr * 64 + m * 16 + fr) * 16 + 4 * fq);
#pragma unroll
        for (int ai = 0; ai < 2; ++ai)
#pragma unroll
            for (int m = 0; m < 4; ++m) { const int row = u.pm * 256 + ai * 128 + wr * 64 + m * 16 + fr;
                float t = (qq[ai][m][0] + qq[ai][m][1]) + (qq[ai][m][2] + qq[ai][m][3]); t += __shfl_xor(t, 16); t += __shfl_xor(t, 32);
                const float inv = rsqrtf(t * (1.0f / D) + EPS);
                const f32x4 g0 = acc[ai][0][m][0] * inv + sg0, g1 = acc[ai][0][m][1] * inv + sg1, u0 = acc[ai][1][m][0] * inv + su0, u1 = acc[ai][1][m][1] * inv + su1; f32x4 o0, o1;
#pragma unroll
                for (int e = 0; e < 4; ++e) { o0[e] = silu_f(g0[e]) * u0[e]; o1[e] = silu_f(g1[e]) * u1[e]; }
                *(v4u*)(hid + (size_t)row * FH + u.pn * 128 + wc * 32 + 8 * fq) = pack8(o0, o1); }
    }
};
struct EpiFfnOut {
    EPI_HEAD; const float* mod; const float* fg; const float* n2g; const bf16* x1; float* xo; float* rss; unsigned* cnt;
    __device__ __forceinline__ void operator()(AccT& acc, const pg8::Unit& u, int wr, int wc, int fr, int fq) const {
        const float* mb = mod + (u.pm >> 4) * NMOD6;
        {
            f32x4 gv[2][2], rc[2][2];
#pragma unroll
            for (int bj = 0; bj < 2; ++bj)
#pragma unroll
                for (int n = 0; n < 2; ++n) { const int col = u.pn * 256 + bj * 128 + wc * 32 + 8 * fq + 4 * n; gv[bj][n] = *(const f32x4*)(mb + 5 * D + col);
                    const f32x4 cs = *(const f32x4*)(n2g + col) * (*(const f32x4*)(mb + 4 * D + col) + 1.0f); rc[bj][n] = (f32x4){1.0f / cs[0], 1.0f / cs[1], 1.0f / cs[2], 1.0f / cs[3]}; }
#pragma unroll
            for (int ai = 0; ai < 2; ++ai)
#pragma unroll
                for (int m = 0; m < 4; ++m) { const int row = u.pm * 256 + ai * 128 + wr * 64 + m * 16 + fr; float ss = 0.f;
#pragma unroll
                    for (int bj = 0; bj < 2; ++bj) { const size_t off = (size_t)row * D + u.pn * 256 + bj * 128 + wc * 32 + 8 * fq;
                        f32x4 r0, r1; unpack8(*(const v4u*)(x1 + off), r0, r1);
                        const f32x4 v0 = r0 * rc[bj][0] + gv[bj][0] * acc[ai][bj][m][0], v1 = r1 * rc[bj][1] + gv[bj][1] * acc[ai][bj][m][1];
                        acc[ai][bj][m][0] = v0; acc[ai][bj][m][1] = v1;
                        ss += (v0[0] * v0[0] + v0[1] * v0[1]) + (v0[2] * v0[2] + v0[3] * v0[3]) + (v1[0] * v1[0] + v1[1] * v1[1]) + (v1[2] * v1[2] + v1[3] * v1[3]); }
                    ss += __shfl_xor(ss, 16); ss += __shfl_xor(ss, 32);
                    if (fq == 0) __hip_atomic_store(rss + row * 16 + u.pn * 4 + wc, ss, __ATOMIC_RELAXED, __HIP_MEMORY_SCOPE_AGENT); }
        }
        asm volatile("s_waitcnt vmcnt(0)" ::: "memory");
        unsigned* cw = cnt + 64 * u.pm;
        if (fr == 0 && fq == 0) __hip_atomic_fetch_add(cw, 1u, __ATOMIC_RELAXED, __HIP_MEMORY_SCOPE_AGENT);
        { unsigned sp = 0; while ((unsigned)__builtin_amdgcn_readfirstlane(__hip_atomic_load(cw, __ATOMIC_RELAXED, __HIP_MEMORY_SCOPE_AGENT)) < 32u) { __builtin_amdgcn_s_sleep(2); if (++sp > (1u << 22)) break; } }
        __builtin_amdgcn_fence(__ATOMIC_ACQUIRE, "agent");
        asm volatile("s_waitcnt vmcnt(0)" ::: "memory");
        f32x4 fv[2][2];
#pragma unroll
        for (int bj = 0; bj < 2; ++bj)
#pragma unroll
            for (int n = 0; n < 2; ++n) fv[bj][n] = *(const f32x4*)(fg + u.pn * 256 + bj * 128 + wc * 32 + 8 * fq + 4 * n);
#pragma unroll
        for (int ai = 0; ai < 2; ++ai)
#pragma unroll
            for (int m = 0; m < 4; ++m) { const int row = u.pm * 256 + ai * 128 + wr * 64 + m * 16 + fr;
                const unsigned long long* pp = (const unsigned long long*)(rss + row * 16 + 4 * fq);
                const unsigned long long w0 = __hip_atomic_load(pp, __ATOMIC_RELAXED, __HIP_MEMORY_SCOPE_AGENT), w1 = __hip_atomic_load(pp + 1, __ATOMIC_RELAXED, __HIP_MEMORY_SCOPE_AGENT);
                float t = (__uint_as_float((unsigned)w0) + __uint_as_float((unsigned)(w0 >> 32))) + (__uint_as_float((unsigned)w1) + __uint_as_float((unsigned)(w1 >> 32)));
                t += __shfl_xor(t, 16); t += __shfl_xor(t, 32);
                const float inv = rsqrtf(t * (1.0f / D) + EPS);
#pragma unroll
                for (int bj = 0; bj < 2; ++bj) { const size_t off = (size_t)row * D + u.pn * 256 + bj * 128 + wc * 32 + 8 * fq;
                    __builtin_nontemporal_store(acc[ai][bj][m][0] * inv * fv[bj][0], (f32x4*)(xo + off)); __builtin_nontemporal_store(acc[ai][bj][m][1] * inv * fv[bj][1], (f32x4*)(xo + off + 4)); } }
    }
};

struct TripleOrder {
    pg8::StaticOrder base; const char* A1; const char* B1; size_t tsA, tsB;
    __device__ __forceinline__ bool next(int i, pg8::Unit& u) const { pg8::Unit t; if (!base.next(i / 3, t)) return false; const int sub = i % 3; u.pm = t.pm;
        if (sub == 0) { u.pn = t.pn; u.z = 0; } else { u.pn = 2 * t.pn + (sub - 1); u.z = 1; } return true; }
    __device__ __forceinline__ const char* pa(const pg8::Unit& u) const { return u.z ? A1 + (size_t)u.pm * tsA : base.pa(u); }
    __device__ __forceinline__ const char* pb(const pg8::Unit& u) const { return u.z ? B1 + (size_t)u.pn * tsB : base.pb(u); }
    __device__ __forceinline__ void a_ready(const pg8::Unit&) const {}
    __device__ __forceinline__ void done(const pg8::Unit&) const {}
};
struct EpiMix {
    EPI_HEAD; const bf16* sgc; const bf16* sgs; bf16* mg;
    __device__ __forceinline__ void operator()(const AccT& acc, const pg8::Unit& u, int wr, int wc, int fr, int fq) const {
        if (u.z == 0) { const EpiConvProj e{sgc, mg}; e(acc, u, wr, wc, fr, fq); } else { const EpiSsmGlu e{sgs, mg}; e(acc, u, wr, wc, fr, fq); }
    }
};

__device__ __forceinline__ int ileave(int n0, int half) { return n0 < half ? 256 * (n0 >> 7) + (n0 & 127) : 256 * ((n0 - half) >> 7) + 128 + ((n0 - half) & 127); }
__device__ __forceinline__ void transpose_item(const float* W, int K, int N, bf16* WT, int mode, LAS float* scr, int item, int lane) {
    const int nblk = N / 32, kb = item / nblk, nb = item % nblk, k0 = 64 * kb, n0 = 32 * nb;
    int r0 = n0;
    if (mode == 1) r0 = n0 < 1024 ? ileave(n0, 512) : n0;
    else if (mode == 2) r0 = ileave(n0, 1024);
    else if (mode == 3) r0 = ileave(n0, FH);
    float tv[32];
#pragma unroll
    for (int i = 0; i < 32; ++i) tv[i] = __builtin_nontemporal_load(W + (size_t)(k0 + 2 * i + (lane >> 5)) * N + n0 + (lane & 31));
#pragma unroll
    for (int i = 0; i < 32; ++i) scr[(2 * i + (lane >> 5)) * 33 + (lane & 31)] = tv[i];
    asm volatile("s_waitcnt lgkmcnt(0)" ::: "memory");
    const int c = lane & 7;
#pragma unroll
    for (int j = 0; j < 4; ++j) { const int n = (lane >> 3) + 8 * j; const LAS float* s = scr + (8 * c) * 33 + n;
        v4u o; o.x = cvt_pk_bf16(s[0 * 33], s[1 * 33]); o.y = cvt_pk_bf16(s[2 * 33], s[3 * 33]); o.z = cvt_pk_bf16(s[4 * 33], s[5 * 33]); o.w = cvt_pk_bf16(s[6 * 33], s[7 * 33]);
        *(v4u*)(WT + (size_t)(r0 + n) * K + k0 + 8 * c) = o; }
    asm volatile("s_waitcnt lgkmcnt(0)" ::: "memory");
}
__device__ __forceinline__ void sincos_d(double x, double& s, double& c) {
    const double k = rint(x * 0.63661977236758134308);
    double r = fma(-k, 1.57079632679489655800e+00, x); r = fma(-k, 6.12323399573676603587e-17, r);
    const int q = ((int)k) & 3; const double r2 = r * r;
    double sp = -1.0 / 1307674368000.0; sp = fma(sp, r2, 1.0 / 6227020800.0); sp = fma(sp, r2, -1.0 / 39916800.0); sp = fma(sp, r2, 1.0 / 362880.0); sp = fma(sp, r2, -1.0 / 5040.0); sp = fma(sp, r2, 1.0 / 120.0); sp = fma(sp, r2, -1.0 / 6.0); sp = fma(sp * r2, r, r);
    double cp = 1.0 / 20922789888000.0; cp = fma(cp, r2, -1.0 / 87178291200.0); cp = fma(cp, r2, 1.0 / 479001600.0); cp = fma(cp, r2, -1.0 / 3628800.0); cp = fma(cp, r2, 1.0 / 40320.0); cp = fma(cp, r2, -1.0 / 720.0); cp = fma(cp, r2, 1.0 / 24.0); cp = fma(cp, r2, -0.5); cp = fma(cp, r2, 1.0);
    s = (q == 0) ? sp : (q == 1) ? cp : (q == 2) ? -sp : -cp;
    c = (q == 0) ? cp : (q == 1) ? -sp : (q == 2) ? -cp : sp;
}
__device__ __forceinline__ void ssm_abar(const float* a_re, const float* a_im, const float* log_dt, int g, int p, double& er, double& ei, double& ar, double& ai) {
    const double dt = (double)expf(log_dt[g]); ar = (double)a_re[g * SP + p]; ai = (double)a_im[g * SP + p];
    const double x = dt * ar;
    double mag = 1.0 / 362880.0; mag = fma(mag, x, 1.0 / 40320.0); mag = fma(mag, x, 1.0 / 5040.0); mag = fma(mag, x, 1.0 / 720.0); mag = fma(mag, x, 1.0 / 120.0); mag = fma(mag, x, 1.0 / 24.0); mag = fma(mag, x, 1.0 / 6.0); mag = fma(mag, x, 0.5); mag = fma(mag, x, 1.0); mag = fma(mag, x, 1.0);
    double s, c; sincos_d(dt * ai, s, c); er = mag * c; ei = mag * s;
}

#define XB_TMO      128
#define XB_XCNT(j)  (256  + 64 * (j))
#define XB_XSUB(j)  (1280 + 64 * (j))
#define XB_XGEN(j)  (2304 + 64 * (j))
#define XB_TOP      3328
#define XB_TOPGEN   3392
#define XCD_BAR_WORDS 3456
#define XB_SPIN_CAP (1u << 18)

__device__ __forceinline__ unsigned xb_ld(unsigned* p)              { return __hip_atomic_load(p, __ATOMIC_RELAXED, __HIP_MEMORY_SCOPE_AGENT); }
__device__ __forceinline__ unsigned xb_add(unsigned* p, unsigned v) { return __hip_atomic_fetch_add(p, v, __ATOMIC_RELAXED, __HIP_MEMORY_SCOPE_AGENT); }
__device__ __forceinline__ unsigned xb_xcc_id() { return (unsigned)__builtin_amdgcn_s_getreg((3 << 11) | 20) & 0xFu; }
#define XB_SPIN(cond, bar) do { unsigned _sp = 0; while (cond) { __builtin_amdgcn_s_sleep(1); \
    if ((++_sp & 255u) == 0u) { if (xb_ld(&(bar)[XB_TMO])) break; if (_sp > XB_SPIN_CAP) { atomicAdd(&(bar)[XB_TMO], 1u); break; } } } } while (0)

struct XcdBarrier {
    unsigned* bar; unsigned x;
    volatile LAS unsigned* st;
};

__device__ __forceinline__ XcdBarrier xcd_barrier_post(unsigned* bar, volatile LAS unsigned* st) {
    XcdBarrier b; b.bar = bar; b.x = xb_xcc_id(); b.st = st;
    if (threadIdx.x == 0) (void)xb_add(&bar[XB_XCNT(b.x)], 1u);
    return b;
}
__device__ __forceinline__ void xcd_barrier_complete(unsigned* bar, unsigned x, unsigned& nloc, unsigned& nx) {
    const unsigned G = gridDim.x * gridDim.y * gridDim.z;
    unsigned sum, cnt, mine, sp = 0u;
    for (;;) {
        sum = 0u; cnt = 0u; mine = 0u;
#pragma unroll
        for (unsigned j = 0; j < 16; ++j) { const unsigned c = xb_ld(&bar[XB_XCNT(j)]); sum += c; cnt += (c > 0u) ? 1u : 0u; mine = (j == x) ? c : mine; }
        if (sum == G) break;
        __builtin_amdgcn_s_sleep(1);
        if ((++sp & 255u) == 0u) { if (xb_ld(&bar[XB_TMO])) break; if (sp > XB_SPIN_CAP) { atomicAdd(&bar[XB_TMO], 1u); break; } }
    }
    nloc = mine > 0u ? mine : 1u; nx = cnt > 0u ? cnt : 1u;
}

__device__ __forceinline__ void xcd_barrier(const XcdBarrier& b) {
    asm volatile("s_waitcnt vmcnt(0)" ::: "memory");
    __syncthreads();
    if (threadIdx.x == 0) {
        unsigned* bar = b.bar;
        __builtin_amdgcn_s_waitcnt(0);
        unsigned nloc = b.st[0], nx = b.st[1];
        if (nloc == 0u) { xcd_barrier_complete(bar, b.x, nloc, nx); b.st[0] = nloc; b.st[1] = nx; }
        const unsigned old = xb_add(&bar[XB_XSUB(b.x)], 1u);
        const unsigned gen = old / nloc;
        if (old + 1u == (gen + 1u) * nloc) {
            __builtin_amdgcn_fence(__ATOMIC_RELEASE, "agent");
            asm volatile("s_waitcnt vmcnt(0)" ::: "memory");
            const unsigned og = xb_add(&bar[XB_TOP], 1u);
            const unsigned tg = og / nx;
            if (og + 1u == (tg + 1u) * nx) xb_add(&bar[XB_TOPGEN], 1u);
            else XB_SPIN(xb_ld(&bar[XB_TOPGEN]) == tg, bar);
            __builtin_amdgcn_fence(__ATOMIC_ACQUIRE, "agent");
            xb_add(&bar[XB_XGEN(b.x)], 1u);
            asm volatile("s_waitcnt vmcnt(0)" ::: "memory");
        } else {
            XB_SPIN(xb_ld(&bar[XB_XGEN(b.x)]) == gen, bar);
            __builtin_amdgcn_fence(__ATOMIC_ACQUIRE, "agent");
            asm volatile("s_waitcnt vmcnt(0)" ::: "memory");
        }
    }
    __syncthreads();
}

struct Args { const float* in[25]; float* out; unsigned char* ws; int ph_lo, ph_hi; };
static_assert(sizeof(Args) == 25 * 8 + 8 + 8 + 8, "Args has no padding");

__global__ void __launch_bounds__(NTHR, 2) fwd_megakernel(Args args) {
    extern __shared__ __attribute__((aligned(16))) unsigned char lds_raw[];
    LAS unsigned char* lds = (LAS unsigned char*)lds_raw;
    const int tid = threadIdx.x, lane = tid & 63, wave = __builtin_amdgcn_readfirstlane(tid >> 6);
    const int G = gridDim.x, bid = blockIdx.x;
    const int gw = bid * NWAVES + wave, NGW = G * NWAVES;
    unsigned char* ws = args.ws;
    const float* x = args.in[0]; const float* cvec = args.in[1]; const float* w_ada = args.in[2]; const float* b_ada = args.in[3]; const float* n1g = args.in[4];
    const float* w_in = args.in[5]; const float* conv_w = args.in[6]; const float* conv_b = args.in[7]; const float* cln_g = args.in[8]; const float* cln_b = args.in[9];
    const float* conv_proj = args.in[10]; const float* a_re = args.in[11]; const float* a_im = args.in[12]; const float* b_re = args.in[13]; const float* b_im = args.in[14];
    const float* c_re = args.in[15]; const float* c_im = args.in[16]; const float* ssm_d = args.in[17]; const float* log_dt = args.in[18]; const float* ssm_glu = args.in[19];
    const float* w_out = args.in[20]; const float* n2g = args.in[21]; const float* w_ffn_in = args.in[22]; const float* w_ffn_out = args.in[23]; const float* final_g = args.in[24];
    float* out = args.out;
    float* MOD = (float*)(ws + WS_MOD); float* RSS1 = (float*)(ws + WS_RSS1); float* RSS2 = (float*)(ws + WS_RSS2); float* SHW = (float*)(ws + WS_SHW);
    bf16* WIN = (bf16*)(ws + WS_WIN); bf16* WCP = (bf16*)(ws + WS_WCP); bf16* WGLU = (bf16*)(ws + WS_WGLU); bf16* WOUT = (bf16*)(ws + WS_WOUT); bf16* WFI = (bf16*)(ws + WS_WFI); bf16* WFO = (bf16*)(ws + WS_WFO);
    bf16* W1T = (bf16*)(ws + WS_W1); bf16* B2T = (bf16*)(ws + WS_B2); bf16* H1 = (bf16*)(ws + WS_H1);
    bf16* UCONV = (bf16*)(ws + WS_UCONV); bf16* A2S = (bf16*)(ws + WS_A2S); bf16* SGC = (bf16*)(ws + WS_SGC); bf16* SGS = (bf16*)(ws + WS_SGS);
    bf16* ACONV = (bf16*)(ws + WS_ACONV); bf16* ASSM = (bf16*)(ws + WS_ASSM); float* SST = (float*)(ws + WS_S); bf16* MG = (bf16*)(ws + WS_MERGED); bf16* HID = (bf16*)(ws + WS_HID); bf16* X1B = (bf16*)(ws + WS_X1B);
    cg::grid_group grid = cg::this_grid();
    const int lo = args.ph_lo, hi = args.ph_hi;
    volatile LAS unsigned* bst = (volatile LAS unsigned*)(lds + RING_BYTES + 1024);
    if (tid < 2) bst[tid] = 0u;
    __syncthreads();
    XcdBarrier xbar = xcd_barrier_post((unsigned*)(ws + WS_BAR), bst);
    if (lo == 0x7fffffff) grid.sync();
#ifndef PHMASK
#define PHMASK 0xFF
#endif
#define IN(k) ((((PHMASK) >> (k)) & 1) && lo <= (k) && (k) < hi)
#define GRID_SYNC() do { xcd_barrier(xbar); } while (0)
#define SEAM(k) do { if (IN(k) && IN((k) + 1)) GRID_SYNC(); } while (0)
#define REPS(k) _Pragma("unroll 1") for (int rep_ = 0; rep_ < ((((DUP_MASK) >> (k)) & 1) ? 2 : 1); ++rep_)

    if (IN(0)) REPS(0) { if (rep_) GRID_SYNC();
        {
            LAS float* scr = (LAS float*)(lds + wave * 16384);
            constexpr int I_IN = (D / 64) * (INC / 32), I_CP = (CW / 64) * (D / 32), I_GLU = (SW / 64) * (2 * D / 32), I_OUT = (D / 64) * (D / 32), I_FI = (D / 64) * (2 * FH / 32), I_FO = (FH / 64) * (D / 32);
            constexpr int NITEMS = I_IN + I_FI;
            const int ngv = NMOD6 / 64;
            const int tw0 = (G >= 2 * ngv) ? (bid - ngv) * NWAVES + wave : gw, tnw = (G >= 2 * ngv) ? (G - ngv) * NWAVES : NGW;
            for (int it = (tw0 >= 0 ? tw0 : NITEMS); it < NITEMS; it += tnw) {
                if (it < I_FI) transpose_item(w_ffn_in, D, 2 * FH, WFI, 3, scr, it, lane);
                else transpose_item(w_in, D, INC, WIN, 1, scr, it - I_FI, lane);
            }
        }
        {
            __syncthreads();
            LAS float* red = (LAS float*)lds;
            LAS float* sc = (LAS float*)(lds + 8192);
            if (bid < NMOD6 / 64) { for (int e = tid; e < BATCH * D; e += NTHR) sc[e] = silu_f(cvec[e]); }
            __syncthreads();
            for (int it = bid; it < NMOD6 / 64; it += G) {
                const int col = it * 64 + lane; float a0 = 0.f, a1 = 0.f, a2 = 0.f, a3 = 0.f;
#pragma unroll 1
                for (int k0 = wave * 128; k0 < wave * 128 + 128; k0 += 32) { float wv[32];
#pragma unroll
                    for (int j = 0; j < 32; ++j) wv[j] = __builtin_nontemporal_load(w_ada + (size_t)(k0 + j) * NMOD6 + col);
#pragma unroll
                    for (int j = 0; j < 32; ++j) { a0 += wv[j] * sc[k0 + j]; a1 += wv[j] * sc[D + k0 + j]; a2 += wv[j] * sc[2 * D + k0 + j]; a3 += wv[j] * sc[3 * D + k0 + j]; } }
                red[(wave * 4 + 0) * 64 + lane] = a0; red[(wave * 4 + 1) * 64 + lane] = a1; red[(wave * 4 + 2) * 64 + lane] = a2; red[(wave * 4 + 3) * 64 + lane] = a3;
                __syncthreads();
                if (tid < 256) { const int b = tid >> 6, c = tid & 63; float t = b_ada[it * 64 + c];
#pragma unroll
                    for (int w = 0; w < 8; ++w) t += red[(w * 4 + b) * 64 + c];
                    __hip_atomic_store(MOD + b * NMOD6 + it * 64 + c, t, __ATOMIC_RELAXED, __HIP_MEMORY_SCOPE_AGENT); }
                asm volatile("s_waitcnt vmcnt(0)" ::: "memory");
                __syncthreads();
                if (tid == 0) __hip_atomic_fetch_add((unsigned*)(ws + WS_GCNT), 1u, __ATOMIC_RELAXED, __HIP_MEMORY_SCOPE_AGENT);
            }
        }
        {
            LAS f32x2* PW = (LAS f32x2*)(lds);
            LAS f32x2* QQ = (LAS f32x2*)(lds + 8704);
            LAS f32x2* BB = (LAS f32x2*)(lds + 9216);
            LAS f32x2* CC = (LAS f32x2*)(lds + 17408);
            LAS float* KT = (LAS float*)(lds + 25600);
            for (int it = bid; it < NG * 8; it += G) {
                const int g = it >> 3, rb = it & 7;
                __syncthreads();
                if (tid < 64) {
                    double er, ei, ar, ai; ssm_abar(a_re, a_im, log_dt, g, tid, er, ei, ar, ai);
                    const double nr = er - 1.0, ni = ei, den = ar * ar + ai * ai;
                    QQ[tid] = (f32x2){(float)((nr * ar + ni * ai) / den), (float)((ni * ar - nr * ai) / den)};
                    double pr = 1.0, pi = 0.0;
                    for (int j = 0; j <= 16; ++j) { PW[j * 64 + tid] = (f32x2){(float)pr, (float)pi}; const double t = pr * er - pi * ei; pi = pr * ei + pi * er; pr = t; }
                }
                for (int e = tid; e < 1024; e += NTHR) CC[e] = (f32x2){c_re[g * 1024 + e], c_im[g * 1024 + e]};
                __syncthreads();
                for (int e = tid; e < 1024; e += NTHR) { const f32x2 q = QQ[e >> 4]; const float br = b_re[g * 1024 + e], bi = b_im[g * 1024 + e]; BB[e] = (f32x2){q.x * br - q.y * bi, q.x * bi + q.y * br}; }
                __syncthreads();
                if (rb < 4) {
                    const int nl = 4 * rb + 4, pair = tid & 255, ho = pair >> 4, hi = pair & 15;
                    for (int j = tid >> 8; j < nl; j += 2) {
                        float s = 0.f;
                        for (int p = 0; p < 64; ++p) { const f32x2 c = CC[ho * 64 + p], w = PW[j * 64 + p], b = BB[p * 16 + hi];
                            const float cr = c.x * w.x - c.y * w.y, ci = c.x * w.y + c.y * w.x; s += cr * b.x - ci * b.y; }
                        KT[j * 256 + pair] = s;
                    }
                    __syncthreads();
                    for (int r = wave * 8; r < wave * 8 + 8; ++r) { const int n = 64 * rb + r, t = n >> 4, ho = n & 15;
#pragma unroll
                        for (int i = 0; i < 3; ++i) { const int kp = lane + 64 * i; float v[2];
#pragma unroll
                            for (int h = 0; h < 2; ++h) { const int k = 2 * kp + h;
                                if (k < 256) { const int s = k >> 4, hi = k & 15; v[h] = (s <= t) ? KT[(t - s) * 256 + ho * 16 + hi] : 0.f; }
                                else { const int p = (k - 256) & 63; const f32x2 c = CC[ho * 64 + p], w = PW[(t + 1) * 64 + p]; v[h] = (k < 320) ? (c.x * w.x - c.y * w.y) : -(c.x * w.y + c.y * w.x); } }
                            *(unsigned*)(B2T + ((size_t)(g * 256 + n) * KA2 + 2 * kp)) = cvt_pk_bf16(v[0], v[1]); } }
                } else {
                    for (int r = wave * 8; r < wave * 8 + 8; ++r) { const int n = 64 * (rb - 4) + r, p = n & 63;
#pragma unroll
                        for (int i = 0; i < 2; ++i) { const int kp = lane + 64 * i; float v[2];
#pragma unroll
                            for (int h = 0; h < 2; ++h) { const int k = 2 * kp + h, s = k >> 4, hi = k & 15; const f32x2 w = PW[(15 - s) * 64 + p], b = BB[p * 16 + hi];
                                v[h] = (n < 64) ? (w.x * b.x - w.y * b.y) : (n < 128) ? (w.x * b.y + w.y * b.x) : 0.f; }
                            *(unsigned*)(W1T + ((size_t)(g * 256 + n) * 256 + 2 * kp)) = cvt_pk_bf16(v[0], v[1]); } }
                }
            }
            __syncthreads();
        }
    }
    if (IN(0) && IN(1)) {
        if (tid == 0) { unsigned sp = 0; while (__hip_atomic_load((unsigned*)(ws + WS_GCNT), __ATOMIC_RELAXED, __HIP_MEMORY_SCOPE_AGENT) < (unsigned)(NMOD6 / 64)) { __builtin_amdgcn_s_sleep(2); if (++sp > (1u << 22)) break; }
            __builtin_amdgcn_fence(__ATOMIC_ACQUIRE, "agent"); asm volatile("s_waitcnt vmcnt(0)" ::: "memory"); }
        __syncthreads();
    }
    for (int xs_ = 0; xs_ < EXTRA_SYNCS; ++xs_) GRID_SYNC();

    if (IN(1)) REPS(1) { if (rep_) GRID_SYNC();
        for (int rb = gw * 8; rb < M; rb += NGW * 8) {
            const float* mb = MOD + (rb >> 12) * NMOD6;
            f32x4 v[8][4]; float inv[8];
#pragma unroll
            for (int q = 0; q < 8; ++q) { const f32x4* xr = (const f32x4*)(x + (size_t)(rb + q) * D) + lane;
#pragma unroll
                for (int j = 0; j < 4; ++j) v[q][j] = __builtin_nontemporal_load(xr + 64 * j); }
#pragma unroll
            for (int q = 0; q < 8; ++q) { float s = 0.f;
#pragma unroll
                for (int j = 0; j < 4; ++j) s += (v[q][j][0] * v[q][j][0] + v[q][j][1] * v[q][j][1]) + (v[q][j][2] * v[q][j][2] + v[q][j][3] * v[q][j][3]);
                inv[q] = rsqrtf(wave_sum(s) * (1.0f / D) + EPS); }
#pragma unroll
            for (int j = 0; j < 4; ++j) { const int col = lane * 4 + 256 * j;
                const f32x4 gsc = (*(const f32x4*)(n1g + col)) * (*(const f32x4*)(mb + D + col) + 1.0f), sh = *(const f32x4*)(mb + col);
#pragma unroll
                for (int q = 0; q < 8; ++q) { const f32x4 h = v[q][j] * inv[q] * gsc + sh;
                    v2u o; o.x = cvt_pk_bf16(h[0], h[1]); o.y = cvt_pk_bf16(h[2], h[3]); *(v2u*)(H1 + (size_t)(rb + q) * D + col) = o; } }
        }
    }
    SEAM(1);

    if (IN(2)) REPS(2) { if (rep_) GRID_SYNC();
        pg8::Gemm g{D, D, D}; pg8::StaticOrder S; S.init(M, INC, G, bid, H1, D, WIN, D);
        EpiIn E{UCONV, A2S, SGC, SGS};
        GEMM_CALL(EpiIn, pg8::StaticOrder)(lds, g, S, E);
        {
            constexpr int NU = (M / 256) * (INC / 256), I_CP = (CW / 64) * (D / 32), I_GLU = (SW / 64) * (2 * D / 32), I_OUT = (D / 64) * (D / 32);
            int first = NU % G, nhelp = G - first; if (first == 0) nhelp = G;
            if (bid >= first) {
                LAS float* scr = (LAS float*)(lds + wave * 16384);
                const int hw0 = (bid - first) * NWAVES + wave, hnw = nhelp * NWAVES;
                for (int it = hw0; it < I_GLU + I_OUT + I_CP; it += hnw) {
                    if (it < I_GLU) transpose_item(ssm_glu, SW, 2 * D, WGLU, 2, scr, it, lane);
                    else if (it < I_GLU + I_OUT) transpose_item(w_out, D, D, WOUT, 0, scr, it - I_GLU, lane);
                    else transpose_item(conv_proj, CW, D, WCP, 0, scr, it - I_GLU - I_OUT, lane);
                }
                for (int v = hw0; v < 2 * FH; v += hnw) {
                    const v4u w0 = *(const v4u*)(WFI + (size_t)v * D + lane * 8), w1 = *(const v4u*)(WFI + (size_t)v * D + 512 + lane * 8);
                    f32x4 a0, a1, b0, b1; unpack8(w0, a0, a1); unpack8(w1, b0, b1);
        #pragma unroll
                    for (int b = 0; b < BATCH; ++b) { const float* sh = MOD + b * NMOD6 + 3 * D;
                        const f32x4 s0 = *(const f32x4*)(sh + lane * 8), s1 = *(const f32x4*)(sh + lane * 8 + 4), s2 = *(const f32x4*)(sh + 512 + lane * 8), s3 = *(const f32x4*)(sh + 512 + lane * 8 + 4);
                        const f32x4 pr = a0 * s0 + a1 * s1 + b0 * s2 + b1 * s3; const float t = wave_sum((pr[0] + pr[1]) + (pr[2] + pr[3]));
                        if (lane == 0) SHW[b * (2 * FH) + v] = t; }
                }
            }
        }
    }
    SEAM(2);

    if (IN(3)) REPS(3) { if (rep_) GRID_SYNC();
        {
            const int cp = tid & 255, th = tid >> 8;
            LAS float* OUTT = (LAS float*)(lds + 65536);
            const bool bal = (G == 256);
            const int nmine = bal ? (bid < NG * 4 ? 0 : 4) : (M / 32 - bid + G - 1) / G;
            for (int ii = 0; ii < nmine; ++ii) {
                const int item = bal ? (bid - NG * 4) * 4 + ii : bid + ii * G;
                const int t0 = item * 32, pos0 = t0 & (SEQ - 1);
                __syncthreads();
                for (int e = tid; e < 62 * 64; e += NTHR) { const int r = e >> 6, ch = e & 63; v4u v = {0u, 0u, 0u, 0u};
                    if (pos0 - 30 + r >= 0) v = *(const v4u*)(UCONV + (size_t)(t0 - 30 + r) * CW + ch * 8);
                    *(LAS v4u*)(lds + r * 1024 + ch * 16) = v; }
                f32x2 w[CK];
#pragma unroll
                for (int j = 0; j < CK; ++j) w[j] = *(const f32x2*)(conv_w + j * CW + 2 * cp);
                f32x2 acc[16]; const f32x2 bias = *(const f32x2*)(conv_b + 2 * cp);
#pragma unroll
                for (int q = 0; q < 16; ++q) acc[q] = bias;
                __syncthreads();
#pragma unroll
                for (int i = 0; i < 46; ++i) { const unsigned uv = *(const LAS unsigned*)(lds + (th * 16 + i) * 1024 + cp * 4); const f32x2 vv = {bf_lo(uv), bf_hi(uv)};
#pragma unroll
                    for (int q = 0; q < 16; ++q) { const int j = i - q; if (j >= 0 && j < CK) acc[q] += vv * w[j]; } }
#pragma unroll
                for (int q = 0; q < 16; ++q) *(LAS f32x2*)(OUTT + (th * 16 + q) * 512 + 2 * cp) = acc[q];
                __syncthreads();
#pragma unroll
                for (int q = 0; q < 4; ++q) { const int tt = wave * 4 + q; const LAS float* rowp = OUTT + tt * 512;
                    f32x4 a = *(const LAS f32x4*)(rowp + lane * 4), b = *(const LAS f32x4*)(rowp + 256 + lane * 4);
                    const float mu = wave_sum((a[0] + a[1]) + (a[2] + a[3]) + (b[0] + b[1]) + (b[2] + b[3])) * (1.0f / CW);
                    a -= mu; b -= mu;
                    const float var = wave_sum((a[0] * a[0] + a[1] * a[1]) + (a[2] * a[2] + a[3] * a[3]) + (b[0] * b[0] + b[1] * b[1]) + (b[2] * b[2] + b[3] * b[3])) * (1.0f / CW);
                    const float rstd = rsqrtf(var + EPS);
                    a = a * rstd * (*(const f32x4*)(cln_g + lane * 4)) + *(const f32x4*)(cln_b + lane * 4);
                    b = b * rstd * (*(const f32x4*)(cln_g + 256 + lane * 4)) + *(const f32x4*)(cln_b + 256 + lane * 4);
                    v2u o0, o1; o0.x = cvt_pk_bf16(silu_f(a[0]), silu_f(a[1])); o0.y = cvt_pk_bf16(silu_f(a[2]), silu_f(a[3])); o1.x = cvt_pk_bf16(silu_f(b[0]), silu_f(b[1])); o1.y = cvt_pk_bf16(silu_f(b[2]), silu_f(b[3]));
                    bf16* dst = ACONV + (size_t)(t0 + tt) * CW; *(v2u*)(dst + lane * 4) = o0; *(v2u*)(dst + 256 + lane * 4) = o1; }
            }
            __syncthreads();
        }
        if (bid < NG * 4) {
            const int L = bid, g = L >> 2, b = L & 3;
            {
                pg8::Gemm gg{256, KA2, 256}; BatchOrder S{4, NG * 4, 1 << 20, L, (const char*)A2S, (const char*)W1T, (size_t)NCH * KA2 * 2, (size_t)256 * KA2 * 2, (size_t)256 * 256 * 2};
                EpiState E{SST};
                GEMM_CALL(EpiState, BatchOrder)(lds, gg, S, E);
            }
            asm volatile("s_waitcnt vmcnt(0)" ::: "memory");
            __syncthreads(); __builtin_amdgcn_fence(__ATOMIC_ACQUIRE, "agent");
            const f32x4* src = (const f32x4*)(SST + (size_t)(g * NCH + b * CPB) * 128);
#pragma unroll 4
            for (int i = 0; i < 16; ++i) *(LAS f32x4*)(lds + (size_t)(tid + i * NTHR) * 16) = src[tid + i * NTHR];
            __syncthreads();
            {
                double er, ei, ar, ai; ssm_abar(a_re, a_im, log_dt, g, lane, er, ei, ar, ai);
#pragma unroll
                for (int j = 0; j < 4; ++j) { const double t = er * er - ei * ei; ei = 2.0 * er * ei; er = t; }
                const float alr = (float)er, ali = (float)ei;
#pragma unroll
                for (int j = 0; j < 5; ++j) { const double t = er * er - ei * ei; ei = 2.0 * er * ei; er = t; }
                const float a32r = (float)er, a32i = (float)ei;
                const LAS float* sl = (const LAS float*)lds + wave * 32 * 128; LAS f32x2* EE = (LAS f32x2*)(lds + RING_BYTES + 2048);
                float xr = 0.f, xi = 0.f;
#pragma unroll 8
                for (int c = 0; c < 32; ++c) { const float sr = sl[c * 128 + lane], si = sl[c * 128 + 64 + lane]; const float nr = alr * xr - ali * xi + sr, ni = alr * xi + ali * xr + si; xr = nr; xi = ni; }
                EE[wave * 64 + lane] = (f32x2){xr, xi};
                __syncthreads();
                xr = 0.f; xi = 0.f;
                for (int v = 0; v < wave; ++v) { const f32x2 e = EE[v * 64 + lane]; const float nr = a32r * xr - a32i * xi + e.x, ni = a32r * xi + a32i * xr + e.y; xr = nr; xi = ni; }
                bf16* dst = A2S + (size_t)(g * NCH + b * CPB + wave * 32) * KA2 + 256 + lane;
#pragma unroll 8
                for (int c = 0; c < 32; ++c) {
                    const unsigned pk = cvt_pk_bf16(xr, xi); dst[(size_t)c * KA2] = (bf16)(pk & 0xffffu); dst[(size_t)c * KA2 + 64] = (bf16)(pk >> 16);
                    const float sr = sl[c * 128 + lane], si = sl[c * 128 + 64 + lane];
                    const float nr = alr * xr - ali * xi + sr, ni = alr * xi + ali * xr + si; xr = nr; xi = ni;
                }
            }
            asm volatile("s_waitcnt vmcnt(0)" ::: "memory");
            __syncthreads(); __builtin_amdgcn_fence(__ATOMIC_ACQUIRE, "agent");
            {
                pg8::Gemm gg{KA2, KA2, KA2}; BatchOrder S{4, NG * 4, 1 << 20, L, (const char*)A2S, (const char*)B2T, (size_t)NCH * KA2 * 2, (size_t)256 * KA2 * 2, (size_t)256 * KA2 * 2};
                EpiSsmOut E{A2S, ssm_d, ASSM};
                GEMM_CALL(EpiSsmOut, BatchOrder)(lds, gg, S, E);
            }
        }
    }
    SEAM(3);

    if (IN(4)) REPS(4) { if (rep_) GRID_SYNC();
        pg8::Gemm g{SW, SW, SW}; TripleOrder S; S.base.init(M, D, G, bid, ACONV, CW, WCP, CW); S.A1 = (const char*)ASSM; S.B1 = (const char*)WGLU; S.tsA = (size_t)256 * SW * 2; S.tsB = (size_t)256 * SW * 2;
        EpiMix E{SGC, SGS, MG};
        GEMM_CALL(EpiMix, TripleOrder)(lds, g, S, E);
    }
    SEAM(4);

    if (IN(5)) REPS(5) { if (rep_) GRID_SYNC();
        pg8::Gemm g{D, D, D}; pg8::StaticOrder S; S.init(M, D, G, bid, MG, D, WOUT, D);
        EpiOut E{x, MOD, n2g, X1B, H1, RSS1};
        GEMM_CALL(EpiOut, pg8::StaticOrder)(lds, g, S, E);
    }
    SEAM(5);

    if (IN(6)) REPS(6) { if (rep_) GRID_SYNC();
        pg8::Gemm g{D, D, D}; pg8::StaticOrder S; S.init(M, 2 * FH, G, bid, H1, D, WFI, D);
        EpiFfnIn E{RSS1, SHW, HID};
        GEMM_CALL(EpiFfnIn, pg8::StaticOrder)(lds, g, S, E);
        {
            constexpr int NU = (M / 256) * (2 * FH / 256), I_FO = (FH / 64) * (D / 32);
            int first = NU % G, nhelp = G - first; if (first == 0) nhelp = G;
            if (bid >= first) {
                LAS float* scr = (LAS float*)(lds + wave * 16384);
                for (int it = (bid - first) * NWAVES + wave; it < I_FO; it += nhelp * NWAVES) transpose_item(w_ffn_out, FH, D, WFO, 0, scr, it, lane);
            }
        }
    }
    SEAM(6);

    if (IN(7)) REPS(7) { if (rep_) GRID_SYNC();
        pg8::Gemm g{FH, FH, FH}; pg8::StaticOrder S; S.init(M, D, G, bid, HID, FH, WFO, FH);
        EpiFfnOut E{MOD, final_g, n2g, H1, out, RSS2, (unsigned*)(ws + WS_PCNT)};
        GEMM_CALL(EpiFfnOut, pg8::StaticOrder)(lds, g, S, E);
    }

#undef IN
#undef SEAM
}

extern "C" void kernel_launch(void* const* d_in, const int* in_sizes, int n_in, void* d_out, int out_size, void* d_ws, size_t ws_size, hipStream_t stream) {
    static int grid = 0;
    if (grid == 0) {
        if (n_in != 25 || out_size != M * D || ws_size < WS_END) { fprintf(stderr, "kernel_launch: unexpected shapes (n_in %d out %d ws %zu)\n", n_in, out_size, ws_size); grid = -1; return; }
        int dev = 0, cus = 0, per_cu = 0;
        (void)hipGetDevice(&dev); (void)hipDeviceGetAttribute(&cus, hipDeviceAttributeMultiprocessorCount, dev);
        if (hipFuncSetAttribute((const void*)fwd_megakernel, hipFuncAttributeMaxDynamicSharedMemorySize, LDS_BYTES) != hipSuccess) { fprintf(stderr, "kernel_launch: hipFuncSetAttribute failed\n"); grid = -1; return; }
        if (hipOccupancyMaxActiveBlocksPerMultiprocessor(&per_cu, (const void*)fwd_megakernel, NTHR, LDS_BYTES) != hipSuccess || per_cu < 1) { fprintf(stderr, "kernel_launch: occupancy query failed (%d)\n", per_cu); (void)hipGetLastError(); per_cu = 1; }
        grid = cus * (per_cu > 1 ? 1 : per_cu);
        if (grid <= 0) grid = 256;
    }
    if (grid < 0) return;
    (void)hipMemsetAsync((char*)d_ws + WS_BAR, 0, BAR_BYTES, stream);
    Args a{};
    for (int i = 0; i < 25; ++i) a.in[i] = (const float*)d_in[i];
    a.out = (float*)d_out; a.ws = (unsigned char*)d_ws;
#if MK_PER_PHASE
    for (int ph = 0; ph < NPHASE; ++ph) { a.ph_lo = ph; a.ph_hi = ph + 1; hipLaunchKernelGGL(fwd_megakernel, dim3(grid), dim3(NTHR), LDS_BYTES, stream, a); }
#else
    a.ph_lo = 0; a.ph_hi = NPHASE;
    void* kargs[] = {&a};
    hipError_t e = hipLaunchCooperativeKernel((const void*)fwd_megakernel, dim3(grid), dim3(NTHR), kargs, LDS_BYTES, stream);
    if (e != hipSuccess) fprintf(stderr, "kernel_launch: cooperative launch failed: %s (grid %d)\n", hipGetErrorString(e), grid);
#endif
}
```

```cpp
#include <hip/hip_runtime.h>
#include <hip/hip_cooperative_groups.h>
#include <cstdio>
#include <cstdint>
namespace cg = cooperative_groups;
#define PG8_ALIGN true
#define PG8_SP2 true
#ifndef DUP_MASK
#define DUP_MASK 0x000
#endif
#ifndef EXTRA_SYNCS
#define EXTRA_SYNCS 0
#endif
#ifndef GEMM_SIMPLE
#define GEMM_SIMPLE 0
#endif
#if GEMM_SIMPLE
#define GEMM_CALL(E_, S_) pg8::gemm_simple<E_, S_>
#else
#define GEMM_CALL(E_, S_) pg8::gemm_phase<E_, S_, PG8_ALIGN, PG8_SP2>
#endif
#ifndef MK_PER_PHASE
#define MK_PER_PHASE 0
#endif
namespace pg8 {
#define PG8_LAS __attribute__((address_space(3)))
typedef unsigned short bf16_t;
typedef short bf16x8 __attribute__((ext_vector_type(8)));
typedef float f32x4 __attribute__((ext_vector_type(4)));
typedef unsigned u32x4 __attribute__((ext_vector_type(4)));
constexpr int BM = 256, BK = 64, HALF = 128, HTB = HALF * BK * 2  , STAGE_BYTES = 8 * HTB, NXCD = 8, WGM = 8;

__host__ __device__ __forceinline__ int lds_byte(int r, int c) { const int st = (r >> 4) * 2 + (c >> 5), rr = r & 15, cc = c & 31, ob = rr * 64 + cc * 2; return st * 1024 + (ob ^ (((ob >> 9) & 1) << 5)); }
__host__ __device__ __forceinline__ void stage_rc(int b, int& R, int& C) { const int st = b / 1024, sb = b % 1024, swz = sb ^ (((sb >> 9) & 1) << 5); R = (st >> 1) * 16 + swz / 64; C = (st & 1) * 32 + (swz % 64) / 2; }
__host__ __device__ __forceinline__ int perm32(int rho) { const int n = rho >> 4, i = rho & 15; return 8 * (i >> 2) + 4 * n + (i & 3); }

struct Unit { int pm, pn, z; };
struct Gemm { int K, lda, ldb; };

struct StaticOrder {
    int nM, nN, nwg, G, c; const char* A; const char* B; size_t tsA, tsB;
    __host__ __device__ void init(int M, int N, int G_, int c_, const void* A_, int lda, const void* B_, int ldb) { nM = M / BM; nN = N / BM; nwg = nM * nN; G = G_; c = c_; A = (const char*)A_; B = (const char*)B_; tsA = (size_t)BM * lda * 2; tsB = (size_t)BM * ldb * 2; }
    __device__ __forceinline__ const char* pa(const Unit& u) const { return A + (size_t)u.pm * tsA; }
    __device__ __forceinline__ const char* pb(const Unit& u) const { return B + (size_t)u.pn * tsB; }
    __host__ __device__ bool next(int i, Unit& u) const {
        const long L = (long)i * G + c; if (L >= nwg) return false;
        int wgid = (int)L; { const int q = nwg / NXCD, r = nwg % NXCD, xcd = wgid % NXCD, off = wgid / NXCD; wgid = (xcd < r ? xcd * (q + 1) : r * (q + 1) + (xcd - r) * q) + off; }
        const int nig = WGM * nN, gid = wgid / nig, fm = gid * WGM, gsz = (nM - fm) < WGM ? (nM - fm) : WGM;
        u.pm = fm + ((wgid % nig) % gsz); u.pn = (wgid % nig) / gsz; u.z = 0; return true;
    }
    __device__ __forceinline__ void a_ready(const Unit&) const {}
    __device__ __forceinline__ void done(const Unit&) const {}
};

__device__ __forceinline__ unsigned cvt_pk_bf16(float lo, float hi) { unsigned r; asm volatile("s_nop 1\n\tv_cvt_pk_bf16_f32 %0, %1, %2" : "=v"(r) : "v"(lo), "v"(hi)); return r; }
template <class Epi, class Sched, bool ALIGN_EPI = false, bool SP2 = false>
__device__ __forceinline__ void gemm_phase(PG8_LAS unsigned char* lds, const Gemm g, const Sched& S, const Epi& E) {
    const int tid = threadIdx.x, wid = __builtin_amdgcn_readfirstlane(tid >> 6), lane = tid & 63, wr = wid >> 2, wc = wid & 3, fr = lane & 15, fq = lane >> 4;
    const int K = g.K, nt = K / BK;
    unsigned voffA[2], voffB[2];
#pragma unroll
    for (int i = 0; i < 2; ++i) { int R, C; stage_rc(tid * 16 + i * 8192, R, C); const int Rb = Epi::PERM ? ((R & ~31) + perm32(R & 31)) : R;
        voffA[i] = (unsigned)(R * g.lda + C) * 2u; voffB[i] = (unsigned)(Rb * g.ldb + C) * 2u; }
    const size_t kstep = (size_t)(BK * 2);
    const size_t hstepA = (size_t)HALF * g.lda * 2, hstepB = (size_t)HALF * g.ldb * 2;
    const unsigned ldsw = (unsigned)wid * 1024u;
    const int aoff = lds_byte(wr * 64 + fr, fq * 8), boff = lds_byte(wc * 32 + fr, fq * 8);
#define PG8_SA(b, h) (((b) * 2 + (h)) * HTB)
#define PG8_SB(b, h) ((4 + (b) * 2 + (h)) * HTB)
#define PG8_STAGE(bufoff, gbase, voff) do { _Pragma("unroll") for (int _i = 0; _i < 2; ++_i) \
        __builtin_amdgcn_global_load_lds((const unsigned*)((const char*)(gbase) + (voff)[_i]), (PG8_LAS unsigned*)(lds + (bufoff) + ldsw + _i * 8192), 16, 0, 0); } while (0)
#define PG8_LDA(dst, b, h) do { _Pragma("unroll") for (int m = 0; m < 4; ++m) _Pragma("unroll") for (int k = 0; k < 2; ++k) dst[m][k] = *(const PG8_LAS bf16x8*)(lds + PG8_SA(b, h) + aoff + m * 2048 + k * 1024); } while (0)
#define PG8_LDB(dst, b, h) do { _Pragma("unroll") for (int n = 0; n < 2; ++n) _Pragma("unroll") for (int k = 0; k < 2; ++k) dst[n][k] = *(const PG8_LAS bf16x8*)(lds + PG8_SB(b, h) + boff + n * 2048 + k * 1024); } while (0)
#define PG8_MMA(ai, bj, At, Bt) do { __builtin_amdgcn_s_setprio(1); _Pragma("unroll") for (int m = 0; m < 4; ++m) _Pragma("unroll") for (int n = 0; n < 2; ++n) _Pragma("unroll") for (int k = 0; k < 2; ++k) \
        acc[ai][bj][m][n] = __builtin_amdgcn_mfma_f32_16x16x32_bf16(Bt[n][k], At[m][k], acc[ai][bj][m][n], 0, 0, 0); __builtin_amdgcn_s_setprio(0); } while (0)
#define PG8_WAIT_V(n) asm volatile("s_waitcnt vmcnt(" #n ")" ::: "memory")
#define PG8_WAIT_L(n) asm volatile("s_waitcnt lgkmcnt(" #n ")" ::: "memory")
#define PG8_BAR __builtin_amdgcn_s_barrier()
#define PG8_SCHED __builtin_amdgcn_sched_barrier(0)
    Unit cur, nxt; int ui = 0;
    if (!S.next(0, cur)) return;
    f32x4 acc[2][2][4][2];
#pragma unroll
    for (int a = 0; a < 2; ++a)
#pragma unroll
        for (int b = 0; b < 2; ++b)
#pragma unroll
            for (int m = 0; m < 4; ++m)
#pragma unroll
                for (int n = 0; n < 2; ++n) acc[a][b][m][n] = (f32x4){0.f, 0.f, 0.f, 0.f};
    bf16x8 At[4][2], B0[2][2], B1[2][2];
    const char* cA = S.pa(cur); const char* cB = S.pb(cur);
    S.a_ready(cur);
    if constexpr (SP2) {
        PG8_STAGE(PG8_SB(0, 0), cB, voffB); PG8_STAGE(PG8_SB(0, 1), cB + hstepB, voffB); PG8_STAGE(PG8_SA(0, 0), cA, voffA); PG8_STAGE(PG8_SA(0, 1), cA + hstepA, voffA);
        if (wr == 1) PG8_BAR;
        PG8_WAIT_V(2); PG8_BAR;
        PG8_STAGE(PG8_SB(1, 0), cB + kstep, voffB); PG8_STAGE(PG8_SA(1, 0), cA + kstep, voffA); PG8_STAGE(PG8_SB(1, 1), cB + hstepB + kstep, voffB);
        PG8_WAIT_V(6); PG8_BAR;
    } else {
        PG8_STAGE(PG8_SB(0, 0), cB, voffB); PG8_STAGE(PG8_SA(0, 0), cA, voffA); PG8_STAGE(PG8_SB(0, 1), cB + hstepB, voffB); PG8_STAGE(PG8_SA(0, 1), cA + hstepA, voffA);
        if (wr == 1) PG8_BAR;
        PG8_WAIT_V(4); PG8_BAR;
        PG8_STAGE(PG8_SB(1, 0), cB + kstep, voffB); PG8_STAGE(PG8_SA(1, 0), cA + kstep, voffA); PG8_STAGE(PG8_SB(1, 1), cB + hstepB + kstep, voffB);
        PG8_WAIT_V(6); PG8_BAR;
    }
    for (;;) {
        const bool has_next = S.next(ui + 1, nxt);
        const char* nA = has_next ? S.pa(nxt) : cA; const char* nB = has_next ? S.pb(nxt) : cB;
#pragma unroll 1
        for (int t = 0; t < nt; t += 2) {
            const bool last = (t == nt - 2);
            const char* a1 = cA + (size_t)(t + 1) * kstep;
            const char* a2 = last ? nA : cA + (size_t)(t + 2) * kstep; const char* b2 = last ? nB : cB + (size_t)(t + 2) * kstep;
            const char* a3 = a2 + kstep; const char* b3 = b2 + kstep;
            if (last && has_next) S.a_ready(nxt);
            if constexpr (SP2) {
            PG8_LDB(B0, 0, 0); PG8_LDB(B1, 0, 1); PG8_SCHED; PG8_LDA(At, 0, 0); PG8_STAGE(PG8_SA(1, 1), a1 + hstepA, voffA);
            PG8_WAIT_V(8); PG8_WAIT_L(0); PG8_BAR; PG8_MMA(0, 0, At, B0); PG8_MMA(0, 1, At, B1); PG8_BAR; PG8_SCHED;
            PG8_LDA(At, 0, 1); PG8_STAGE(PG8_SB(0, 0), b2, voffB); PG8_STAGE(PG8_SB(0, 1), b2 + hstepB, voffB); PG8_STAGE(PG8_SA(0, 0), a2, voffA);
            PG8_WAIT_V(8); PG8_WAIT_L(0); PG8_BAR; PG8_MMA(1, 0, At, B0); PG8_MMA(1, 1, At, B1); PG8_BAR; PG8_SCHED;
            PG8_LDB(B0, 1, 0); PG8_LDB(B1, 1, 1); PG8_SCHED; PG8_LDA(At, 1, 0); PG8_STAGE(PG8_SA(0, 1), a2 + hstepA, voffA);
            PG8_WAIT_V(8); PG8_WAIT_L(0); PG8_BAR; PG8_MMA(0, 0, At, B0); PG8_MMA(0, 1, At, B1); PG8_BAR; PG8_SCHED;
            PG8_LDA(At, 1, 1); PG8_STAGE(PG8_SB(1, 0), b3, voffB); PG8_STAGE(PG8_SB(1, 1), b3 + hstepB, voffB); PG8_STAGE(PG8_SA(1, 0), a3, voffA);
            PG8_WAIT_V(8); PG8_WAIT_L(0); PG8_BAR; PG8_MMA(1, 0, At, B0); PG8_MMA(1, 1, At, B1); PG8_BAR; PG8_SCHED;
            } else {
            PG8_LDB(B0, 0, 0); PG8_SCHED; PG8_LDA(At, 0, 0); PG8_STAGE(PG8_SA(1, 1), a1 + hstepA, voffA);
            PG8_WAIT_L(8); PG8_BAR; PG8_WAIT_L(0); PG8_MMA(0, 0, At, B0); PG8_BAR; PG8_SCHED;
            PG8_LDB(B1, 0, 1); PG8_STAGE(PG8_SB(0, 0), b2, voffB);
            PG8_BAR; PG8_WAIT_L(0); PG8_MMA(0, 1, At, B1); PG8_BAR;
            PG8_LDA(At, 0, 1); PG8_STAGE(PG8_SA(0, 0), a2, voffA);
            PG8_BAR; PG8_WAIT_L(0); PG8_MMA(1, 0, At, B0); PG8_BAR; PG8_SCHED;
            PG8_STAGE(PG8_SB(0, 1), b2 + hstepB, voffB);
            PG8_WAIT_V(6); PG8_BAR; PG8_MMA(1, 1, At, B1); PG8_BAR;
            PG8_LDB(B0, 1, 0); PG8_SCHED; PG8_LDA(At, 1, 0); PG8_STAGE(PG8_SA(0, 1), a2 + hstepA, voffA);
            PG8_WAIT_L(8); PG8_BAR; PG8_WAIT_L(0); PG8_MMA(0, 0, At, B0); PG8_BAR; PG8_SCHED;
            PG8_LDB(B1, 1, 1); PG8_STAGE(PG8_SB(1, 0), b3, voffB);
            PG8_BAR; PG8_WAIT_L(0); PG8_MMA(0, 1, At, B1); PG8_BAR;
            PG8_LDA(At, 1, 1); PG8_STAGE(PG8_SA(1, 0), a3, voffA);
            PG8_BAR; PG8_WAIT_L(0); PG8_MMA(1, 0, At, B0); PG8_BAR; PG8_SCHED;
            PG8_STAGE(PG8_SB(1, 1), b3 + hstepB, voffB);
            PG8_WAIT_V(6); PG8_BAR; PG8_MMA(1, 1, At, B1); PG8_BAR;
            }
        }
        if constexpr (ALIGN_EPI) { if (wr == 0) PG8_BAR; }
        if constexpr (!Epi::AFTER_DRAIN) { E(acc, cur, wr, wc, fr, fq); S.done(cur); }
        if (!has_next) break;
#pragma unroll
        for (int a = 0; a < 2; ++a)
#pragma unroll
            for (int b = 0; b < 2; ++b)
#pragma unroll
                for (int m = 0; m < 4; ++m)
#pragma unroll
                    for (int n = 0; n < 2; ++n) acc[a][b][m][n] = (f32x4){0.f, 0.f, 0.f, 0.f};
        cur = nxt; cA = nA; cB = nB; ++ui;
        if constexpr (ALIGN_EPI) { if (wr == 1) PG8_BAR; }
    }
    PG8_WAIT_V(0);
    if constexpr (!ALIGN_EPI) { if (wr == 0) PG8_BAR; }
    PG8_BAR;
    if constexpr (Epi::AFTER_DRAIN) { E.fused(acc, cur, wr, wc, fr, fq, lds, wid, lane); S.done(cur); }
#undef PG8_SA
#undef PG8_SB
#undef PG8_STAGE
#undef PG8_LDA
#undef PG8_LDB
#undef PG8_MMA
#undef PG8_WAIT_V
#undef PG8_WAIT_L
#undef PG8_BAR
#undef PG8_SCHED
}

template <class Epi, class Sched>
__device__ __forceinline__ void gemm_simple(PG8_LAS unsigned char* lds, const Gemm g, const Sched& S, const Epi& E) {
    const int tid = threadIdx.x, wid = __builtin_amdgcn_readfirstlane(tid >> 6), lane = tid & 63, wr = wid >> 2, wc = wid & 3, fr = lane & 15, fq = lane >> 4;
    const int nt = g.K / BK;
    unsigned voffA[2], voffB[2];
#pragma unroll
    for (int i = 0; i < 2; ++i) { int R, C; stage_rc(tid * 16 + i * 8192, R, C); const int Rb = Epi::PERM ? ((R & ~31) + perm32(R & 31)) : R;
        voffA[i] = (unsigned)(R * g.lda + C) * 2u; voffB[i] = (unsigned)(Rb * g.ldb + C) * 2u; }
    const size_t kstep = (size_t)(BK * 2), hstepA = (size_t)HALF * g.lda * 2, hstepB = (size_t)HALF * g.ldb * 2;
    const unsigned ldst = (unsigned)tid * 16u;
    const int aoff = lds_byte(wr * 64 + fr, fq * 8), boff = lds_byte(wc * 32 + fr, fq * 8);
#define SG_SA(b, h) (((b) * 2 + (h)) * HTB)
#define SG_SB(b, h) ((4 + (b) * 2 + (h)) * HTB)
#define SG_LDB(dst, b, h) do { _Pragma("unroll") for (int n = 0; n < 2; ++n) _Pragma("unroll") for (int k = 0; k < 2; ++k) dst[n][k] = *(const PG8_LAS bf16x8*)(lds + SG_SB(b, h) + boff + n * 2048 + k * 1024); } while (0)
#define SG_AFRAG(b, st, k) (*(const PG8_LAS bf16x8*)(lds + SG_SA(b, (st) >> 2) + aoff + ((st) & 3) * 2048 + (k) * 1024))
#define SG_AHALF(b, ai) do { bf16x8 c0 = SG_AFRAG(b, (ai) * 4, 0), c1 = SG_AFRAG(b, (ai) * 4, 1); \
        _Pragma("unroll") for (int m = 0; m < 4; ++m) { bf16x8 n0 = c0, n1 = c1; \
            if (m < 3) { n0 = SG_AFRAG(b, (ai) * 4 + m + 1, 0); n1 = SG_AFRAG(b, (ai) * 4 + m + 1, 1); } \
            __builtin_amdgcn_sched_barrier(0); \
            _Pragma("unroll") for (int n = 0; n < 2; ++n) { \
                acc[ai][0][m][n] = __builtin_amdgcn_mfma_f32_16x16x32_bf16(B0[n][0], c0, acc[ai][0][m][n], 0, 0, 0); acc[ai][0][m][n] = __builtin_amdgcn_mfma_f32_16x16x32_bf16(B0[n][1], c1, acc[ai][0][m][n], 0, 0, 0); \
                acc[ai][1][m][n] = __builtin_amdgcn_mfma_f32_16x16x32_bf16(B1[n][0], c0, acc[ai][1][m][n], 0, 0, 0); acc[ai][1][m][n] = __builtin_amdgcn_mfma_f32_16x16x32_bf16(B1[n][1], c1, acc[ai][1][m][n], 0, 0, 0); } \
            __builtin_amdgcn_sched_barrier(0); c0 = n0; c1 = n1; } } while (0)
#define SG_LOADA(t) do { _Pragma("unroll") for (int h = 0; h < 2; ++h) _Pragma("unroll") for (int i = 0; i < 2; ++i) rr[h][i] = *(const u32x4*)(cA + h * hstepA + (size_t)(t) * kstep + voffA[i]); } while (0)
#define SG_LOADB(t) do { _Pragma("unroll") for (int h = 0; h < 2; ++h) _Pragma("unroll") for (int i = 0; i < 2; ++i) rr[h][i] = *(const u32x4*)(cB + h * hstepB + (size_t)(t) * kstep + voffB[i]); } while (0)
#define SG_STOREA(b) do { _Pragma("unroll") for (int h = 0; h < 2; ++h) _Pragma("unroll") for (int i = 0; i < 2; ++i) *(PG8_LAS u32x4*)(lds + SG_SA(b, h) + i * 8192 + ldst) = rr[h][i]; } while (0)
#define SG_STOREB(b) do { _Pragma("unroll") for (int h = 0; h < 2; ++h) _Pragma("unroll") for (int i = 0; i < 2; ++i) *(PG8_LAS u32x4*)(lds + SG_SB(b, h) + i * 8192 + ldst) = rr[h][i]; } while (0)
#define SG_KTILE(b, tn, more) do { bf16x8 B0[2][2], B1[2][2]; if (more) SG_LOADA(tn); SG_LDB(B0, b, 0); SG_LDB(B1, b, 1); SG_AHALF(b, 0); \
        if (more) { SG_STOREA((b) ^ 1); SG_LOADB(tn); } SG_AHALF(b, 1); if (more) SG_STOREB((b) ^ 1); __syncthreads(); } while (0)
    Unit cur;
    for (int ui = 0; S.next(ui, cur); ++ui) {
        f32x4 acc[2][2][4][2];
#pragma unroll
        for (int a = 0; a < 2; ++a)
#pragma unroll
            for (int b = 0; b < 2; ++b)
#pragma unroll
                for (int m = 0; m < 4; ++m)
#pragma unroll
                    for (int n = 0; n < 2; ++n) acc[a][b][m][n] = (f32x4){0.f, 0.f, 0.f, 0.f};
        const char* cA = S.pa(cur); const char* cB = S.pb(cur);
        u32x4 rr[2][2];
        __syncthreads();
        SG_LOADA(0); SG_STOREA(0); SG_LOADB(0); SG_STOREB(0);
        __syncthreads();
#pragma unroll 1
        for (int t = 0; t < nt; t += 2) {
            SG_KTILE(0, t + 1, true);
            const bool more = (t + 2 < nt);
            SG_KTILE(1, t + 2, more);
        }
        E(acc, cur, wr, wc, fr, fq);
    }
#undef SG_SA
#undef SG_SB
#undef SG_LDB
#undef SG_AFRAG
#undef SG_AHALF
#undef SG_LOADA
#undef SG_LOADB
#undef SG_STOREA
#undef SG_STOREB
#undef SG_KTILE
}
}

constexpr int BATCH = 4, SEQ = 4096, D = 1024, M = BATCH * SEQ;
constexpr int CW = 512, CK = 31, SW = 512, NG = 32, SP = 64, FH = 2816, INC = 3584, NMOD6 = 6 * D;
constexpr int LC = 16, NCH = M / LC, CPB = SEQ / LC, KA2 = 384;
constexpr float EPS = 1e-6f;
constexpr int NWAVES = 8, NTHR = 512;
constexpr int NPHASE = 8;

constexpr size_t MiB = 1u << 20;
constexpr size_t WS_CTL = 0, CTL_ZERO_BYTES = 1 * MiB;
constexpr size_t WS_BAR = 512 * 1024, WS_PCNT = 512 * 1024 + 16384, WS_GCNT = 512 * 1024 + 32768, BAR_BYTES = 32768 + 256;
constexpr size_t WS_MOD = 0, WS_RSS1 = 30 * MiB, WS_RSS2 = 31 * MiB;
constexpr size_t WS_WIN = 1 * MiB, WS_WCP = 8 * MiB, WS_WGLU = 9 * MiB, WS_WOUT = 11 * MiB, WS_WFI = 13 * MiB, WS_WFO = 24 * MiB;
constexpr size_t WS_SHW = 29 * MiB + 512 * 1024;
constexpr size_t WS_W1 = 30 * MiB, WS_B2 = 34 * MiB;
constexpr size_t WS_H1 = 40 * MiB;
constexpr size_t WS_UCONV = 72 * MiB, WS_A2S = 88 * MiB, WS_SGC = 112 * MiB, WS_SGS = 144 * MiB, WS_ACONV = 176 * MiB, WS_ASSM = 192 * MiB, WS_S = 208 * MiB, WS_MERGED = 224 * MiB;
constexpr size_t WS_X1B = 72 * MiB;
constexpr size_t WS_HID = 136 * MiB;
constexpr size_t WS_END = 256 * MiB;
static_assert(WS_HID + (size_t)M * FH * 2 <= WS_MERGED && WS_WFO + (size_t)D * FH * 2 <= WS_SHW && WS_B2 + (size_t)NG * 256 * KA2 * 2 <= WS_H1, "ws map");

constexpr int RING_BYTES = 131072, LDS_BYTES = 147456;

#define GAS __attribute__((address_space(1)))
#define LAS __attribute__((address_space(3)))
typedef unsigned short bf16;
typedef unsigned v4u __attribute__((ext_vector_type(4)));
typedef unsigned v2u __attribute__((ext_vector_type(2)));
typedef float f32x4 __attribute__((ext_vector_type(4)));
typedef float f32x2 __attribute__((ext_vector_type(2)));
using pg8::cvt_pk_bf16;
__device__ __forceinline__ float bf_lo(unsigned w) { return __uint_as_float(w << 16); }
__device__ __forceinline__ float bf_hi(unsigned w) { return __uint_as_float(w & 0xffff0000u); }
__device__ __forceinline__ float sigm(float x) { return __builtin_amdgcn_rcpf(1.0f + __expf(-x)); }
__device__ __forceinline__ float silu_f(float x) { return x * sigm(x); }
__device__ __forceinline__ float gelu_tanh(float x) { return x * sigm(1.5957691216057308f * (x + 0.044715f * x * x * x)); }
__device__ __forceinline__ float wave_sum(float v) {
#pragma unroll
    for (int o = 1; o < 64; o <<= 1) v += __shfl_xor(v, o);
    return v;
}
__device__ __forceinline__ v4u pack8(const f32x4 a, const f32x4 b) { v4u w; w.x = cvt_pk_bf16(a[0], a[1]); w.y = cvt_pk_bf16(a[2], a[3]); w.z = cvt_pk_bf16(b[0], b[1]); w.w = cvt_pk_bf16(b[2], b[3]); return w; }
__device__ __forceinline__ void unpack8(const v4u w, f32x4& a, f32x4& b) { a = (f32x4){bf_lo(w.x), bf_hi(w.x), bf_lo(w.y), bf_hi(w.y)}; b = (f32x4){bf_lo(w.z), bf_hi(w.z), bf_lo(w.w), bf_hi(w.w)}; }

struct BatchOrder {
    int nM, nwg, G, c; const char* A; const char* B; size_t zsA, tsA, zsB;
    __device__ __forceinline__ bool next(int i, pg8::Unit& u) const { const int L = i * G + c; if (L >= nwg) return false; u.z = L / nM; u.pm = L % nM; u.pn = 0; return true; }
    __device__ __forceinline__ const char* pa(const pg8::Unit& u) const { return A + (size_t)u.z * zsA + (size_t)u.pm * tsA; }
    __device__ __forceinline__ const char* pb(const pg8::Unit& u) const { return B + (size_t)u.z * zsB; }
    __device__ __forceinline__ void a_ready(const pg8::Unit&) const {}
    __device__ __forceinline__ void done(const pg8::Unit&) const {}
};

#define EPI_HEAD static constexpr bool PERM = true, AFTER_DRAIN = false
typedef f32x4 AccT[2][2][4][2];

struct EpiIn {
    EPI_HEAD; bf16* uconv; bf16* a2s; bf16* sgc; bf16* sgs;
    __device__ __forceinline__ void operator()(const AccT& acc, const pg8::Unit& u, int wr, int wc, int fr, int fq) const {
        const int row0 = u.pm * 256 + wr * 64 + fr;
        if (u.pn < 4) {
            const int col = u.pn * 128 + wc * 32 + 8 * fq;
#pragma unroll
            for (int ai = 0; ai < 2; ++ai)
#pragma unroll
                for (int m = 0; m < 4; ++m) { const int row = row0 + ai * 128 + m * 16; f32x4 o0, o1;
#pragma unroll
                    for (int e = 0; e < 4; ++e) { o0[e] = acc[ai][0][m][0][e] * sigm(acc[ai][1][m][0][e]); o1[e] = acc[ai][0][m][1][e] * sigm(acc[ai][1][m][1][e]); }
                    *(v4u*)(uconv + (size_t)row * CW + col) = pack8(o0, o1); }
        } else if (u.pn < 6) {
#pragma unroll
            for (int bj = 0; bj < 2; ++bj) { const int cc = (u.pn - 4) * 256 + bj * 128 + wc * 32 + 8 * fq, g = cc >> 4, h0 = cc & 15;
#pragma unroll
                for (int ai = 0; ai < 2; ++ai)
#pragma unroll
                    for (int m = 0; m < 4; ++m) { const int row = row0 + ai * 128 + m * 16;
                        *(v4u*)(a2s + ((size_t)(g * NCH + (row >> 4)) * KA2 + (row & 15) * 16 + h0)) = pack8(acc[ai][bj][m][0], acc[ai][bj][m][1]); } }
        } else {
#pragma unroll
            for (int bj = 0; bj < 2; ++bj) { const int gc = (u.pn - 6) * 256 + bj * 128 + wc * 32 + 8 * fq; bf16* dst = gc < D ? sgc + gc : sgs + (gc - D);
#pragma unroll
                for (int ai = 0; ai < 2; ++ai)
#pragma unroll
                    for (int m = 0; m < 4; ++m) { const int row = row0 + ai * 128 + m * 16; f32x4 o0, o1;
#pragma unroll
                        for (int e = 0; e < 4; ++e) { o0[e] = sigm(acc[ai][bj][m][0][e]); o1[e] = sigm(acc[ai][bj][m][1][e]); }
                        *(v4u*)(dst + (size_t)row * D) = pack8(o0, o1); } }
        }
    }
};
struct EpiState {
    EPI_HEAD; float* S;
    __device__ __forceinline__ void operator()(const AccT& acc, const pg8::Unit& u, int wr, int wc, int fr, int fq) const {
        const int col = wc * 32 + 8 * fq;
#pragma unroll
        for (int ai = 0; ai < 2; ++ai)
#pragma unroll
            for (int m = 0; m < 4; ++m) { const int rr = u.pm * 256 + ai * 128 + wr * 64 + m * 16 + fr; float* p = S + ((size_t)(u.z * NCH + rr)) * 128 + col;
                *(f32x4*)p = acc[ai][0][m][0]; *(f32x4*)(p + 4) = acc[ai][0][m][1]; }
    }
};
struct EpiSsmOut {
    EPI_HEAD; const bf16* a2s; const float* dvec; bf16* assm;
    __device__ __forceinline__ void operator()(const AccT& acc, const pg8::Unit& u, int wr, int wc, int fr, int fq) const {
        const int g = u.z; asm volatile("" : "+v"(fq), "+v"(fr));
#pragma unroll
        for (int bj = 0; bj < 2; ++bj) { const int c = bj * 128 + wc * 32 + 8 * fq, t = c >> 4, h0 = c & 15;
            const f32x4 d0 = *(const f32x4*)(dvec + g * 16 + h0), d1 = *(const f32x4*)(dvec + g * 16 + h0 + 4);
            v4u uu[2][4];
#pragma unroll
            for (int ai = 0; ai < 2; ++ai)
#pragma unroll
                for (int m = 0; m < 4; ++m) uu[ai][m] = *(const v4u*)(a2s + ((size_t)(g * NCH + u.pm * 256 + ai * 128 + wr * 64 + m * 16 + fr) * KA2 + c));
#pragma unroll
            for (int ai = 0; ai < 2; ++ai)
#pragma unroll
                for (int m = 0; m < 4; ++m) { const int rr = u.pm * 256 + ai * 128 + wr * 64 + m * 16 + fr;
                    f32x4 u0, u1; unpack8(uu[ai][m], u0, u1);
                    f32x4 y0 = acc[ai][bj][m][0] + d0 * u0, y1 = acc[ai][bj][m][1] + d1 * u1;
#pragma unroll
                    for (int e = 0; e < 4; ++e) { y0[e] = gelu_tanh(y0[e]); y1[e] = gelu_tanh(y1[e]); }
                    *(v4u*)(assm + ((size_t)(rr * LC + t) * SW + g * 16 + h0)) = pack8(y0, y1); }
            asm volatile("" ::: "memory"); }
    }
};
struct EpiConvProj {
    EPI_HEAD; const bf16* sgc; bf16* mg;
    __device__ __forceinline__ void operator()(const AccT& acc, const pg8::Unit& u, int wr, int wc, int fr, int fq) const {
#pragma unroll
        for (int bj = 0; bj < 2; ++bj) { const int col = u.pn * 256 + bj * 128 + wc * 32 + 8 * fq;
            v4u gg[2][4];
#pragma unroll
            for (int ai = 0; ai < 2; ++ai)
#pragma unroll
                for (int m = 0; m < 4; ++m) gg[ai][m] = *(const v4u*)(sgc + (size_t)(u.pm * 256 + ai * 128 + wr * 64 + m * 16 + fr) * D + col);
#pragma unroll
            for (int ai = 0; ai < 2; ++ai)
#pragma unroll
                for (int m = 0; m < 4; ++m) { const size_t off = (size_t)(u.pm * 256 + ai * 128 + wr * 64 + m * 16 + fr) * D + col;
                    f32x4 g0, g1; unpack8(gg[ai][m], g0, g1);
                    *(v4u*)(mg + off) = pack8(g0 * acc[ai][bj][m][0], g1 * acc[ai][bj][m][1]); }
            asm volatile("" ::: "memory"); }
    }
};
struct EpiSsmGlu {
    EPI_HEAD; const bf16* sgs; bf16* mg;
    __device__ __forceinline__ void operator()(const AccT& acc, const pg8::Unit& u, int wr, int wc, int fr, int fq) const {
        const int col = u.pn * 128 + wc * 32 + 8 * fq;
#pragma unroll
        for (int ai = 0; ai < 2; ++ai) {
            v4u gg[4], pp[4];
#pragma unroll
            for (int m = 0; m < 4; ++m) { const size_t off = (size_t)(u.pm * 256 + ai * 128 + wr * 64 + m * 16 + fr) * D + col; gg[m] = *(const v4u*)(sgs + off); pp[m] = *(const v4u*)(mg + off); }
#pragma unroll
            for (int m = 0; m < 4; ++m) { const size_t off = (size_t)(u.pm * 256 + ai * 128 + wr * 64 + m * 16 + fr) * D + col;
                f32x4 g0, g1, p0, p1; unpack8(gg[m], g0, g1); unpack8(pp[m], p0, p1);
#pragma unroll
                for (int e = 0; e < 4; ++e) { p0[e] += g0[e] * acc[ai][0][m][0][e] * sigm(acc[ai][1][m][0][e]); p1[e] += g1[e] * acc[ai][0][m][1][e] * sigm(acc[ai][1][m][1][e]); }
                *(v4u*)(mg + off) = pack8(p0, p1); }
            asm volatile("" ::: "memory"); }
    }
};
struct EpiOut {
    EPI_HEAD; const float* x; const float* mod; const float* n2g; bf16* x1; bf16* a2; float* rss;
    __device__ __forceinline__ void operator()(const AccT& acc, const pg8::Unit& u, int wr, int wc, int fr, int fq) const {
        const float* mb = mod + (u.pm >> 4) * NMOD6;
        float ss[2][4];
#pragma unroll
        for (int ai = 0; ai < 2; ++ai)
#pragma unroll
            for (int m = 0; m < 4; ++m) ss[ai][m] = 0.f;
#pragma unroll
        for (int bj = 0; bj < 2; ++bj) { const int col = u.pn * 256 + bj * 128 + wc * 32 + 8 * fq;
            const f32x4 gv0 = *(const f32x4*)(mb + 2 * D + col), gv1 = *(const f32x4*)(mb + 2 * D + col + 4);
            const f32x4 cs0 = *(const f32x4*)(n2g + col) * (*(const f32x4*)(mb + 4 * D + col) + 1.0f), cs1 = *(const f32x4*)(n2g + col + 4) * (*(const f32x4*)(mb + 4 * D + col + 4) + 1.0f);
#pragma unroll
            for (int ai = 0; ai < 2; ++ai) {
                f32x4 xx[4][2];
#pragma unroll
                for (int m = 0; m < 4; ++m) { const size_t off = (size_t)(u.pm * 256 + ai * 128 + wr * 64 + m * 16 + fr) * D + col;
                    xx[m][0] = __builtin_nontemporal_load((const f32x4*)(x + off)); xx[m][1] = __builtin_nontemporal_load((const f32x4*)(x + off + 4)); }
#pragma unroll
                for (int m = 0; m < 4; ++m) { const size_t off = (size_t)(u.pm * 256 + ai * 128 + wr * 64 + m * 16 + fr) * D + col;
                    const f32x4 v0 = xx[m][0] + gv0 * acc[ai][bj][m][0], v1 = xx[m][1] + gv1 * acc[ai][bj][m][1];
                    *(v4u*)(a2 + off) = pack8(v0 * cs0, v1 * cs1);
                    ss[ai][m] += (v0[0] * v0[0] + v0[1] * v0[1]) + (v0[2] * v0[2] + v0[3] * v0[3]) + (v1[0] * v1[0] + v1[1] * v1[1]) + (v1[2] * v1[2] + v1[3] * v1[3]); }
                asm volatile("" ::: "memory"); } }
#pragma unroll
        for (int ai = 0; ai < 2; ++ai)
#pragma unroll
            for (int m = 0; m < 4; ++m) { float t = ss[ai][m]; t += __shfl_xor(t, 16); t += __shfl_xor(t, 32);
                if (fq == 0) rss[(u.pm * 256 + ai * 128 + wr * 64 + m * 16 + fr) * 16 + u.pn * 4 + wc] = t; }
    }
};
struct EpiFfnIn {
    EPI_HEAD; const float* rss; const float* shw; bf16* hid;
    __device__ __forceinline__ void operator()(const AccT& acc, const pg8::Unit& u, int wr, int wc, int fr, int fq) const {
        const float* sb = shw + (u.pm >> 4) * (2 * FH) + u.pn * 256 + wc * 32 + 8 * fq;
        const f32x4 sg0 = *(const f32x4*)sb, sg1 = *(const f32x4*)(sb + 4), su0 = *(const f32x4*)(sb + 128), su1 = *(const f32x4*)(sb + 132);
        f32x4 qq[2][4];
#pragma unroll
        for (int ai = 0; ai < 2; ++ai)
#pragma unroll
            for (int m = 0; m < 4; ++m) qq[ai][m] = *(const f32x4*)(rss + (u.pm * 256 + ai * 128 + wr * 64 + m * 16 + fr) * 16 + 4 * fq);
#pragma unroll
        for (int ai = 0; ai < 2; ++ai)
#pragma unroll
            for (int m = 0; m < 4; ++m) { const int row = u.pm * 256 + ai * 128 + wr * 64 + m * 16 + fr;
                float t = (qq[ai][m][0] + qq[ai][m][1]) + (qq[ai][m][2] + qq[ai][m][3]); t += __shfl_xor(t, 16); t += __shfl_xor(t, 32);
                const float inv = rsqrtf(t * (1.0f / D) + EPS);
                const f32x4 g0 = acc[ai][0][m][0] * inv + sg0, g1 = acc[ai][0][m][1] * inv + sg1, u0 = acc[ai][1][m][0] * inv + su0, u1 = acc[ai][1][m][1] * inv + su1; f32x4 o0, o1;
#pragma unroll
                for (int e = 0; e < 4; ++e) { o0[e] = silu_f(g0[e]) * u0[e]; o1[e] = silu_f(g1[e]) * u1[e]; }
                *(v4u*)(hid + (size_t)row * FH + u.pn * 128 + wc * 32 + 8 * fq) = pack8(o0, o1); }
    }
};
struct EpiFfnOut {
    EPI_HEAD; const float* mod; const float* fg; const float* n2g; const bf16* x1; float* xo; float* rss; unsigned* cnt;
    __device__ __forceinline__ void operator()(AccT& acc, const pg8::Unit& u, int wr, int wc, int fr, int fq) const {
        const float* mb = mod + (u.pm >> 4) * NMOD6;
        {
            f32x4 gv[2][2], rc[2][2];
#pragma unroll
            for (int bj = 0; bj < 2; ++bj)
#pragma unroll
                for (int n = 0; n < 2; ++n) { const int col = u.pn * 256 + bj * 128 + wc * 32 + 8 * fq + 4 * n; gv[bj][n] = *(const f32x4*)(mb + 5 * D + col);
                    const f32x4 cs = *(const f32x4*)(n2g + col) * (*(const f32x4*)(mb + 4 * D + col) + 1.0f); rc[bj][n] = (f32x4){1.0f / cs[0], 1.0f / cs[1], 1.0f / cs[2], 1.0f / cs[3]}; }
#pragma unroll
            for (int ai = 0; ai < 2; ++ai)
#pragma unroll
                for (int m = 0; m < 4; ++m) { const int row = u.pm * 256 + ai * 128 + wr * 64 + m * 16 + fr; float ss = 0.f;
#pragma unroll
                    for (int bj = 0; bj < 2; ++bj) { const size_t off = (size_t)row * D + u.pn * 256 + bj * 128 + wc * 32 + 8 * fq;
                        f32x4 r0, r1; unpack8(*(const v4u*)(x1 + off), r0, r1);
                        const f32x4 v0 = r0 * rc[bj][0] + gv[bj][0] * acc[ai][bj][m][0], v1 = r1 * rc[bj][1] + gv[bj][1] * acc[ai][bj][m][1];
                        acc[ai][bj][m][0] = v0; acc[ai][bj][m][1] = v1;
                        ss += (v0[0] * v0[0] + v0[1] * v0[1]) + (v0[2] * v0[2] + v0[3] * v0[3]) + (v1[0] * v1[0] + v1[1] * v1[1]) + (v1[2] * v1[2] + v1[3] * v1[3]); }
                    ss += __shfl_xor(ss, 16); ss += __shfl_xor(ss, 32);
                    if (fq == 0) __hip_atomic_store(rss + row * 16 + u.pn * 4 + wc, ss, __ATOMIC_RELAXED, __HIP_MEMORY_SCOPE_AGENT); }
        }
        asm volatile("s_waitcnt vmcnt(0)" ::: "memory");
        unsigned* cw = cnt + 64 * u.pm;
        if (fr == 0 && fq == 0) __hip_atomic_fetch_add(cw, 1u, __ATOMIC_RELAXED, __HIP_MEMORY_SCOPE_AGENT);
        { unsigned sp = 0; while ((unsigned)__builtin_amdgcn_readfirstlane(__hip_atomic_load(cw, __ATOMIC_RELAXED, __HIP_MEMORY_SCOPE_AGENT)) < 32u) { __builtin_amdgcn_s_sleep(2); if (++sp > (1u << 22)) break; } }
        __builtin_amdgcn_fence(__ATOMIC_ACQUIRE, "agent");
        asm volatile("s_waitcnt vmcnt(0)" ::: "memory");
        f32x4 fv[2][2];
#pragma unroll
        for (int bj = 0; bj < 2; ++bj)
#pragma unroll
            for (int n = 0; n < 2; ++n) fv[bj][n] = *(const f32x4*)(fg + u.pn * 256 + bj * 128 + wc * 32 + 8 * fq + 4 * n);
#pragma unroll
        for (int ai = 0; ai < 2; ++ai)
#pragma unroll
            for (int m = 0; m < 4; ++m) { const int row = u.pm * 256 + ai * 128 + wr * 64 + m * 16 + fr;
                const unsigned long long* pp = (const unsigned long long*)(rss + row * 16 + 4 * fq);
                const unsigned long long w0 = __hip_atomic_load(pp, __ATOMIC_RELAXED, __HIP_MEMORY_SCOPE_AGENT), w1 = __hip_atomic_load(pp + 1, __ATOMIC_RELAXED, __HIP_MEMORY_SCOPE_AGENT);
                float t = (__uint_as_float((unsigned)w0) + __uint_as_float((unsigned)(w0 >> 32))) + (__uint_as_float((unsigned)w1) + __uint_as_float((unsigned)(w1 >> 32)));
                t += __shfl_xor(t, 16); t += __shfl_xor(t, 32);
                const float inv = rsqrtf(t * (1.0f / D) + EPS);
#pragma unroll
                for (int bj = 0; bj < 2; ++bj) { const size_t off = (size_t)row * D + u.pn * 256 + bj * 128 + wc * 32 + 8 * fq;
                    __builtin_nontemporal_store(acc[ai][bj][m][0] * inv * fv[bj][0], (f32x4*)(xo + off)); __builtin_nontemporal_store(acc[ai][bj][m][1] * inv * fv[bj][1], (f32x4*)(xo + off + 4)); } }
    }
};

struct TripleOrder {
    pg8::StaticOrder base; const char* A1; const char* B1; size_t tsA, tsB;
    __device__ __forceinline__ bool next(int i, pg8::Unit& u) const { pg8::Unit t; if (!base.next(i / 3, t)) return false; const int sub = i % 3; u.pm = t.pm;
        if (sub == 0) { u.pn = t.pn; u.z = 0; } else { u.pn = 2 * t.pn + (sub - 1); u.z = 1; } return true; }
    __device__ __forceinline__ const char* pa(const pg8::Unit& u) const { return u.z ? A1 + (size_t)u.pm * tsA : base.pa(u); }
    __device__ __forceinline__ const char* pb(const pg8::Unit& u) const { return u.z ? B1 + (size_t)u.pn * tsB : base.pb(u); }
    __device__ __forceinline__ void a_ready(const pg8::Unit&) const {}
    __device__ __forceinline__ void done(const pg8::Unit&) const {}
};
struct EpiMix {
    EPI_HEAD; const bf16* sgc; const bf16* sgs; bf16* mg;
    __device__ __forceinline__ void operator()(const AccT& acc, const pg8::Unit& u, int wr, int wc, int fr, int fq) const {
        if (u.z == 0) { const EpiConvProj e{sgc, mg}; e(acc, u, wr, wc, fr, fq); } else { const EpiSsmGlu e{sgs, mg}; e(acc, u, wr, wc, fr, fq); }
    }
};

__device__ __forceinline__ int ileave(int n0, int half) { return n0 < half ? 256 * (n0 >> 7) + (n0 & 127) : 256 * ((n0 - half) >> 7) + 128 + ((n0 - half) & 127); }
__device__ __forceinline__ void transpose_item(const float* W, int K, int N, bf16* WT, int mode, LAS float* scr, int item, int lane) {
    const int nblk = N / 32, kb = item / nblk, nb = item % nblk, k0 = 64 * kb, n0 = 32 * nb;
    int r0 = n0;
    if (mode == 1) r0 = n0 < 1024 ? ileave(n0, 512) : n0;
    else if (mode == 2) r0 = ileave(n0, 1024);
    else if (mode == 3) r0 = ileave(n0, FH);
    float tv[32];
#pragma unroll
    for (int i = 0; i < 32; ++i) tv[i] = __builtin_nontemporal_load(W + (size_t)(k0 + 2 * i + (lane >> 5)) * N + n0 + (lane & 31));
#pragma unroll
    for (int i = 0; i < 32; ++i) scr[(2 * i + (lane >> 5)) * 33 + (lane & 31)] = tv[i];
    asm volatile("s_waitcnt lgkmcnt(0)" ::: "memory");
    const int c = lane & 7;
#pragma unroll
    for (int j = 0; j < 4; ++j) { const int n = (lane >> 3) + 8 * j; const LAS float* s = scr + (8 * c) * 33 + n;
        v4u o; o.x = cvt_pk_bf16(s[0 * 33], s[1 * 33]); o.y = cvt_pk_bf16(s[2 * 33], s[3 * 33]); o.z = cvt_pk_bf16(s[4 * 33], s[5 * 33]); o.w = cvt_pk_bf16(s[6 * 33], s[7 * 33]);
        *(v4u*)(WT + (size_t)(r0 + n) * K + k0 + 8 * c) = o; }
    asm volatile("s_waitcnt lgkmcnt(0)" ::: "memory");
}
__device__ __forceinline__ void sincos_d(double x, double& s, double& c) {
    const double k = rint(x * 0.63661977236758134308);
    double r = fma(-k, 1.57079632679489655800e+00, x); r = fma(-k, 6.12323399573676603587e-17, r);
    const int q = ((int)k) & 3; const double r2 = r * r;
    double sp = -1.0 / 1307674368000.0; sp = fma(sp, r2, 1.0 / 6227020800.0); sp = fma(sp, r2, -1.0 / 39916800.0); sp = fma(sp, r2, 1.0 / 362880.0); sp = fma(sp, r2, -1.0 / 5040.0); sp = fma(sp, r2, 1.0 / 120.0); sp = fma(sp, r2, -1.0 / 6.0); sp = fma(sp * r2, r, r);
    double cp = 1.0 / 20922789888000.0; cp = fma(cp, r2, -1.0 / 87178291200.0); cp = fma(cp, r2, 1.0 / 479001600.0); cp = fma(cp, r2, -1.0 / 3628800.0); cp = fma(cp, r2, 1.0 / 40320.0); cp = fma(cp, r2, -1.0 / 720.0); cp = fma(cp, r2, 1.0 / 24.0); cp = fma(cp, r2, -0.5); cp = fma(cp, r2, 1.0);
    s = (q == 0) ? sp : (q == 1) ? cp : (q == 2) ? -sp : -cp;
    c = (q == 0) ? cp : (q == 1) ? -sp : (q == 2) ? -cp : sp;
}
__device__ __forceinline__ void ssm_abar(const float* a_re, const float* a_im, const float* log_dt, int g, int p, double& er, double& ei, double& ar, double& ai) {
    const double dt = (double)expf(log_dt[g]); ar = (double)a_re[g * SP + p]; ai = (double)a_im[g * SP + p];
    const double x = dt * ar;
    double mag = 1.0 / 362880.0; mag = fma(mag, x, 1.0 / 40320.0); mag = fma(mag, x, 1.0 / 5040.0); mag = fma(mag, x, 1.0 / 720.0); mag = fma(mag, x, 1.0 / 120.0); mag = fma(mag, x, 1.0 / 24.0); mag = fma(mag, x, 1.0 / 6.0); mag = fma(mag, x, 0.5); mag = fma(mag, x, 1.0); mag = fma(mag, x, 1.0);
    double s, c; sincos_d(dt * ai, s, c); er = mag * c; ei = mag * s;
}

#define XB_TMO      128
#define XB_XCNT(j)  (256  + 64 * (j))
#define XB_XSUB(j)  (1280 + 64 * (j))
#define XB_XGEN(j)  (2304 + 64 * (j))
#define XB_TOP      3328
#define XB_TOPGEN   3392
#define XCD_BAR_WORDS 3456
#define XB_SPIN_CAP (1u << 18)

__device__ __forceinline__ unsigned xb_ld(unsigned* p)              { return __hip_atomic_load(p, __ATOMIC_RELAXED, __HIP_MEMORY_SCOPE_AGENT); }
__device__ __forceinline__ unsigned xb_add(unsigned* p, unsigned v) { return __hip_atomic_fetch_add(p, v, __ATOMIC_RELAXED, __HIP_MEMORY_SCOPE_AGENT); }
__device__ __forceinline__ unsigned xb_xcc_id() { return (unsigned)__builtin_amdgcn_s_getreg((3 << 11) | 20) & 0xFu; }
#define XB_SPIN(cond, bar) do { unsigned _sp = 0; while (cond) { __builtin_amdgcn_s_sleep(1); \
    if ((++_sp & 255u) == 0u) { if (xb_ld(&(bar)[XB_TMO])) break; if (_sp > XB_SPIN_CAP) { atomicAdd(&(bar)[XB_TMO], 1u); break; } } } } while (0)

struct XcdBarrier {
    unsigned* bar; unsigned x;
    volatile LAS unsigned* st;
};

__device__ __forceinline__ XcdBarrier xcd_barrier_post(unsigned* bar, volatile LAS unsigned* st) {
    XcdBarrier b; b.bar = bar; b.x = xb_xcc_id(); b.st = st;
    if (threadIdx.x == 0) (void)xb_add(&bar[XB_XCNT(b.x)], 1u);
    return b;
}
__device__ __forceinline__ void xcd_barrier_complete(unsigned* bar, unsigned x, unsigned& nloc, unsigned& nx) {
    const unsigned G = gridDim.x * gridDim.y * gridDim.z;
    unsigned sum, cnt, mine, sp = 0u;
    for (;;) {
        sum = 0u; cnt = 0u; mine = 0u;
#pragma unroll
        for (unsigned j = 0; j < 16; ++j) { const unsigned c = xb_ld(&bar[XB_XCNT(j)]); sum += c; cnt += (c > 0u) ? 1u : 0u; mine = (j == x) ? c : mine; }
        if (sum == G) break;
        __builtin_amdgcn_s_sleep(1);
        if ((++sp & 255u) == 0u) { if (xb_ld(&bar[XB_TMO])) break; if (sp > XB_SPIN_CAP) { atomicAdd(&bar[XB_TMO], 1u); break; } }
    }
    nloc = mine > 0u ? mine : 1u; nx = cnt > 0u ? cnt : 1u;
}

__device__ __forceinline__ void xcd_barrier(const XcdBarrier& b) {
    asm volatile("s_waitcnt vmcnt(0)" ::: "memory");
    __syncthreads();
    if (threadIdx.x == 0) {
        unsigned* bar = b.bar;
        __builtin_amdgcn_s_waitcnt(0);
        unsigned nloc = b.st[0], nx = b.st[1];
        if (nloc == 0u) { xcd_barrier_complete(bar, b.x, nloc, nx); b.st[0] = nloc; b.st[1] = nx; }
        const unsigned old = xb_add(&bar[XB_XSUB(b.x)], 1u);
        const unsigned gen = old / nloc;
        if (old + 1u == (gen + 1u) * nloc) {
            __builtin_amdgcn_fence(__ATOMIC_RELEASE, "agent");
            asm volatile("s_waitcnt vmcnt(0)" ::: "memory");
            const unsigned og = xb_add(&bar[XB_TOP], 1u);
            const unsigned tg = og / nx;
            if (og + 1u == (tg + 1u) * nx) xb_add(&bar[XB_TOPGEN], 1u);
            else XB_SPIN(xb_ld(&bar[XB_TOPGEN]) == tg, bar);
            __builtin_amdgcn_fence(__ATOMIC_ACQUIRE, "agent");
            xb_add(&bar[XB_XGEN(b.x)], 1u);
            asm volatile("s_waitcnt vmcnt(0)" ::: "memory");
        } else {
            XB_SPIN(xb_ld(&bar[XB_TOPGEN]) == gen, bar);
            __builtin_amdgcn_fence(__ATOMIC_ACQUIRE, "agent");
            asm volatile("s_waitcnt vmcnt(0)" ::: "memory");
        }
    }
    __syncthreads();
}

struct Args { const float* in[25]; float* out; unsigned char* ws; int ph_lo, ph_hi; };
static_assert(sizeof(Args) == 25 * 8 + 8 + 8 + 8, "Args has no padding");

__global__ void __launch_bounds__(NTHR, 2) fwd_megakernel(Args args) {
    extern __shared__ __attribute__((aligned(16))) unsigned char lds_raw[];
    LAS unsigned char* lds = (LAS unsigned char*)lds_raw;
    const int tid = threadIdx.x, lane = tid & 63, wave = __builtin_amdgcn_readfirstlane(tid >> 6);
    const int G = gridDim.x, bid = blockIdx.x;
    const int gw = bid * NWAVES + wave, NGW = G * NWAVES;
    unsigned char* ws = args.ws;
    const float* x = args.in[0]; const float* cvec = args.in[1]; const float* w_ada = args.in[2]; const float* b_ada = args.in[3]; const float* n1g = args.in[4];
    const float* w_in = args.in[5]; const float* conv_w = args.in[6]; const float* conv_b = args.in[7]; const float* cln_g = args.in[8]; const float* cln_b = args.in[9];
    const float* conv_proj = args.in[10]; const float* a_re = args.in[11]; const float* a_im = args.in[12]; const float* b_re = args.in[13]; const float* b_im = args.in[14];
    const float* c_re = args.in[15]; const float* c_im = args.in[16]; const float* ssm_d = args.in[17]; const float* log_dt = args.in[18]; const float* ssm_glu = args.in[19];
    const float* w_out = args.in[20]; const float* n2g = args.in[21]; const float* w_ffn_in = args.in[22]; const float* w_ffn_out = args.in[23]; const float* final_g = args.in[24];
    float* out = args.out;
    float* MOD = (float*)(ws + WS_MOD); float* RSS1 = (float*)(ws + WS_RSS1); float* RSS2 = (float*)(ws + WS_RSS2); float* SHW = (float*)(ws + WS_SHW);
    bf16* WIN = (bf16*)(ws + WS_WIN); bf16* WCP = (bf16*)(ws + WS_WCP); bf16* WGLU = (bf16*)(ws + WS_WGLU); bf16* WOUT = (bf16*)(ws + WS_WOUT); bf16* WFI = (bf16*)(ws + WS_WFI); bf16* WFO = (bf16*)(ws + WS_WFO);
    bf16* W1T = (bf16*)(ws + WS_W1); bf16* B2T = (bf16*)(ws + WS_B2); bf16* H1 = (bf16*)(ws + WS_H1);
    bf16* UCONV = (bf16*)(ws + WS_UCONV); bf16* A2S = (bf16*)(ws + WS_A2S); bf16* SGC = (bf16*)(ws + WS_SGC); bf16* SGS = (bf16*)(ws + WS_SGS);
    bf16* ACONV = (bf16*)(ws + WS_ACONV); bf16* ASSM = (bf16*)(ws + WS_ASSM); float* SST = (float*)(ws + WS_S); bf16* MG = (bf16*)(ws + WS_MERGED); bf16* HID = (bf16*)(ws + WS_HID); bf16* X1B = (bf16*)(ws + WS_X1B);
    cg::grid_group grid = cg::this_grid();
    const int lo = args.ph_lo, hi = args.ph_hi;
    volatile LAS unsigned* bst = (volatile LAS unsigned*)(lds + RING_BYTES + 1024);
    if (tid < 2) bst[tid] = 0u;
    __syncthreads();
    XcdBarrier xbar = xcd_barrier_post((unsigned*)(ws + WS_BAR), bst);
    if (lo == 0x7fffffff) grid.sync();
#ifndef PHMASK
#define PHMASK 0xFF
#endif
#define IN(k) ((((PHMASK) >> (k)) & 1) && lo <= (k) && (k) < hi)
#define GRID_SYNC() do { xcd_barrier(xbar); } while (0)
#define SEAM(k) do { if (IN(k) && IN((k) + 1)) GRID_SYNC(); } while (0)
#define REPS(k) _Pragma("unroll 1") for (int rep_ = 0; rep_ < ((((DUP_MASK) >> (k)) & 1) ? 2 : 1); ++rep_)

    if (IN(0)) REPS(0) { if (rep_) GRID_SYNC();
        {
            LAS float* scr = (LAS float*)(lds + wave * 16384);
            constexpr int I_IN = (D / 64) * (INC / 32), I_CP = (CW / 64) * (D / 32), I_GLU = (SW / 64) * (2 * D / 32), I_OUT = (D / 64) * (D / 32), I_FI = (D / 64) * (2 * FH / 32), I_FO = (FH / 64) * (D / 32);
            constexpr int NITEMS = I_IN + I_FI;
            const int ngv = NMOD6 / 64;
            const int tw0 = (G >= 2 * ngv) ? (bid - ngv) * NWAVES + wave : gw, tnw = (G >= 2 * ngv) ? (G - ngv) * NWAVES : NGW;
            for (int it = (tw0 >= 0 ? tw0 : NITEMS); it < NITEMS; it += tnw) {
                if (it < I_FI) transpose_item(w_ffn_in, D, 2 * FH, WFI, 3, scr, it, lane);
                else transpose_item(w_in, D, INC, WIN, 1, scr, it - I_FI, lane);
            }
        }
        {
            __syncthreads();
            LAS float* red = (LAS float*)lds;
            LAS float* sc = (LAS float*)(lds + 8192);
            if (bid < NMOD6 / 64) { for (int e = tid; e < BATCH * D; e += NTHR) sc[e] = silu_f(cvec[e]); }
            __syncthreads();
            for (int it = bid; it < NMOD6 / 64; it += G) {
                const int col = it * 64 + lane; float a0 = 0.f, a1 = 0.f, a2 = 0.f, a3 = 0.f;
#pragma unroll 1
                for (int k0 = wave * 128; k0 < wave * 128 + 128; k0 += 32) { float wv[32];
#pragma unroll
                    for (int j = 0; j < 32; ++j) wv[j] = __builtin_nontemporal_load(w_ada + (size_t)(k0 + j) * NMOD6 + col);
#pragma unroll
                    for (int j = 0; j < 32; ++j) { a0 += wv[j] * sc[k0 + j]; a1 += wv[j] * sc[D + k0 + j]; a2 += wv[j] * sc[2 * D + k0 + j]; a3 += wv[j] * sc[3 * D + k0 + j]; } }
                red[(wave * 4 + 0) * 64 + lane] = a0; red[(wave * 4 + 1) * 64 + lane] = a1; red[(wave * 4 + 2) * 64 + lane] = a2; red[(wave * 4 + 3) * 64 + lane] = a3;
                __syncthreads();
                if (tid < 256) { const int b = tid >> 6, c = tid & 63; float t = b_ada[it * 64 + c];
#pragma unroll
                    for (int w = 0; w < 8; ++w) t += red[(w * 4 + b) * 64 + c];
                    __hip_atomic_store(MOD + b * NMOD6 + it * 64 + c, t, __ATOMIC_RELAXED, __HIP_MEMORY_SCOPE_AGENT); }
                asm volatile("s_waitcnt vmcnt(0)" ::: "memory");
                __syncthreads();
                if (tid == 0) __hip_atomic_fetch_add((unsigned*)(ws + WS_GCNT), 1u, __ATOMIC_RELAXED, __HIP_MEMORY_SCOPE_AGENT);
            }
        }
        {
            LAS f32x2* PW = (LAS f32x2*)(lds);
            LAS f32x2* QQ = (LAS f32x2*)(lds + 8704);
            LAS f32x2* BB = (LAS f32x2*)(lds + 9216);
            LAS f32x2* CC = (LAS f32x2*)(lds + 17408);
            LAS float* KT = (LAS float*)(lds + 25600);
            for (int it = bid; it < NG * 8; it += G) {
                const int g = it >> 3, rb = it & 7;
                __syncthreads();
                if (tid < 64) {
                    double er, ei, ar, ai; ssm_abar(a_re, a_im, log_dt, g, tid, er, ei, ar, ai);
                    const double nr = er - 1.0, ni = ei, den = ar * ar + ai * ai;
                    QQ[tid] = (f32x2){(float)((nr * ar + ni * ai) / den), (float)((ni * ar - nr * ai) / den)};
                    double pr = 1.0, pi = 0.0;
                    for (int j = 0; j <= 16; ++j) { PW[j * 64 + tid] = (f32x2){(float)pr, (float)pi}; const double t = pr * er - pi * ei; pi = pr * ei + pi * er; pr = t; }
                }
                for (int e = tid; e < 1024; e += NTHR) CC[e] = (f32x2){c_re[g * 1024 + e], c_im[g * 1024 + e]};
                __syncthreads();
                for (int e = tid; e < 1024; e += NTHR) { const f32x2 q = QQ[e >> 4]; const float br = b_re[g * 1024 + e], bi = b_im[g * 1024 + e]; BB[e] = (f32x2){q.x * br - q.y * bi, q.x * bi + q.y * br}; }
                __syncthreads();
                if (rb < 4) {
                    const int nl = 4 * rb + 4, pair = tid & 255, ho = pair >> 4, hi = pair & 15;
                    for (int j = tid >> 8; j < nl; j += 2) {
                        float s = 0.f;
                        for (int p = 0; p < 64; ++p) { const f32x2 c = CC[ho * 64 + p], w = PW[j * 64 + p], b = BB[p * 16 + hi];
                            const float cr = c.x * w.x - c.y * w.y, ci = c.x * w.y + c.y * w.x; s += cr * b.x - ci * b.y; }
                        KT[j * 256 + pair] = s;
                    }
                    __syncthreads();
                    for (int r = wave * 8; r < wave * 8 + 8; ++r) { const int n = 64 * rb + r, t = n >> 4, ho = n & 15;
#pragma unroll
                        for (int i = 0; i < 3; ++i) { const int kp = lane + 64 * i; float v[2];
#pragma unroll
                            for (int h = 0; h < 2; ++h) { const int k = 2 * kp + h;
                                if (k < 256) { const int s = k >> 4, hi = k & 15; v[h] = (s <= t) ? KT[(t - s) * 256 + ho * 16 + hi] : 0.f; }
                                else { const int p = (k - 256) & 63; const f32x2 c = CC[ho * 64 + p], w = PW[(t + 1) * 64 + p]; v[h] = (k < 320) ? (c.x * w.x - c.y * w.y) : -(c.x * w.y + c.y * w.x); } }
                            *(unsigned*)(B2T + ((size_t)(g * 256 + n) * KA2 + 2 * kp)) = cvt_pk_bf16(v[0], v[1]); } }
                } else {
                    for (int r = wave * 8; r < wave * 8 + 8; ++r) { const int n = 64 * (rb - 4) + r, p = n & 63;
#pragma unroll
                        for (int i = 0; i < 2; ++i) { const int kp = lane + 64 * i; float v[2];
#pragma unroll
                            for (int h = 0; h < 2; ++h) { const int k = 2 * kp + h, s = k >> 4, hi = k & 15; const f32x2 w = PW[(15 - s) * 64 + p], b = BB[p * 16 + hi];
                                v[h] = (n < 64) ? (w.x * b.x - w.y * b.y) : (n < 128) ? (w.x * b.y + w.y * b.x) : 0.f; }
                            *(unsigned*)(W1T + ((size_t)(g * 256 + n) * 256 + 2 * kp)) = cvt_pk_bf16(v[0], v[1]); } }
                }
            }
            __syncthreads();
        }
    }
    if (IN(0) && IN(1)) {
        if (tid == 0) { unsigned sp = 0; while (__hip_atomic_load((unsigned*)(ws + WS_GCNT), __ATOMIC_RELAXED, __HIP_MEMORY_SCOPE_AGENT) < (unsigned)(NMOD6 / 64)) { __builtin_amdgcn_s_sleep(2); if (++sp > (1u << 22)) break; }
            __builtin_amdgcn_fence(__ATOMIC_ACQUIRE, "agent"); asm volatile("s_waitcnt vmcnt(0)" ::: "memory"); }
        __syncthreads();
    }
    for (int xs_ = 0; xs_ < EXTRA_SYNCS; ++xs_) GRID_SYNC();

    if (IN(1)) REPS(1) { if (rep_) GRID_SYNC();
        for (int rb = gw * 8; rb < M; rb += NGW * 8) {
            const float* mb = MOD + (rb >> 12) * NMOD6;
            f32x4 v[8][4]; float inv[8];
#pragma unroll
            for (int q = 0; q < 8; ++q) { const f32x4* xr = (const f32x4*)(x + (size_t)(rb + q) * D) + lane;
#pragma unroll
                for (int j = 0; j < 4; ++j) v[q][j] = __builtin_nontemporal_load(xr + 64 * j); }
#pragma unroll
            for (int q = 0; q < 8; ++q) { float s = 0.f;
#pragma unroll
                for (int j = 0; j < 4; ++j) s += (v[q][j][0] * v[q][j][0] + v[q][j][1] * v[q][j][1]) + (v[q][j][2] * v[q][j][2] + v[q][j][3] * v[q][j][3]);
                inv[q] = rsqrtf(wave_sum(s) * (1.0f / D) + EPS); }
#pragma unroll
            for (int j = 0; j < 4; ++j) { const int col = lane * 4 + 256 * j;
                const f32x4 gsc = (*(const f32x4*)(n1g + col)) * (*(const f32x4*)(mb + D + col) + 1.0f), sh = *(const f32x4*)(mb + col);
#pragma unroll
                for (int q = 0; q < 8; ++q) { const f32x4 h = v[q][j] * inv[q] * gsc + sh;
                    v2u o; o.x = cvt_pk_bf16(h[0], h[1]); o.y = cvt_pk_bf16(h[2], h[3]); *(v2u*)(H1 + (size_t)(rb + q) * D + col) = o; } }
        }
    }
    SEAM(1);

    if (IN(2)) REPS(2) { if (rep_) GRID_SYNC();
        pg8::Gemm g{D, D, D}; pg8::StaticOrder S; S.init(M, INC, G, bid, H1, D, WIN, D);
        EpiIn E{UCONV, A2S, SGC, SGS};
        GEMM_CALL(EpiIn, pg8::StaticOrder)(lds, g, S, E);
        {
            constexpr int NU = (M / 256) * (INC / 256), I_CP = (CW / 64) * (D / 32), I_GLU = (SW / 64) * (2 * D / 32), I_OUT = (D / 64) * (D / 32);
            int first = NU % G, nhelp = G - first; if (first == 0) nhelp = G;
            if (bid >= first) {
                LAS float* scr = (LAS float*)(lds + wave * 16384);
                const int hw0 = (bid - first) * NWAVES + wave, hnw = nhelp * NWAVES;
                for (int it = hw0; it < I_GLU + I_OUT + I_CP; it += hnw) {
                    if (it < I_GLU) transpose_item(ssm_glu, SW, 2 * D, WGLU, 2, scr, it, lane);
                    else if (it < I_GLU + I_OUT) transpose_item(w_out, D, D, WOUT, 0, scr, it - I_GLU, lane);
                    else transpose_item(conv_proj, CW, D, WCP, 0, scr, it - I_GLU - I_OUT, lane);
                }
                for (int v = hw0; v < 2 * FH; v += hnw) {
                    const v4u w0 = *(const v4u*)(WFI + (size_t)v * D + lane * 8), w1 = *(const v4u*)(WFI + (size_t)v * D + 512 + lane * 8);
                    f32x4 a0, a1, b0, b1; unpack8(w0, a0, a1); unpack8(w1, b0, b1);
        #pragma unroll
                    for (int b = 0; b < BATCH; ++b) { const float* sh = MOD + b * NMOD6 + 3 * D;
                        const f32x4 s0 = *(const f32x4*)(sh + lane * 8), s1 = *(const f32x4*)(sh + lane * 8 + 4), s2 = *(const f32x4*)(sh + 512 + lane * 8), s3 = *(const f32x4*)(sh + 512 + lane * 8 + 4);
                        const f32x4 pr = a0 * s0 + a1 * s1 + b0 * s2 + b1 * s3; const float t = wave_sum((pr[0] + pr[1]) + (pr[2] + pr[3]));
                        if (lane == 0) SHW[b * (2 * FH) + v] = t; }
                }
            }
        }
    }
    SEAM(2);

    if (IN(3)) REPS(3) { if (rep_) GRID_SYNC();
        {
            const int cp = tid & 255, th = tid >> 8;
            LAS float* OUTT = (LAS float*)(lds + 65536);
            const bool bal = (G == 256);
            const int nmine = bal ? (bid < NG * 4 ? 0 : 4) : (M / 32 - bid + G - 1) / G;
            for (int ii = 0; ii < nmine; ++ii) {
                const int item = bal ? (bid - NG * 4) * 4 + ii : bid + ii * G;
                const int t0 = item * 32, pos0 = t0 & (SEQ - 1);
                __syncthreads();
                for (int e = tid; e < 62 * 64; e += NTHR) { const int r = e >> 6, ch = e & 63; v4u v = {0u, 0u, 0u, 0u};
                    if (pos0 - 30 + r >= 0) v = *(const v4u*)(UCONV + (size_t)(t0 - 30 + r) * CW + ch * 8);
                    *(LAS v4u*)(lds + r * 1024 + ch * 16) = v; }
                f32x2 w[CK];
#pragma unroll
                for (int j = 0; j < CK; ++j) w[j] = *(const f32x2*)(conv_w + j * CW + 2 * cp);
                f32x2 acc[16]; const f32x2 bias = *(const f32x2*)(conv_b + 2 * cp);
#pragma unroll
                for (int q = 0; q < 16; ++q) acc[q] = bias;
                __syncthreads();
#pragma unroll
                for (int i = 0; i < 46; ++i) { const unsigned uv = *(const LAS unsigned*)(lds + (th * 16 + i) * 1024 + cp * 4); const f32x2 vv = {bf_lo(uv), bf_hi(uv)};
#pragma unroll
                    for (int q = 0; q < 16; ++q) { const int j = i - q; if (j >= 0 && j < CK) acc[q] += vv * w[j]; } }
#pragma unroll
                for (int q = 0; q < 16; ++q) *(LAS f32x2*)(OUTT + (th * 16 + q) * 512 + 2 * cp) = acc[q];
                __syncthreads();
#pragma unroll
                for (int q = 0; q < 4; ++q) { const int tt = wave * 4 + q; const LAS float* rowp = OUTT + tt * 512;
                    f32x4 a = *(const LAS f32x4*)(rowp + lane * 4), b = *(const LAS f32x4*)(rowp + 256 + lane * 4);
                    const float mu = wave_sum((a[0] + a[1]) + (a[2] + a[3]) + (b[0] + b[1]) + (b[2] + b[3])) * (1.0f / CW);
                    a -= mu; b -= mu;
                    const float var = wave_sum((a[0] * a[0] + a[1] * a[1]) + (a[2] * a[2] + a[3] * a[3]) + (b[0] * b[0] + b[1] * b[1]) + (b[2] * b[2] + b[3] * b[3])) * (1.0f / CW);
                    const float rstd = rsqrtf(var + EPS);
                    a = a * rstd * (*(const f32x4*)(cln_g + lane * 4)) + *(const f32x4*)(cln_b + lane * 4);
                    b = b * rstd * (*(const f32x4*)(cln_g + 256 + lane * 4)) + *(const f32x4*)(cln_b + 256 + lane * 4);
                    v2u o0, o1; o0.x = cvt_pk_bf16(silu_f(a[0]), silu_f(a[1])); o0.y = cvt_pk_bf16(silu_f(a[2]), silu_f(a[3])); o1.x = cvt_pk_bf16(silu_f(b[0]), silu_f(b[1])); o1.y = cvt_pk_bf16(silu_f(b[2]), silu_f(b[3]));
                    bf16* dst = ACONV + (size_t)(t0 + tt) * CW; *(v2u*)(dst + lane * 4) = o0; *(v2u*)(dst + 256 + lane * 4) = o1; }
            }
            __syncthreads();
        }
        if (bid < NG * 4) {
            const int L = bid, g = L >> 2, b = L & 3;
            {
                pg8::Gemm gg{256, KA2, 256}; BatchOrder S{4, NG * 4, 1 << 20, L, (const char*)A2S, (const char*)W1T, (size_t)NCH * KA2 * 2, (size_t)256 * KA2 * 2, (size_t)256 * 256 * 2};
                EpiState E{SST};
                GEMM_CALL(EpiState, BatchOrder)(lds, gg, S, E);
            }
            asm volatile("s_waitcnt vmcnt(0)" ::: "memory");
            __syncthreads(); __builtin_amdgcn_fence(__ATOMIC_ACQUIRE, "agent");
            const f32x4* src = (const f32x4*)(SST + (size_t)(g * NCH + b * CPB) * 128);
#pragma unroll 4
            for (int i = 0; i < 16; ++i) *(LAS f32x4*)(lds + (size_t)(tid + i * NTHR) * 16) = src[tid + i * NTHR];
            __syncthreads();
            {
                double er, ei, ar, ai; ssm_abar(a_re, a_im, log_dt, g, lane, er, ei, ar, ai);
#pragma unroll
                for (int j = 0; j < 4; ++j) { const double t = er * er - ei * ei; ei = 2.0 * er * ei; er = t; }
                const float alr = (float)er, ali = (float)ei;
#pragma unroll
                for (int j = 0; j < 5; ++j) { const double t = er * er - ei * ei; ei = 2.0 * er * ei; er = t; }
                const float a32r = (float)er, a32i = (float)ei;
                const LAS float* sl = (const LAS float*)lds + wave * 32 * 128; LAS f32x2* EE = (LAS f32x2*)(lds + RING_BYTES + 2048);
                float xr = 0.f, xi = 0.f;
#pragma unroll 8
                for (int c = 0; c < 32; ++c) { const float sr = sl[c * 128 + lane], si = sl[c * 128 + 64 + lane]; const float nr = alr * xr - ali * xi + sr, ni = alr * xi + ali * xr + si; xr = nr; xi = ni; }
                EE[wave * 64 + lane] = (f32x2){xr, xi};
                __syncthreads();
                xr = 0.f; xi = 0.f;
                for (int v = 0; v < wave; ++v) { const f32x2 e = EE[v * 64 + lane]; const float nr = a32r * xr - a32i * xi + e.x, ni = a32r * xi + a32i * xr + e.y; xr = nr; xi = ni; }
                bf16* dst = A2S + (size_t)(g * NCH + b * CPB + wave * 32) * KA2 + 256 + lane;
#pragma unroll 8
                for (int c = 0; c < 32; ++c) {
                    const unsigned pk = cvt_pk_bf16(xr, xi); dst[(size_t)c * KA2] = (bf16)(pk & 0xffffu); dst[(size_t)c * KA2 + 64] = (bf16)(pk >> 16);
                    const float sr = sl[c * 128 + lane], si = sl[c * 128 + 64 + lane];
                    const float nr = alr * xr - ali * xi + sr, ni = alr * xi + ali * xr + si; xr = nr; xi = ni;
                }
            }
            asm volatile("s_waitcnt vmcnt(0)" ::: "memory");
            __syncthreads(); __builtin_amdgcn_fence(__ATOMIC_ACQUIRE, "agent");
            {
                pg8::Gemm gg{KA2, KA2, KA2}; BatchOrder S{4, NG * 4, 1 << 20, L, (const char*)A2S, (const char*)B2T, (size_t)NCH * KA2 * 2, (size_t)256 * KA2 * 2, (size_t)256 * KA2 * 2};
                EpiSsmOut E{A2S, ssm_d, ASSM};
                GEMM_CALL(EpiSsmOut, BatchOrder)(lds, gg, S, E);
            }
        }
    }
    SEAM(3);

    if (IN(4)) REPS(4) { if (rep_) GRID_SYNC();
        pg8::Gemm g{SW, SW, SW}; TripleOrder S; S.base.init(M, D, G, bid, ACONV, CW, WCP, CW); S.A1 = (const char*)ASSM; S.B1 = (const char*)WGLU; S.tsA = (size_t)256 * SW * 2; S.tsB = (size_t)256 * SW * 2;
        EpiMix E{SGC, SGS, MG};
        GEMM_CALL(EpiMix, TripleOrder)(lds, g, S, E);
    }
    SEAM(4);

    if (IN(5)) REPS(5) { if (rep_) GRID_SYNC();
        pg8::Gemm g{D, D, D}; pg8::StaticOrder S; S.init(M, D, G, bid, MG, D, WOUT, D);
        EpiOut E{x, MOD, n2g, X1B, H1, RSS1};
        GEMM_CALL(EpiOut, pg8::StaticOrder)(lds, g, S, E);
    }
    SEAM(5);

    if (IN(6)) REPS(6) { if (rep_) GRID_SYNC();
        pg8::Gemm g{D, D, D}; pg8::StaticOrder S; S.init(M, 2 * FH, G, bid, H1, D, WFI, D);
        EpiFfnIn E{RSS1, SHW, HID};
        GEMM_CALL(EpiFfnIn, pg8::StaticOrder)(lds, g, S, E);
        {
            constexpr int NU = (M / 256) * (2 * FH / 256), I_FO = (FH / 64) * (D / 32);
            int first = NU % G, nhelp = G - first; if (first == 0) nhelp = G;
            if (bid >= first) {
                LAS float* scr = (LAS float*)(lds + wave * 16384);
                for (int it = (bid - first) * NWAVES + wave; it < I_FO; it += nhelp * NWAVES) transpose_item(w_ffn_out, FH, D, WFO, 0, scr, it, lane);
            }
        }
    }
    SEAM(6);

    if (IN(7)) REPS(7) { if (rep_) GRID_SYNC();
        pg8::Gemm g{FH, FH, FH}; pg8::StaticOrder S; S.init(M, D, G, bid, HID, FH, WFO, FH);
        EpiFfnOut E{MOD, final_g, n2g, H1, out, RSS2, (unsigned*)(ws + WS_PCNT)};
        GEMM_CALL(EpiFfnOut, pg8::StaticOrder)(lds, g, S, E);
    }

#undef IN
#undef SEAM
}

extern "C" void kernel_launch(void* const* d_in, const int* in_sizes, int n_in, void* d_out, int out_size, void* d_ws, size_t ws_size, hipStream_t stream) {
    static int grid = 0;
    if (grid == 0) {
        if (n_in != 25 || out_size != M * D || ws_size < WS_END) { fprintf(stderr, "kernel_launch: unexpected shapes (n_in %d out %d ws %zu)\n", n_in, out_size, ws_size); grid = -1; return; }
        int dev = 0, cus = 0, per_cu = 0;
        (void)hipGetDevice(&dev); (void)hipDeviceGetAttribute(&cus, hipDeviceAttributeMultiprocessorCount, dev);
        if (hipFuncSetAttribute((const void*)fwd_megakernel, hipFuncAttributeMaxDynamicSharedMemorySize, LDS_BYTES) != hipSuccess) { fprintf(stderr, "kernel_launch: hipFuncSetAttribute failed\n"); grid = -1; return; }
        if (hipOccupancyMaxActiveBlocksPerMultiprocessor(&per_cu, (const void*)fwd_megakernel, NTHR, LDS_BYTES) != hipSuccess || per_cu < 1) { fprintf(stderr, "kernel_launch: occupancy query failed (%d)\n", per_cu); (void)hipGetLastError(); per_cu = 1; }
        grid = cus * (per_cu > 1 ? 1 : per_cu);
        if (grid <= 0) grid = 256;
    }
    if (grid < 0) return;
    (void)hipMemsetAsync((char*)d_ws + WS_BAR, 0, BAR_BYTES, stream);
    Args a{};
    for (int i = 0; i < 25; ++i) a.in[i] = (const float*)d_in[i];
    a.out = (float*)d_out; a.ws = (unsigned char*)d_ws;
#if MK_PER_PHASE
    for (int ph = 0; ph < NPHASE; ++ph) { a.ph_lo = ph; a.ph_hi = ph + 1; hipLaunchKernelGGL(fwd_megakernel, dim3(grid), dim3(NTHR), LDS_BYTES, stream, a); }
#else
    a.ph_lo = 0; a.ph_hi = NPHASE;
    void* kargs[] = {&a};
    hipError_t e = hipLaunchCooperativeKernel((const void*)fwd_megakernel, dim3(grid), dim3(NTHR), kargs, LDS_BYTES, stream);
    if (e != hipSuccess) fprintf(stderr, "kernel_launch: cooperative launch failed: %s (grid %d)\n", hipGetErrorString(e), grid);
#endif
}
```

```cpp
#include <hip/hip_runtime.h>
#include <hip/hip_cooperative_groups.h>
#include <cstdio>
#include <cstdint>
namespace cg = cooperative_groups;
#define PG8_ALIGN true
#define PG8_SP2 true
#ifndef DUP_MASK
#define DUP_MASK 0x000
#endif
#ifndef EXTRA_SYNCS
#define EXTRA_SYNCS 0
#endif
#ifndef GEMM_SIMPLE
#define GEMM_SIMPLE 0
#endif
#if GEMM_SIMPLE
#define GEMM_CALL(E_, S_) pg8::gemm_simple<E_, S_>
#else
#define GEMM_CALL(E_, S_) pg8::gemm_phase<E_, S_, PG8_ALIGN, PG8_SP2>
#endif
#ifndef MK_PER_PHASE
#define MK_PER_PHASE 0
#endif
namespace pg8 {
#define PG8_LAS __attribute__((address_space(3)))
typedef unsigned short bf16_t;
typedef short bf16x8 __attribute__((ext_vector_type(8)));
typedef float f32x4 __attribute__((ext_vector_type(4)));
typedef unsigned u32x4 __attribute__((ext_vector_type(4)));
constexpr int BM = 256, BK = 64, HALF = 128, HTB = HALF * BK * 2  , STAGE_BYTES = 8 * HTB, NXCD = 8, WGM = 8;

__host__ __device__ __forceinline__ int lds_byte(int r, int c) { const int st = (r >> 4) * 2 + (c >> 5), rr = r & 15, cc = c & 31, ob = rr * 64 + cc * 2; return st * 1024 + (ob ^ (((ob >> 9) & 1) << 5)); }
__host__ __device__ __forceinline__ void stage_rc(int b, int& R, int& C) { const int st = b / 1024, sb = b % 1024, swz = sb ^ (((sb >> 9) & 1) << 5); R = (st >> 1) * 16 + swz / 64; C = (st & 1) * 32 + (swz % 64) / 2; }
__host__ __device__ __forceinline__ int perm32(int rho) { const int n = rho >> 4, i = rho & 15; return 8 * (i >> 2) + 4 * n + (i & 3); }

struct Unit { int pm, pn, z; };
struct Gemm { int K, lda, ldb; };

struct StaticOrder {
    int nM, nN, nwg, G, c; const char* A; const char* B; size_t tsA, tsB;
    __host__ __device__ void init(int M, int N, int G_, int c_, const void* A_, int lda, const void* B_, int ldb) { nM = M / BM; nN = N / BM; nwg = nM * nN; G = G_; c = c_; A = (const char*)A_; B = (const char*)B_; tsA = (size_t)BM * lda * 2; tsB = (size_t)BM * ldb * 2; }
    __device__ __forceinline__ const char* pa(const Unit& u) const { return A + (size_t)u.pm * tsA; }
    __device__ __forceinline__ const char* pb(const Unit& u) const { return B + (size_t)u.pn * tsB; }
    __host__ __device__ bool next(int i, Unit& u) const {
        const long L = (long)i * G + c; if (L >= nwg) return false;
        int wgid = (int)L; { const int q = nwg / NXCD, r = nwg % NXCD, xcd = wgid % NXCD, off = wgid / NXCD; wgid = (xcd < r ? xcd * (q + 1) : r * (q + 1) + (xcd - r) * q) + off; }
        const int nig = WGM * nN, gid = wgid / nig, fm = gid * WGM, gsz = (nM - fm) < WGM ? (nM - fm) : WGM;
        u.pm = fm + ((wgid % nig) % gsz); u.pn = (wgid % nig) / gsz; u.z = 0; return true;
    }
    __device__ __forceinline__ void a_ready(const Unit&) const {}
    __device__ __forceinline__ void done(const Unit&) const {}
};

__device__ __forceinline__ unsigned cvt_pk_bf16(float lo, float hi) { unsigned r; asm volatile("s_nop 1\n\tv_cvt_pk_bf16_f32 %0, %1, %2" : "=v"(r) : "v"(lo), "v"(hi)); return r; }
template <class Epi, class Sched, bool ALIGN_EPI = false, bool SP2 = false>
__device__ __forceinline__ void gemm_phase(PG8_LAS unsigned char* lds, const Gemm g, const Sched& S, const Epi& E) {
    const int tid = threadIdx.x, wid = __builtin_amdgcn_readfirstlane(tid >> 6), lane = tid & 63, wr = wid >> 2, wc = wid & 3, fr = lane & 15, fq = lane >> 4;
    const int K = g.K, nt = K / BK;
    unsigned voffA[2], voffB[2];
#pragma unroll
    for (int i = 0; i < 2; ++i) { int R, C; stage_rc(tid * 16 + i * 8192, R, C); const int Rb = Epi::PERM ? ((R & ~31) + perm32(R & 31)) : R;
        voffA[i] = (unsigned)(R * g.lda + C) * 2u; voffB[i] = (unsigned)(Rb * g.ldb + C) * 2u; }
    const size_t kstep = (size_t)(BK * 2);
    const size_t hstepA = (size_t)HALF * g.lda * 2, hstepB = (size_t)HALF * g.ldb * 2;
    const unsigned ldsw = (unsigned)wid * 1024u;
    const int aoff = lds_byte(wr * 64 + fr, fq * 8), boff = lds_byte(wc * 32 + fr, fq * 8);
#define PG8_SA(b, h) (((b) * 2 + (h)) * HTB)
#define PG8_SB(b, h) ((4 + (b) * 2 + (h)) * HTB)
#define PG8_STAGE(bufoff, gbase, voff) do { _Pragma("unroll") for (int _i = 0; _i < 2; ++_i) \
        __builtin_amdgcn_global_load_lds((const unsigned*)((const char*)(gbase) + (voff)[_i]), (PG8_LAS unsigned*)(lds + (bufoff) + ldsw + _i * 8192), 16, 0, 0); } while (0)
#define PG8_LDA(dst, b, h) do { _Pragma("unroll") for (int m = 0; m < 4; ++m) _Pragma("unroll") for (int k = 0; k < 2; ++k) dst[m][k] = *(const PG8_LAS bf16x8*)(lds + PG8_SA(b, h) + aoff + m * 2048 + k * 1024); } while (0)
#define PG8_LDB(dst, b, h) do { _Pragma("unroll") for (int n = 0; n < 2; ++n) _Pragma("unroll") for (int k = 0; k < 2; ++k) dst[n][k] = *(const PG8_LAS bf16x8*)(lds + PG8_SB(b, h) + boff + n * 2048 + k * 1024); } while (0)
#define PG8_MMA(ai, bj, At, Bt) do { __builtin_amdgcn_s_setprio(1); _Pragma("unroll") for (int m = 0; m < 4; ++m) _Pragma("unroll") for (int n = 0; n < 2; ++n) _Pragma("unroll") for (int k = 0; k < 2; ++k) \
        acc[ai][bj][m][n] = __builtin_amdgcn_mfma_f32_16x16x32_bf16(Bt[n][k], At[m][k], acc[ai][bj][m][n], 0, 0, 0); __builtin_amdgcn_s_setprio(0); } while (0)
#define PG8_WAIT_V(n) asm volatile("s_waitcnt vmcnt(" #n ")" ::: "memory")
#define PG8_WAIT_L(n) asm volatile("s_waitcnt lgkmcnt(" #n ")" ::: "memory")
#define PG8_BAR __builtin_amdgcn_s_barrier()
#define PG8_SCHED __builtin_amdgcn_sched_barrier(0)
    Unit cur, nxt; int ui = 0;
    if (!S.next(0, cur)) return;
    f32x4 acc[2][2][4][2];
#pragma unroll
    for (int a = 0; a < 2; ++a)
#pragma unroll
        for (int b = 0; b < 2; ++b)
#pragma unroll
            for (int m = 0; m < 4; ++m)
#pragma unroll
                for (int n = 0; n < 2; ++n) acc[a][b][m][n] = (f32x4){0.f, 0.f, 0.f, 0.f};
    bf16x8 At[4][2], B0[2][2], B1[2][2];
    const char* cA = S.pa(cur); const char* cB = S.pb(cur);
    S.a_ready(cur);
    if constexpr (SP2) {
        PG8_STAGE(PG8_SB(0, 0), cB, voffB); PG8_STAGE(PG8_SB(0, 1), cB + hstepB, voffB); PG8_STAGE(PG8_SA(0, 0), cA, voffA); PG8_STAGE(PG8_SA(0, 1), cA + hstepA, voffA);
        if (wr == 1) PG8_BAR;
        PG8_WAIT_V(2); PG8_BAR;
        PG8_STAGE(PG8_SB(1, 0), cB + kstep, voffB); PG8_STAGE(PG8_SA(1, 0), cA + kstep, voffA); PG8_STAGE(PG8_SB(1, 1), cB + hstepB + kstep, voffB);
        PG8_WAIT_V(6); PG8_BAR;
    } else {
        PG8_STAGE(PG8_SB(0, 0), cB, voffB); PG8_STAGE(PG8_SA(0, 0), cA, voffA); PG8_STAGE(PG8_SB(0, 1), cB + hstepB, voffB); PG8_STAGE(PG8_SA(0, 1), cA + hstepA, voffA);
        if (wr == 1) PG8_BAR;
        PG8_WAIT_V(4); PG8_BAR;
        PG8_STAGE(PG8_SB(1, 0), cB + kstep, voffB); PG8_STAGE(PG8_SA(1, 0), cA + kstep, voffA); PG8_STAGE(PG8_SB(1, 1), cB + hstepB + kstep, voffB);
        PG8_WAIT_V(6); PG8_BAR;
    }
    for (;;) {
        const bool has_next = S.next(ui + 1, nxt);
        const char* nA = has_next ? S.pa(nxt) : cA; const char* nB = has_next ? S.pb(nxt) : cB;
#pragma unroll 1
        for (int t = 0; t < nt; t += 2) {
            const bool last = (t == nt - 2);
            const char* a1 = cA + (size_t)(t + 1) * kstep;
            const char* a2 = last ? nA : cA + (size_t)(t + 2) * kstep; const char* b2 = last ? nB : cB + (size_t)(t + 2) * kstep;
            const char* a3 = a2 + kstep; const char* b3 = b2 + kstep;
            if (last && has_next) S.a_ready(nxt);
            if constexpr (SP2) {
            PG8_LDB(B0, 0, 0); PG8_LDB(B1, 0, 1); PG8_SCHED; PG8_LDA(At, 0, 0); PG8_STAGE(PG8_SA(1, 1), a1 + hstepA, voffA);
            PG8_WAIT_V(8); PG8_WAIT_L(0); PG8_BAR; PG8_MMA(0, 0, At, B0); PG8_MMA(0, 1, At, B1); PG8_BAR; PG8_SCHED;
            PG8_LDA(At, 0, 1); PG8_STAGE(PG8_SB(0, 0), b2, voffB); PG8_STAGE(PG8_SB(0, 1), b2 + hstepB, voffB); PG8_STAGE(PG8_SA(0, 0), a2, voffA);
            PG8_WAIT_V(8); PG8_WAIT_L(0); PG8_BAR; PG8_MMA(1, 0, At, B0); PG8_MMA(1, 1, At, B1); PG8_BAR; PG8_SCHED;
            PG8_LDB(B0, 1, 0); PG8_LDB(B1, 1, 1); PG8_SCHED; PG8_LDA(At, 1, 0); PG8_STAGE(PG8_SA(0, 1), a2 + hstepA, voffA);
            PG8_WAIT_V(8); PG8_WAIT_L(0); PG8_BAR; PG8_MMA(0, 0, At, B0); PG8_MMA(0, 1, At, B1); PG8_BAR; PG8_SCHED;
            PG8_LDA(At, 1, 1); PG8_STAGE(PG8_SB(1, 0), b3, voffB); PG8_STAGE(PG8_SB(1, 1), b3 + hstepB, voffB); PG8_STAGE(PG8_SA(1, 0), a3, voffA);
            PG8_WAIT_V(8); PG8_WAIT_L(0); PG8_BAR; PG8_MMA(1, 0, At, B0); PG8_MMA(1, 1, At, B1); PG8_BAR; PG8_SCHED;
            } else {
            PG8_LDB(B0, 0, 0); PG8_SCHED; PG8_LDA(At, 0, 0); PG8_STAGE(PG8_SA(1, 1), a1 + hstepA, voffA);
            PG8_WAIT_L(8); PG8_BAR; PG8_WAIT_L(0); PG8_MMA(0, 0, At, B0); PG8_BAR; PG8_SCHED;
            PG8_LDB(B1, 0, 1); PG8_STAGE(PG8_SB(0, 0), b2, voffB);
            PG8_BAR; PG8_WAIT_L(0); PG8_MMA(0, 1, At, B1); PG8_BAR;
            PG8_LDA(At, 0, 1); PG8_STAGE(PG8_SA(0, 0), a2, voffA);
            PG8_BAR; PG8_WAIT_L(0); PG8_MMA(1, 0, At, B0); PG8_BAR; PG8_SCHED;
            PG8_STAGE(PG8_SB(0, 1), b2 + hstepB, voffB);
            PG8_WAIT_V(6); PG8_BAR; PG8_MMA(1, 1, At, B1); PG8_BAR;
            PG8_LDB(B0, 1, 0); PG8_SCHED; PG8_LDA(At, 1, 0); PG8_STAGE(PG8_SA(0, 1), a2 + hstepA, voffA);
            PG8_WAIT_L(8); PG8_BAR; PG8_WAIT_L(0); PG8_MMA(0, 0, At, B0); PG8_BAR; PG8_SCHED;
            PG8_LDB(B1, 1, 1); PG8_STAGE(PG8_SB(1, 0), b3, voffB);
            PG8_BAR; PG8_WAIT_L(0); PG8_MMA(0, 1, At, B1); PG8_BAR;
            PG8_LDA(At, 1, 1); PG8_STAGE(PG8_SA(1, 0), a3, voffA);
            PG8_BAR; PG8_WAIT_L(0); PG8_MMA(1, 0, At, B0); PG8_BAR; PG8_SCHED;
            PG8_STAGE(PG8_SB(1, 1), b3 + hstepB, voffB);
            PG8_WAIT_V(6); PG8_BAR; PG8_MMA(1, 1, At, B1); PG8_BAR;
            }
        }
        if constexpr (ALIGN_EPI) { if (wr == 0) PG8_BAR; }
        if constexpr (!Epi::AFTER_DRAIN) { E(acc, cur, wr, wc, fr, fq); S.done(cur); }
        if (!has_next) break;
#pragma unroll
        for (int a = 0; a < 2; ++a)
#pragma unroll
            for (int b = 0; b < 2; ++b)
#pragma unroll
                for (int m = 0; m < 4; ++m)
#pragma unroll
                    for (int n = 0; n < 2; ++n) acc[a][b][m][n] = (f32x4){0.f, 0.f, 0.f, 0.f};
        cur = nxt; cA = nA; cB = nB; ++ui;
        if constexpr (ALIGN_EPI) { if (wr == 1) PG8_BAR; }
    }
    PG8_WAIT_V(0);
    if constexpr (!ALIGN_EPI) { if (wr == 0) PG8_BAR; }
    PG8_BAR;
    if constexpr (Epi::AFTER_DRAIN) { E.fused(acc, cur, wr, wc, fr, fq, lds, wid, lane); S.done(cur); }
#undef PG8_SA
#undef PG8_SB
#undef PG8_STAGE
#undef PG8_LDA
#undef PG8_LDB
#undef PG8_MMA
#undef PG8_WAIT_V
#undef PG8_WAIT_L
#undef PG8_BAR
#undef PG8_SCHED
}

template <class Epi, class Sched>
__device__ __forceinline__ void gemm_simple(PG8_LAS unsigned char* lds, const Gemm g, const Sched& S, const Epi& E) {
    const int tid = threadIdx.x, wid = __builtin_amdgcn_readfirstlane(tid >> 6), lane = tid & 63, wr = wid >> 2, wc = wid & 3, fr = lane & 15, fq = lane >> 4;
    const int nt = g.K / BK;
    unsigned voffA[2], voffB[2];
#pragma unroll
    for (int i = 0; i < 2; ++i) { int R, C; stage_rc(tid * 16 + i * 8192, R, C); const int Rb = Epi::PERM ? ((R & ~31) + perm32(R & 31)) : R;
        voffA[i] = (unsigned)(R * g.lda + C) * 2u; voffB[i] = (unsigned)(Rb * g.ldb + C) * 2u; }
    const size_t kstep = (size_t)(BK * 2), hstepA = (size_t)HALF * g.lda * 2, hstepB = (size_t)HALF * g.ldb * 2;
    const unsigned ldst = (unsigned)tid * 16u;
    const int aoff = lds_byte(wr * 64 + fr, fq * 8), boff = lds_byte(wc * 32 + fr, fq * 8);
#define SG_SA(b, h) (((b) * 2 + (h)) * HTB)
#define SG_SB(b, h) ((4 + (b) * 2 + (h)) * HTB)
#define SG_LDB(dst, b, h) do { _Pragma("unroll") for (int n = 0; n < 2; ++n) _Pragma("unroll") for (int k = 0; k < 2; ++k) dst[n][k] = *(const PG8_LAS bf16x8*)(lds + SG_SB(b, h) + boff + n * 2048 + k * 1024); } while (0)
#define SG_AFRAG(b, st, k) (*(const PG8_LAS bf16x8*)(lds + SG_SA(b, (st) >> 2) + aoff + ((st) & 3) * 2048 + (k) * 1024))
#define SG_AHALF(b, ai) do { bf16x8 c0 = SG_AFRAG(b, (ai) * 4, 0), c1 = SG_AFRAG(b, (ai) * 4, 1); \
        _Pragma("unroll") for (int m = 0; m < 4; ++m) { bf16x8 n0 = c0, n1 = c1; \
            if (m < 3) { n0 = SG_AFRAG(b, (ai) * 4 + m + 1, 0); n1 = SG_AFRAG(b, (ai) * 4 + m + 1, 1); } \
            __builtin_amdgcn_sched_barrier(0); \
            _Pragma("unroll") for (int n = 0; n < 2; ++n) { \
                acc[ai][0][m][n] = __builtin_amdgcn_mfma_f32_16x16x32_bf16(B0[n][0], c0, acc[ai][0][m][n], 0, 0, 0); acc[ai][0][m][n] = __builtin_amdgcn_mfma_f32_16x16x32_bf16(B0[n][1], c1, acc[ai][0][m][n], 0, 0, 0); \
                acc[ai][1][m][n] = __builtin_amdgcn_mfma_f32_16x16x32_bf16(B1[n][0], c0, acc[ai][1][m][n], 0, 0, 0); acc[ai][1][m][n] = __builtin_amdgcn_mfma_f32_16x16x32_bf16(B1[n][1], c1, acc[ai][1][m][n], 0, 0, 0); } \
            __builtin_amdgcn_sched_barrier(0); c0 = n0; c1 = n1; } } while (0)
#define SG_LOADA(t) do { _Pragma("unroll") for (int h = 0; h < 2; ++h) _Pragma("unroll") for (int i = 0; i < 2; ++i) rr[h][i] = *(const u32x4*)(cA + h * hstepA + (size_t)(t) * kstep + voffA[i]); } while (0)
#define SG_LOADB(t) do { _Pragma("unroll") for (int h = 0; h < 2; ++h) _Pragma("unroll") for (int i = 0; i < 2; ++i) rr[h][i] = *(const u32x4*)(cB + h * hstepB + (size_t)(t) * kstep + voffB[i]); } while (0)
#define SG_STOREA(b) do { _Pragma("unroll") for (int h = 0; h < 2; ++h) _Pragma("unroll") for (int i = 0; i < 2; ++i) *(PG8_LAS u32x4*)(lds + SG_SA(b, h) + i * 8192 + ldst) = rr[h][i]; } while (0)
#define SG_STOREB(b) do { _Pragma("unroll") for (int h = 0; h < 2; ++h) _Pragma("unroll") for (int i = 0; i < 2; ++i) *(PG8_LAS u32x4*)(lds + SG_SB(b, h) + i * 8192 + ldst) = rr[h][i]; } while (0)
#define SG_KTILE(b, tn, more) do { bf16x8 B0[2][2], B1[2][2]; if (more) SG_LOADA(tn); SG_LDB(B0, b, 0); SG_LDB(B1, b, 1); SG_AHALF(b, 0); \
        if (more) { SG_STOREA((b) ^ 1); SG_LOADB(tn); } SG_AHALF(b, 1); if (more) SG_STOREB((b) ^ 1); __syncthreads(); } while (0)
    Unit cur;
    for (int ui = 0; S.next(ui, cur); ++ui) {
        f32x4 acc[2][2][4][2];
#pragma unroll
        for (int a = 0; a < 2; ++a)
#pragma unroll
            for (int b = 0; b < 2; ++b)
#pragma unroll
                for (int m = 0; m < 4; ++m)
#pragma unroll
                    for (int n = 0; n < 2; ++n) acc[a][b][m][n] = (f32x4){0.f, 0.f, 0.f, 0.f};
        const char* cA = S.pa(cur); const char* cB = S.pb(cur);
        u32x4 rr[2][2];
        __syncthreads();
        SG_LOADA(0); SG_STOREA(0); SG_LOADB(0); SG_STOREB(0);
        __syncthreads();
#pragma unroll 1
        for (int t = 0; t < nt; t += 2) {
            SG_KTILE(0, t + 1, true);
            const bool more = (t + 2 < nt);
            SG_KTILE(1, t + 2, more);
        }
        E(acc, cur, wr, wc, fr, fq);
    }
#undef SG_SA
#undef SG_SB
#undef SG_LDB
#undef SG_AFRAG
#undef SG_AHALF
#undef SG_LOADA
#undef SG_LOADB
#undef SG_STOREA
#undef SG_STOREB
#undef SG_KTILE
}
}

constexpr int BATCH = 4, SEQ = 4096, D = 1024, M = BATCH * SEQ;
constexpr int CW = 512, CK = 31, SW = 512, NG = 32, SP = 64, FH = 2816, INC = 3584, NMOD6 = 6 * D;
constexpr int LC = 16, NCH = M / LC, CPB = SEQ / LC, KA2 = 384;
constexpr float EPS = 1e-6f;
constexpr int NWAVES = 8, NTHR = 512;
constexpr int NPHASE = 8;

constexpr size_t MiB = 1u << 20;
constexpr size_t WS_CTL = 0, CTL_ZERO_BYTES = 1 * MiB;
constexpr size_t WS_BAR = 512 * 1024, WS_PCNT = 512 * 1024 + 16384, WS_GCNT = 512 * 1024 + 32768, BAR_BYTES = 32768 + 256;
constexpr size_t WS_MOD = 0, WS_RSS1 = 30 * MiB, WS_RSS2 = 31 * MiB;
constexpr size_t WS_WIN = 1 * MiB, WS_WCP = 8 * MiB, WS_WGLU = 9 * MiB, WS_WOUT = 11 * MiB, WS_WFI = 13 * MiB, WS_WFO = 24 * MiB;
constexpr size_t WS_SHW = 29 * MiB + 512 * 1024;
constexpr size_t WS_W1 = 30 * MiB, WS_B2 = 34 * MiB;
constexpr size_t WS_H1 = 40 * MiB;
constexpr size_t WS_UCONV = 72 * MiB, WS_A2S = 88 * MiB, WS_SGC = 112 * MiB, WS_SGS = 144 * MiB, WS_ACONV = 176 * MiB, WS_ASSM = 192 * MiB, WS_S = 208 * MiB, WS_MERGED = 224 * MiB;
constexpr size_t WS_X1B = 72 * MiB;
constexpr size_t WS_HID = 136 * MiB;
constexpr size_t WS_END = 256 * MiB;
static_assert(WS_HID + (size_t)M * FH * 2 <= WS_MERGED && WS_WFO + (size_t)D * FH * 2 <= WS_SHW && WS_B2 + (size_t)NG * 256 * KA2 * 2 <= WS_H1, "ws map");

constexpr int RING_BYTES = 131072, LDS_BYTES = 147456;

#define GAS __attribute__((address_space(1)))
#define LAS __attribute__((address_space(3)))
typedef unsigned short bf16;
typedef unsigned v4u __attribute__((ext_vector_type(4)));
typedef unsigned v2u __attribute__((ext_vector_type(2)));
typedef float f32x4 __attribute__((ext_vector_type(4)));
typedef float f32x2 __attribute__((ext_vector_type(2)));
using pg8::cvt_pk_bf16;
__device__ __forceinline__ float bf_lo(unsigned w) { return __uint_as_float(w << 16); }
__device__ __forceinline__ float bf_hi(unsigned w) { return __uint_as_float(w & 0xffff0000u); }
__device__ __forceinline__ float sigm(float x) { return __builtin_amdgcn_rcpf(1.0f + __expf(-x)); }
__device__ __forceinline__ float silu_f(float x) { return x * sigm(x); }
__device__ __forceinline__ float gelu_tanh(float x) { return x * sigm(1.5957691216057308f * (x + 0.044715f * x * x * x)); }
__device__ __forceinline__ float wave_sum(float v) {
#pragma unroll
    for (int o = 1; o < 64; o <<= 1) v += __shfl_xor(v, o);
    return v;
}
__device__ __forceinline__ v4u pack8(const f32x4 a, const f32x4 b) { v4u w; w.x = cvt_pk_bf16(a[0], a[1]); w.y = cvt_pk_bf16(a[2], a[3]); w.z = cvt_pk_bf16(b[0], b[1]); w.w = cvt_pk_bf16(b[2], b[3]); return w; }
__device__ __forceinline__ void unpack8(const v4u w, f32x4& a, f32x4& b) { a = (f32x4){bf_lo(w.x), bf_hi(w.x), bf_lo(w.y), bf_hi(w.y)}; b = (f32x4){bf_lo(w.z), bf_hi(w.z), bf_lo(w.w), bf_hi(w.w)}; }

struct BatchOrder {
    int nM, nwg, G, c; const char* A; const char* B; size_t zsA, tsA, zsB;
    __device__ __forceinline__ bool next(int i, pg8::Unit& u) const { const int L = i * G + c; if (L >= nwg) return false; u.z = L / nM; u.pm = L % nM; u.pn = 0; return true; }
    __device__ __forceinline__ const char* pa(const pg8::Unit& u) const { return A + (size_t)u.z * zsA + (size_t)u.pm * tsA; }
    __device__ __forceinline__ const char* pb(const pg8::Unit& u) const { return B + (size_t)u.z * zsB; }
    __device__ __forceinline__ void a_ready(const pg8::Unit&) const {}
    __device__ __forceinline__ void done(const pg8::Unit&) const {}
};

#define EPI_HEAD static constexpr bool PERM = true, AFTER_DRAIN = false
typedef f32x4 AccT[2][2][4][2];

struct EpiIn {
    EPI_HEAD; bf16* uconv; bf16* a2s; bf16* sgc; bf16* sgs;
    __device__ __forceinline__ void operator()(const AccT& acc, const pg8::Unit& u, int wr, int wc, int fr, int fq) const {
        const int row0 = u.pm * 256 + wr * 64 + fr;
        if (u.pn < 4) {
            const int col = u.pn * 128 + wc * 32 + 8 * fq;
#pragma unroll
            for (int ai = 0; ai < 2; ++ai)
#pragma unroll
                for (int m = 0; m < 4; ++m) { const int row = row0 + ai * 128 + m * 16; f32x4 o0, o1;
#pragma unroll
                    for (int e = 0; e < 4; ++e) { o0[e] = acc[ai][0][m][0][e] * sigm(acc[ai][1][m][0][e]); o1[e] = acc[ai][0][m][1][e] * sigm(acc[ai][1][m][1][e]); }
                    *(v4u*)(uconv + (size_t)row * CW + col) = pack8(o0, o1); }
        } else if (u.pn < 6) {
#pragma unroll
            for (int bj = 0; bj < 2; ++bj) { const int cc = (u.pn - 4) * 256 + bj * 128 + wc * 32 + 8 * fq, g = cc >> 4, h0 = cc & 15;
#pragma unroll
                for (int ai = 0; ai < 2; ++ai)
#pragma unroll
                    for (int m = 0; m < 4; ++m) { const int row = row0 + ai * 128 + m * 16;
                        *(v4u*)(a2s + ((size_t)(g * NCH + (row >> 4)) * KA2 + (row & 15) * 16 + h0)) = pack8(acc[ai][bj][m][0], acc[ai][bj][m][1]); } }
        } else {
#pragma unroll
            for (int bj = 0; bj < 2; ++bj) { const int gc = (u.pn - 6) * 256 + bj * 128 + wc * 32 + 8 * fq; bf16* dst = gc < D ? sgc + gc : sgs + (gc - D);
#pragma unroll
                for (int ai = 0; ai < 2; ++ai)
#pragma unroll
                    for (int m = 0; m < 4; ++m) { const int row = row0 + ai * 128 + m * 16; f32x4 o0, o1;
#pragma unroll
                        for (int e = 0; e < 4; ++e) { o0[e] = sigm(acc[ai][bj][m][0][e]); o1[e] = sigm(acc[ai][bj][m][1][e]); }
                        *(v4u*)(dst + (size_t)row * D) = pack8(o0, o1); } }
        }
    }
};
struct EpiState {
    EPI_HEAD; float* S;
    __device__ __forceinline__ void operator()(const AccT& acc, const pg8::Unit& u, int wr, int wc, int fr, int fq) const {
        const int col = wc * 32 + 8 * fq;
#pragma unroll
        for (int ai = 0; ai < 2; ++ai)
#pragma unroll
            for (int m = 0; m < 4; ++m) { const int rr = u.pm * 256 + ai * 128 + wr * 64 + m * 16 + fr; float* p = S + ((size_t)(u.z * NCH + rr)) * 128 + col;
                *(f32x4*)p = acc[ai][0][m][0]; *(f32x4*)(p + 4) = acc[ai][0][m][1]; }
    }
};
struct EpiStateLds {
    static constexpr bool PERM = true, AFTER_DRAIN = true;
    __device__ __forceinline__ void fused(const AccT& acc, const pg8::Unit& u, int wr, int wc, int fr, int fq, LAS unsigned char* lds, int wid, int lane) const {
        const int col = wc * 32 + 8 * fq;
#pragma unroll
        for (int ai = 0; ai < 2; ++ai)
#pragma unroll
            for (int m = 0; m < 4; ++m) { LAS float* p = (LAS float*)lds + (ai * 128 + wr * 64 + m * 16 + fr) * 128 + col;
                *(LAS f32x4*)p = acc[ai][0][m][0]; *(LAS f32x4*)(p + 4) = acc[ai][0][m][1]; }
    }
};
struct EpiSsmOut {
    EPI_HEAD; const bf16* a2s; const float* dvec; bf16* assm;
    __device__ __forceinline__ void operator()(const AccT& acc, const pg8::Unit& u, int wr, int wc, int fr, int fq) const {
        const int g = u.z; asm volatile("" : "+v"(fq), "+v"(fr));
#pragma unroll
        for (int bj = 0; bj < 2; ++bj) { const int c = bj * 128 + wc * 32 + 8 * fq, t = c >> 4, h0 = c & 15;
            const f32x4 d0 = *(const f32x4*)(dvec + g * 16 + h0), d1 = *(const f32x4*)(dvec + g * 16 + h0 + 4);
            v4u uu[2][4];
#pragma unroll
            for (int ai = 0; ai < 2; ++ai)
#pragma unroll
                for (int m = 0; m < 4; ++m) uu[ai][m] = *(const v4u*)(a2s + ((size_t)(g * NCH + u.pm * 256 + ai * 128 + wr * 64 + m * 16 + fr) * KA2 + c));
#pragma unroll
            for (int ai = 0; ai < 2; ++ai)
#pragma unroll
                for (int m = 0; m < 4; ++m) { const int rr = u.pm * 256 + ai * 128 + wr * 64 + m * 16 + fr;
                    f32x4 u0, u1; unpack8(uu[ai][m], u0, u1);
                    f32x4 y0 = acc[ai][bj][m][0] + d0 * u0, y1 = acc[ai][bj][m][1] + d1 * u1;
#pragma unroll
                    for (int e = 0; e < 4; ++e) { y0[e] = gelu_tanh(y0[e]); y1[e] = gelu_tanh(y1[e]); }
                    *(v4u*)(assm + ((size_t)(rr * LC + t) * SW + g * 16 + h0)) = pack8(y0, y1); }
            asm volatile("" ::: "memory"); }
    }
};
struct EpiConvProj {
    EPI_HEAD; const bf16* sgc; bf16* mg;
    __device__ __forceinline__ void operator()(const AccT& acc, const pg8::Unit& u, int wr, int wc, int fr, int fq) const {
#pragma unroll
        for (int bj = 0; bj < 2; ++bj) { const int col = u.pn * 256 + bj * 128 + wc * 32 + 8 * fq;
            v4u gg[2][4];
#pragma unroll
            for (int ai = 0; ai < 2; ++ai)
#pragma unroll
                for (int m = 0; m < 4; ++m) gg[ai][m] = *(const v4u*)(sgc + (size_t)(u.pm * 256 + ai * 128 + wr * 64 + m * 16 + fr) * D + col);
#pragma unroll
            for (int ai = 0; ai < 2; ++ai)
#pragma unroll
                for (int m = 0; m < 4; ++m) { const size_t off = (size_t)(u.pm * 256 + ai * 128 + wr * 64 + m * 16 + fr) * D + col;
                    f32x4 g0, g1; unpack8(gg[ai][m], g0, g1);
                    *(v4u*)(mg + off) = pack8(g0 * acc[ai][bj][m][0], g1 * acc[ai][bj][m][1]); }
            asm volatile("" ::: "memory"); }
    }
};
struct EpiSsmGlu {
    EPI_HEAD; const bf16* sgs; bf16* mg;
    __device__ __forceinline__ void operator()(const AccT& acc, const pg8::Unit& u, int wr, int wc, int fr, int fq) const {
        const int col = u.pn * 128 + wc * 32 + 8 * fq;
#pragma unroll
        for (int ai = 0; ai < 2; ++ai) {
            v4u gg[4], pp[4];
#pragma unroll
            for (int m = 0; m < 4; ++m) { const size_t off = (size_t)(u.pm * 256 + ai * 128 + wr * 64 + m * 16 + fr) * D + col; gg[m] = *(const v4u*)(sgs + off); pp[m] = *(const v4u*)(mg + off); }
#pragma unroll
            for (int m = 0; m < 4; ++m) { const size_t off = (size_t)(u.pm * 256 + ai * 128 + wr * 64 + m * 16 + fr) * D + col;
                f32x4 g0, g1, p0, p1; unpack8(gg[m], g0, g1); unpack8(pp[m], p0, p1);
#pragma unroll
                for (int e = 0; e < 4; ++e) { p0[e] += g0[e] * acc[ai][0][m][0][e] * sigm(acc[ai][1][m][0][e]); p1[e] += g1[e] * acc[ai][0][m][1][e] * sigm(acc[ai][1][m][1][e]); }
                *(v4u*)(mg + off) = pack8(p0, p1); }
            asm volatile("" ::: "memory"); }
    }
};
struct EpiOut {
    EPI_HEAD; const float* x; const float* mod; const float* n2g; bf16* x1; bf16* a2; float* rss;
    __device__ __forceinline__ void operator()(const AccT& acc, const pg8::Unit& u, int wr, int wc, int fr, int fq) const {
        const float* mb = mod + (u.pm >> 4) * NMOD6;
        float ss[2][4];
#pragma unroll
        for (int ai = 0; ai < 2; ++ai)
#pragma unroll
            for (int m = 0; m < 4; ++m) ss[ai][m] = 0.f;
#pragma unroll
        for (int bj = 0; bj < 2; ++bj) { const int col = u.pn * 256 + bj * 128 + wc * 32 + 8 * fq;
            const f32x4 gv0 = *(const f32x4*)(mb + 2 * D + col), gv1 = *(const f32x4*)(mb + 2 * D + col + 4);
            const f32x4 cs0 = *(const f32x4*)(n2g + col) * (*(const f32x4*)(mb + 4 * D + col) + 1.0f), cs1 = *(const f32x4*)(n2g + col + 4) * (*(const f32x4*)(mb + 4 * D + col + 4) + 1.0f);
#pragma unroll
            for (int ai = 0; ai < 2; ++ai) {
                f32x4 xx[4][2];
#pragma unroll
                for (int m = 0; m < 4; ++m) { const size_t off = (size_t)(u.pm * 256 + ai * 128 + wr * 64 + m * 16 + fr) * D + col;
                    xx[m][0] = __builtin_nontemporal_load((const f32x4*)(x + off)); xx[m][1] = __builtin_nontemporal_load((const f32x4*)(x + off + 4)); }
#pragma unroll
                for (int m = 0; m < 4; ++m) { const size_t off = (size_t)(u.pm * 256 + ai * 128 + wr * 64 + m * 16 + fr) * D + col;
                    const f32x4 v0 = xx[m][0] + gv0 * acc[ai][bj][m][0], v1 = xx[m][1] + gv1 * acc[ai][bj][m][1];
                    *(v4u*)(a2 + off) = pack8(v0 * cs0, v1 * cs1);
                    ss[ai][m] += (v0[0] * v0[0] + v0[1] * v0[1]) + (v0[2] * v0[2] + v0[3] * v0[3]) + (v1[0] * v1[0] + v1[1] * v1[1]) + (v1[2] * v1[2] + v1[3] * v1[3]); }
                asm volatile("" ::: "memory"); } }
#pragma unroll
        for (int ai = 0; ai < 2; ++ai)
#pragma unroll
            for (int m = 0; m < 4; ++m) { float t = ss[ai][m]; t += __shfl_xor(t, 16); t += __shfl_xor(t, 32);
                if (fq == 0) rss[(u.pm * 256 + ai * 128 + wr * 64 + m * 16 + fr) * 16 + u.pn * 4 + wc] = t; }
    }
};
struct EpiFfnIn {
    EPI_HEAD; const float* rss; const float* shw; bf16* hid;
    __device__ __forceinline__ void operator()(const AccT& acc, const pg8::Unit& u, int wr, int wc, int fr, int fq) const {
        const float* sb = shw + (u.pm >> 4) * (2 * FH) + u.pn * 256 + wc * 32 + 8 * fq;
        const f32x4 sg0 = *(const f32x4*)sb, sg1 = *(const f32x4*)(sb + 4), su0 = *(const f32x4*)(sb + 128), su1 = *(const f32x4*)(sb + 132);
        f32x4 qq[2][4];
#pragma unroll
        for (int ai = 0; ai < 2; ++ai)
#pragma unroll
            for (int m = 0; m < 4; ++m) qq[ai][m] = *(const f32x4*)(rss + (u.pm * 256 + ai * 128 + wr * 64 + m * 16 + fr) * 16 + 4 * fq);
#pragma unroll
        for (int ai = 0; ai < 2; ++ai)
#pragma unroll
            for (int m = 0; m < 4; ++m) { const int row = u.pm * 256 + ai * 128 + wr * 64 + m * 16 + fr;
                float t = (qq[ai][m][0] + qq[ai][m][1]) + (qq[ai][m][2] + qq[ai][m][3]); t += __shfl_xor(t, 16); t += __shfl_xor(t, 32);
                const float inv = rsqrtf(t * (1.0f / D) + EPS);
                const f32x4 g0 = acc[ai][0][m][0] * inv + sg0, g1 = acc[ai][0][m][1] * inv + sg1, u0 = acc[ai][1][m][0] * inv + su0, u1 = acc[ai][1][m][1] * inv + su1; f32x4 o0, o1;
#pragma unroll
                for (int e = 0; e < 4; ++e) { o0[e] = silu_f(g0[e]) * u0[e]; o1[e] = silu_f(g1[e]) * u1[e]; }
                *(v4u*)(hid + (size_t)row * FH + u.pn * 128 + wc * 32 + 8 * fq) = pack8(o0, o1); }
    }
};
struct EpiFfnOut {
    EPI_HEAD; const float* mod; const float* fg; const float* n2g; const bf16* x1; float* xo; float* rss; unsigned* cnt;
    __device__ __forceinline__ void operator()(AccT& acc, const pg8::Unit& u, int wr, int wc, int fr, int fq) const {
        const float* mb = mod + (u.pm >> 4) * NMOD6;
        {
            f32x4 gv[2][2], rc[2][2];
#pragma unroll
            for (int bj = 0; bj < 2; ++bj)
#pragma unroll
                for (int n = 0; n < 2; ++n) { const int col = u.pn * 256 + bj * 128 + wc * 32 + 8 * fq + 4 * n; gv[bj][n] = *(const f32x4*)(mb + 5 * D + col);
                    const f32x4 cs = *(const f32x4*)(n2g + col) * (*(const f32x4*)(mb + 4 * D + col) + 1.0f); rc[bj][n] = (f32x4){1.0f / cs[0], 1.0f / cs[1], 1.0f / cs[2], 1.0f / cs[3]}; }
#pragma unroll
            for (int ai = 0; ai < 2; ++ai)
#pragma unroll
                for (int m = 0; m < 4; ++m) { const int row = u.pm * 256 + ai * 128 + wr * 64 + m * 16 + fr; float ss = 0.f;
#pragma unroll
                    for (int bj = 0; bj < 2; ++bj) { const size_t off = (size_t)row * D + u.pn * 256 + bj * 128 + wc * 32 + 8 * fq;
                        f32x4 r0, r1; unpack8(*(const v4u*)(x1 + off), r0, r1);
                        const f32x4 v0 = r0 * rc[bj][0] + gv[bj][0] * acc[ai][bj][m][0], v1 = r1 * rc[bj][1] + gv[bj][1] * acc[ai][bj][m][1];
                        acc[ai][bj][m][0] = v0; acc[ai][bj][m][1] = v1;
                        ss += (v0[0] * v0[0] + v0[1] * v0[1]) + (v0[2] * v0[2] + v0[3] * v0[3]) + (v1[0] * v1[0] + v1[1] * v1[1]) + (v1[2] * v1[2] + v1[3] * v1[3]); }
                    ss += __shfl_xor(ss, 16); ss += __shfl_xor(ss, 32);
                    if (fq == 0) __hip_atomic_store(rss + row * 16 + u.pn * 4 + wc, ss, __ATOMIC_RELAXED, __HIP_MEMORY_SCOPE_AGENT); }
        }
        asm volatile("s_waitcnt vmcnt(0)" ::: "memory");
        unsigned* cw = cnt + 64 * u.pm;
        if (fr == 0 && fq == 0) __hip_atomic_fetch_add(cw, 1u, __ATOMIC_RELAXED, __HIP_MEMORY_SCOPE_AGENT);
        { unsigned sp = 0; while ((unsigned)__builtin_amdgcn_readfirstlane(__hip_atomic_load(cw, __ATOMIC_RELAXED, __HIP_MEMORY_SCOPE_AGENT)) < 32u) { __builtin_amdgcn_s_sleep(2); if (++sp > (1u << 22)) break; } }
        __builtin_amdgcn_fence(__ATOMIC_ACQUIRE, "agent");
        asm volatile("s_waitcnt vmcnt(0)" ::: "memory");
        f32x4 fv[2][2];
#pragma unroll
        for (int bj = 0; bj < 2; ++bj)
#pragma unroll
            for (int n = 0; n < 2; ++n) fv[bj][n] = *(const f32x4*)(fg + u.pn * 256 + bj * 128 + wc * 32 + 8 * fq + 4 * n);
#pragma unroll
        for (int ai = 0; ai < 2; ++ai)
#pragma unroll
            for (int m = 0; m < 4; ++m) { const int row = u.pm * 256 + ai * 128 + wr * 64 + m * 16 + fr;
                const unsigned long long* pp = (const unsigned long long*)(rss + row * 16 + 4 * fq);
                const unsigned long long w0 = __hip_atomic_load(pp, __ATOMIC_RELAXED, __HIP_MEMORY_SCOPE_AGENT), w1 = __hip_atomic_load(pp + 1, __ATOMIC_RELAXED, __HIP_MEMORY_SCOPE_AGENT);
                float t = (__uint_as_float((unsigned)w0) + __uint_as_float((unsigned)(w0 >> 32))) + (__uint_as_float((unsigned)w1) + __uint_as_float((unsigned)(w1 >> 32)));
                t += __shfl_xor(t, 16); t += __shfl_xor(t, 32);
                const float inv = rsqrtf(t * (1.0f / D) + EPS);
#pragma unroll
                for (int bj = 0; bj < 2; ++bj) { const size_t off = (size_t)row * D + u.pn * 256 + bj * 128 + wc * 32 + 8 * fq;
                    __builtin_nontemporal_store(acc[ai][bj][m][0] * inv * fv[bj][0], (f32x4*)(xo + off)); __builtin_nontemporal_store(acc[ai][bj][m][1] * inv * fv[bj][1], (f32x4*)(xo + off + 4)); } }
    }
};

struct TripleOrder {
    pg8::StaticOrder base; const char* A1; const char* B1; size_t tsA, tsB;
    __device__ __forceinline__ bool next(int i, pg8::Unit& u) const { pg8::Unit t; if (!base.next(i / 3, t)) return false; const int sub = i % 3; u.pm = t.pm;
        if (sub == 0) { u.pn = t.pn; u.z = 0; } else { u.pn = 2 * t.pn + (sub - 1); u.z = 1; } return true; }
    __device__ __forceinline__ const char* pa(const pg8::Unit& u) const { return u.z ? A1 + (size_t)u.pm * tsA : base.pa(u); }
    __device__ __forceinline__ const char* pb(const pg8::Unit& u) const { return u.z ? B1 + (size_t)u.pn * tsB : base.pb(u); }
    __device__ __forceinline__ void a_ready(const pg8::Unit&) const {}
    __device__ __forceinline__ void done(const pg8::Unit&) const {}
};
struct EpiMix {
    EPI_HEAD; const bf16* sgc; const bf16* sgs; bf16* mg;
    __device__ __forceinline__ void operator()(const AccT& acc, const pg8::Unit& u, int wr, int wc, int fr, int fq) const {
        if (u.z == 0) { const EpiConvProj e{sgc, mg}; e(acc, u, wr, wc, fr, fq); } else { const EpiSsmGlu e{sgs, mg}; e(acc, u, wr, wc, fr, fq); }
    }
};

__device__ __forceinline__ int ileave(int n0, int half) { return n0 < half ? 256 * (n0 >> 7) + (n0 & 127) : 256 * ((n0 - half) >> 7) + 128 + ((n0 - half) & 127); }
__device__ __forceinline__ void transpose_item(const float* W, int K, int N, bf16* WT, int mode, LAS float* scr, int item, int lane) {
    const int nblk = N / 32, kb = item / nblk, nb = item % nblk, k0 = 64 * kb, n0 = 32 * nb;
    int r0 = n0;
    if (mode == 1) r0 = n0 < 1024 ? ileave(n0, 512) : n0;
    else if (mode == 2) r0 = ileave(n0, 1024);
    else if (mode == 3) r0 = ileave(n0, FH);
    float tv[32];
#pragma unroll
    for (int i = 0; i < 32; ++i) tv[i] = __builtin_nontemporal_load(W + (size_t)(k0 + 2 * i + (lane >> 5)) * N + n0 + (lane & 31));
#pragma unroll
    for (int i = 0; i < 32; ++i) scr[(2 * i + (lane >> 5)) * 33 + (lane & 31)] = tv[i];
    asm volatile("s_waitcnt lgkmcnt(0)" ::: "memory");
    const int c = lane & 7;
#pragma unroll
    for (int j = 0; j < 4; ++j) { const int n = (lane >> 3) + 8 * j; const LAS float* s = scr + (8 * c) * 33 + n;
        v4u o; o.x = cvt_pk_bf16(s[0 * 33], s[1 * 33]); o.y = cvt_pk_bf16(s[2 * 33], s[3 * 33]); o.z = cvt_pk_bf16(s[4 * 33], s[5 * 33]); o.w = cvt_pk_bf16(s[6 * 33], s[7 * 33]);
        *(v4u*)(WT + (size_t)(r0 + n) * K + k0 + 8 * c) = o; }
    asm volatile("s_waitcnt lgkmcnt(0)" ::: "memory");
}
__device__ __forceinline__ void sincos_d(double x, double& s, double& c) {
    const double k = rint(x * 0.63661977236758134308);
    double r = fma(-k, 1.57079632679489655800e+00, x); r = fma(-k, 6.12323399573676603587e-17, r);
    const int q = ((int)k) & 3; const double r2 = r * r;
    double sp = -1.0 / 1307674368000.0; sp = fma(sp, r2, 1.0 / 6227020800.0); sp = fma(sp, r2, -1.0 / 39916800.0); sp = fma(sp, r2, 1.0 / 362880.0); sp = fma(sp, r2, -1.0 / 5040.0); sp = fma(sp, r2, 1.0 / 120.0); sp = fma(sp, r2, -1.0 / 6.0); sp = fma(sp * r2, r, r);
    double cp = 1.0 / 20922789888000.0; cp = fma(cp, r2, -1.0 / 87178291200.0); cp = fma(cp, r2, 1.0 / 479001600.0); cp = fma(cp, r2, -1.0 / 3628800.0); cp = fma(cp, r2, 1.0 / 40320.0); cp = fma(cp, r2, -1.0 / 720.0); cp = fma(cp, r2, 1.0 / 24.0); cp = fma(cp, r2, -0.5); cp = fma(cp, r2, 1.0);
    s = (q == 0) ? sp : (q == 1) ? cp : (q == 2) ? -sp : -cp;
    c = (q == 0) ? cp : (q == 1) ? -sp : (q == 2) ? -cp : sp;
}
__device__ __forceinline__ void ssm_abar(const float* a_re, const float* a_im, const float* log_dt, int g, int p, double& er, double& ei, double& ar, double& ai) {
    const double dt = (double)expf(log_dt[g]); ar = (double)a_re[g * SP + p]; ai = (double)a_im[g * SP + p];
    const double x = dt * ar;
    double mag = 1.0 / 362880.0; mag = fma(mag, x, 1.0 / 40320.0); mag = fma(mag, x, 1.0 / 5040.0); mag = fma(mag, x, 1.0 / 720.0); mag = fma(mag, x, 1.0 / 120.0); mag = fma(mag, x, 1.0 / 24.0); mag = fma(mag, x, 1.0 / 6.0); mag = fma(mag, x, 0.5); mag = fma(mag, x, 1.0); mag = fma(mag, x, 1.0);
    double s, c; sincos_d(dt * ai, s, c); er = mag * c; ei = mag * s;
}

#define XB_TMO      128
#define XB_XCNT(j)  (256  + 64 * (j))
#define XB_XSUB(j)  (1280 + 64 * (j))
#define XB_XGEN(j)  (2304 + 64 * (j))
#define XB_TOP      3328
#define XB_TOPGEN   3392
#define XCD_BAR_WORDS 3456
#define XB_SPIN_CAP (1u << 18)

__device__ __forceinline__ unsigned xb_ld(unsigned* p)              { return __hip_atomic_load(p, __ATOMIC_RELAXED, __HIP_MEMORY_SCOPE_AGENT); }
__device__ __forceinline__ unsigned xb_add(unsigned* p, unsigned v) { return __hip_atomic_fetch_add(p, v, __ATOMIC_RELAXED, __HIP_MEMORY_SCOPE_AGENT); }
__device__ __forceinline__ unsigned xb_xcc_id() { return (unsigned)__builtin_amdgcn_s_getreg((3 << 11) | 20) & 0xFu; }
#define XB_SPIN(cond, bar) do { unsigned _sp = 0; while (cond) { __builtin_amdgcn_s_sleep(1); \
    if ((++_sp & 255u) == 0u) { if (xb_ld(&(bar)[XB_TMO])) break; if (_sp > XB_SPIN_CAP) { atomicAdd(&(bar)[XB_TMO], 1u); break; } } } } while (0)

struct XcdBarrier {
    unsigned* bar; unsigned x;
    volatile LAS unsigned* st;
};

__device__ __forceinline__ XcdBarrier xcd_barrier_post(unsigned* bar, volatile LAS unsigned* st) {
    XcdBarrier b; b.bar = bar; b.x = xb_xcc_id(); b.st = st;
    if (threadIdx.x == 0) (void)xb_add(&bar[XB_XCNT(b.x)], 1u);
    return b;
}
__device__ __forceinline__ void xcd_barrier_complete(unsigned* bar, unsigned x, unsigned& nloc, unsigned& nx) {
    const unsigned G = gridDim.x * gridDim.y * gridDim.z;
    unsigned sum, cnt, mine, sp = 0u;
    for (;;) {
        sum = 0u; cnt = 0u; mine = 0u;
#pragma unroll
        for (unsigned j = 0; j < 16; ++j) { const unsigned c = xb_ld(&bar[XB_XCNT(j)]); sum += c; cnt += (c > 0u) ? 1u : 0u; mine = (j == x) ? c : mine; }
        if (sum == G) break;
        __builtin_amdgcn_s_sleep(1);
        if ((++sp & 255u) == 0u) { if (xb_ld(&bar[XB_TMO])) break; if (sp > XB_SPIN_CAP) { atomicAdd(&bar[XB_TMO], 1u); break; } }
    }
    nloc = mine > 0u ? mine : 1u; nx = cnt > 0u ? cnt : 1u;
}

__device__ __forceinline__ void xcd_barrier(const XcdBarrier& b) {
    asm volatile("s_waitcnt vmcnt(0)" ::: "memory");
    __syncthreads();
    if (threadIdx.x == 0) {
        unsigned* bar = b.bar;
        __builtin_amdgcn_s_waitcnt(0);
        unsigned nloc = b.st[0], nx = b.st[1];
        if (nloc == 0u) { xcd_barrier_complete(bar, b.x, nloc, nx); b.st[0] = nloc; b.st[1] = nx; }
        const unsigned old = xb_add(&bar[XB_XSUB(b.x)], 1u);
        const unsigned gen = old / nloc;
        if (old + 1u == (gen + 1u) * nloc) {
            __builtin_amdgcn_fence(__ATOMIC_RELEASE, "agent");
            asm volatile("s_waitcnt vmcnt(0)" ::: "memory");
            const unsigned og = xb_add(&bar[XB_TOP], 1u);
            const unsigned tg = og / nx;
            if (og + 1u == (tg + 1u) * nx) xb_add(&bar[XB_TOPGEN], 1u);
            else XB_SPIN(xb_ld(&bar[XB_TOPGEN]) == tg, bar);
            __builtin_amdgcn_fence(__ATOMIC_ACQUIRE, "agent");
            xb_add(&bar[XB_XGEN(b.x)], 1u);
            asm volatile("s_waitcnt vmcnt(0)" ::: "memory");
        } else {
            XB_SPIN(xb_ld(&bar[XB_TOPGEN]) == gen, bar);
            __builtin_amdgcn_fence(__ATOMIC_ACQUIRE, "agent");
            asm volatile("s_waitcnt vmcnt(0)" ::: "memory");
        }
    }
    __syncthreads();
}

struct Args { const float* in[25]; float* out; unsigned char* ws; int ph_lo, ph_hi; };
static_assert(sizeof(Args) == 25 * 8 + 8 + 8 + 8, "Args has no padding");

__global__ void __launch_bounds__(NTHR, 2) fwd_megakernel(Args args) {
    extern __shared__ __attribute__((aligned(16))) unsigned char lds_raw[];
    LAS unsigned char* lds = (LAS unsigned char*)lds_raw;
    const int tid = threadIdx.x, lane = tid & 63, wave = __builtin_amdgcn_readfirstlane(tid >> 6);
    const int G = gridDim.x, bid = blockIdx.x;
    const int gw = bid * NWAVES + wave, NGW = G * NWAVES;
    unsigned char* ws = args.ws;
    const float* x = args.in[0]; const float* cvec = args.in[1]; const float* w_ada = args.in[2]; const float* b_ada = args.in[3]; const float* n1g = args.in[4];
    const float* w_in = args.in[5]; const float* conv_w = args.in[6]; const float* conv_b = args.in[7]; const float* cln_g = args.in[8]; const float* cln_b = args.in[9];
    const float* conv_proj = args.in[10]; const float* a_re = args.in[11]; const float* a_im = args.in[12]; const float* b_re = args.in[13]; const float* b_im = args.in[14];
    const float* c_re = args.in[15]; const float* c_im = args.in[16]; const float* ssm_d = args.in[17]; const float* log_dt = args.in[18]; const float* ssm_glu = args.in[19];
    const float* w_out = args.in[20]; const float* n2g = args.in[21]; const float* w_ffn_in = args.in[22]; const float* w_ffn_out = args.in[23]; const float* final_g = args.in[24];
    float* out = args.out;
    float* MOD = (float*)(ws + WS_MOD); float* RSS1 = (float*)(ws + WS_RSS1); float* RSS2 = (float*)(ws + WS_RSS2); float* SHW = (float*)(ws + WS_SHW);
    bf16* WIN = (bf16*)(ws + WS_WIN); bf16* WCP = (bf16*)(ws + WS_WCP); bf16* WGLU = (bf16*)(ws + WS_WGLU); bf16* WOUT = (bf16*)(ws + WS_WOUT); bf16* WFI = (bf16*)(ws + WS_WFI); bf16* WFO = (bf16*)(ws + WS_WFO);
    bf16* W1T = (bf16*)(ws + WS_W1); bf16* B2T = (bf16*)(ws + WS_B2); bf16* H1 = (bf16*)(ws + WS_H1);
    bf16* UCONV = (bf16*)(ws + WS_UCONV); bf16* A2S = (bf16*)(ws + WS_A2S); bf16* SGC = (bf16*)(ws + WS_SGC); bf16* SGS = (bf16*)(ws + WS_SGS);
    bf16* ACONV = (bf16*)(ws + WS_ACONV); bf16* ASSM = (bf16*)(ws + WS_ASSM); float* SST = (float*)(ws + WS_S); bf16* MG = (bf16*)(ws + WS_MERGED); bf16* HID = (bf16*)(ws + WS_HID); bf16* X1B = (bf16*)(ws + WS_X1B);
    cg::grid_group grid = cg::this_grid();
    const int lo = args.ph_lo, hi = args.ph_hi;
    volatile LAS unsigned* bst = (volatile LAS unsigned*)(lds + RING_BYTES + 1024);
    if (tid < 2) bst[tid] = 0u;
    __syncthreads();
    XcdBarrier xbar = xcd_barrier_post((unsigned*)(ws + WS_BAR), bst);
    if (lo == 0x7fffffff) grid.sync();
#ifndef PHMASK
#define PHMASK 0xFF
#endif
#define IN(k) ((((PHMASK) >> (k)) & 1) && lo <= (k) && (k) < hi)
#define GRID_SYNC() do { xcd_barrier(xbar); } while (0)
#define SEAM(k) do { if (IN(k) && IN((k) + 1)) GRID_SYNC(); } while (0)
#define REPS(k) _Pragma("unroll 1") for (int rep_ = 0; rep_ < ((((DUP_MASK) >> (k)) & 1) ? 2 : 1); ++rep_)

    if (IN(0)) REPS(0) { if (rep_) GRID_SYNC();
        {
            LAS float* scr = (LAS float*)(lds + wave * 16384);
            constexpr int I_IN = (D / 64) * (INC / 32), I_CP = (CW / 64) * (D / 32), I_GLU = (SW / 64) * (2 * D / 32), I_OUT = (D / 64) * (D / 32), I_FI = (D / 64) * (2 * FH / 32), I_FO = (FH / 64) * (D / 32);
            constexpr int NITEMS = I_IN + I_FI;
            const int ngv = NMOD6 / 64;
            const int tw0 = (G >= 2 * ngv) ? (bid - ngv) * NWAVES + wave : gw, tnw = (G >= 2 * ngv) ? (G - ngv) * NWAVES : NGW;
            for (int it = (tw0 >= 0 ? tw0 : NITEMS); it < NITEMS; it += tnw) {
                if (it < I_FI) transpose_item(w_ffn_in, D, 2 * FH, WFI, 3, scr, it, lane);
                else transpose_item(w_in, D, INC, WIN, 1, scr, it - I_FI, lane);
            }
        }
        {
            __syncthreads();
            LAS float* red = (LAS float*)lds;
            LAS float* sc = (LAS float*)(lds + 8192);
            if (bid < NMOD6 / 64) { for (int e = tid; e < BATCH * D; e += NTHR) sc[e] = silu_f(cvec[e]); }
            __syncthreads();
            for (int it = bid; it < NMOD6 / 64; it += G) {
                const int col = it * 64 + lane; float a0 = 0.f, a1 = 0.f, a2 = 0.f, a3 = 0.f;
#pragma unroll 1
                for (int k0 = wave * 128; k0 < wave * 128 + 128; k0 += 32) { float wv[32];
#pragma unroll
                    for (int j = 0; j < 32; ++j) wv[j] = __builtin_nontemporal_load(w_ada + (size_t)(k0 + j) * NMOD6 + col);
#pragma unroll
                    for (int j = 0; j < 32; ++j) { a0 += wv[j] * sc[k0 + j]; a1 += wv[j] * sc[D + k0 + j]; a2 += wv[j] * sc[2 * D + k0 + j]; a3 += wv[j] * sc[3 * D + k0 + j]; } }
                red[(wave * 4 + 0) * 64 + lane] = a0; red[(wave * 4 + 1) * 64 + lane] = a1; red[(wave * 4 + 2) * 64 + lane] = a2; red[(wave * 4 + 3) * 64 + lane] = a3;
                __syncthreads();
                if (tid < 256) { const int b = tid >> 6, c = tid & 63; float t = b_ada[it * 64 + c];
#pragma unroll
                    for (int w = 0; w < 8; ++w) t += red[(w * 4 + b) * 64 + c];
                    __hip_atomic_store(MOD + b * NMOD6 + it * 64 + c, t, __ATOMIC_RELAXED, __HIP_MEMORY_SCOPE_AGENT); }
                asm volatile("s_waitcnt vmcnt(0)" ::: "memory");
                __syncthreads();
                if (tid == 0) __hip_atomic_fetch_add((unsigned*)(ws + WS_GCNT), 1u, __ATOMIC_RELAXED, __HIP_MEMORY_SCOPE_AGENT);
            }
        }
        {
            LAS f32x2* PW = (LAS f32x2*)(lds);
            LAS f32x2* QQ = (LAS f32x2*)(lds + 8704);
            LAS f32x2* BB = (LAS f32x2*)(lds + 9216);
            LAS f32x2* CC = (LAS f32x2*)(lds + 17408);
            LAS float* KT = (LAS float*)(lds + 25600);
            for (int it = bid; it < NG * 8; it += G) {
                const int g = it >> 3, rb = it & 7;
                __syncthreads();
                if (tid < 64) {
                    double er, ei, ar, ai; ssm_abar(a_re, a_im, log_dt, g, tid, er, ei, ar, ai);
                    const double nr = er - 1.0, ni = ei, den = ar * ar + ai * ai;
                    QQ[tid] = (f32x2){(float)((nr * ar + ni * ai) / den), (float)((ni * ar - nr * ai) / den)};
                    double pr = 1.0, pi = 0.0;
                    for (int j = 0; j <= 16; ++j) { PW[j * 64 + tid] = (f32x2){(float)pr, (float)pi}; const double t = pr * er - pi * ei; pi = pr * ei + pi * er; pr = t; }
                }
                for (int e = tid; e < 1024; e += NTHR) CC[e] = (f32x2){c_re[g * 1024 + e], c_im[g * 1024 + e]};
                __syncthreads();
                for (int e = tid; e < 1024; e += NTHR) { const f32x2 q = QQ[e >> 4]; const float br = b_re[g * 1024 + e], bi = b_im[g * 1024 + e]; BB[e] = (f32x2){q.x * br - q.y * bi, q.x * bi + q.y * br}; }
                __syncthreads();
                if (rb < 4) {
                    const int nl = 4 * rb + 4, pair = tid & 255, ho = pair >> 4, hi = pair & 15;
                    for (int j = tid >> 8; j < nl; j += 2) {
                        float s = 0.f;
                        for (int p = 0; p < 64; ++p) { const f32x2 c = CC[ho * 64 + p], w = PW[j * 64 + p], b = BB[p * 16 + hi];
                            const float cr = c.x * w.x - c.y * w.y, ci = c.x * w.y + c.y * w.x; s += cr * b.x - ci * b.y; }
                        KT[j * 256 + pair] = s;
                    }
                    __syncthreads();
                    for (int r = wave * 8; r < wave * 8 + 8; ++r) { const int n = 64 * rb + r, t = n >> 4, ho = n & 15;
#pragma unroll
                        for (int i = 0; i < 3; ++i) { const int kp = lane + 64 * i; float v[2];
#pragma unroll
                            for (int h = 0; h < 2; ++h) { const int k = 2 * kp + h;
                                if (k < 256) { const int s = k >> 4, hi = k & 15; v[h] = (s <= t) ? KT[(t - s) * 256 + ho * 16 + hi] : 0.f; }
                                else { const int p = (k - 256) & 63; const f32x2 c = CC[ho * 64 + p], w = PW[(t + 1) * 64 + p]; v[h] = (k < 320) ? (c.x * w.x - c.y * w.y) : -(c.x * w.y + c.y * w.x); } }
                            *(unsigned*)(B2T + ((size_t)(g * 256 + n) * KA2 + 2 * kp)) = cvt_pk_bf16(v[0], v[1]); } }
                } else {
                    for (int r = wave * 8; r < wave * 8 + 8; ++r) { const int n = 64 * (rb - 4) + r, p = n & 63;
#pragma unroll
                        for (int i = 0; i < 2; ++i) { const int kp = lane + 64 * i; float v[2];
#pragma unroll
                            for (int h = 0; h < 2; ++h) { const int k = 2 * kp + h, s = k >> 4, hi = k & 15; const f32x2 w = PW[(15 - s) * 64 + p], b = BB[p * 16 + hi];
                                v[h] = (n < 64) ? (w.x * b.x - w.y * b.y) : (n < 128) ? (w.x * b.y + w.y * b.x) : 0.f; }
                            *(unsigned*)(W1T + ((size_t)(g * 256 + n) * 256 + 2 * kp)) = cvt_pk_bf16(v[0], v[1]); } }
                }
            }
            __syncthreads();
        }
    }
    if (IN(0) && IN(1)) {
        if (tid == 0) { unsigned sp = 0; while (__hip_atomic_load((unsigned*)(ws + WS_GCNT), __ATOMIC_RELAXED, __HIP_MEMORY_SCOPE_AGENT) < (unsigned)(NMOD6 / 64)) { __builtin_amdgcn_s_sleep(2); if (++sp > (1u << 22)) break; }
            __builtin_amdgcn_fence(__ATOMIC_ACQUIRE, "agent"); asm volatile("s_waitcnt vmcnt(0)" ::: "memory"); }
        __syncthreads();
    }
    for (int xs_ = 0; xs_ < EXTRA_SYNCS; ++xs_) GRID_SYNC();

    if (IN(1)) REPS(1) { if (rep_) GRID_SYNC();
        for (int rb = gw * 8; rb < M; rb += NGW * 8) {
            const float* mb = MOD + (rb >> 12) * NMOD6;
            f32x4 v[8][4]; float inv[8];
#pragma unroll
            for (int q = 0; q < 8; ++q) { const f32x4* xr = (const f32x4*)(x + (size_t)(rb + q) * D) + lane;
#pragma unroll
                for (int j = 0; j < 4; ++j) v[q][j] = __builtin_nontemporal_load(xr + 64 * j); }
#pragma unroll
            for (int q = 0; q < 8; ++q) { float s = 0.f;
#pragma unroll
                for (int j = 0; j < 4; ++j) s += (v[q][j][0] * v[q][j][0] + v[q][j][1] * v[q][j][1]) + (v[q][j][2] * v[q][j][2] + v[q][j][3] * v[q][j][3]);
                inv[q] = rsqrtf(wave_sum(s) * (1.0f / D) + EPS); }
#pragma unroll
            for (int j = 0; j < 4; ++j) { const int col = lane * 4 + 256 * j;
                const f32x4 gsc = (*(const f32x4*)(n1g + col)) * (*(const f32x4*)(mb + D + col) + 1.0f), sh = *(const f32x4*)(mb + col);
#pragma unroll
                for (int q = 0; q < 8; ++q) { const f32x4 h = v[q][j] * inv[q] * gsc + sh;
                    v2u o; o.x = cvt_pk_bf16(h[0], h[1]); o.y = cvt_pk_bf16(h[2], h[3]); *(v2u*)(H1 + (size_t)(rb + q) * D + col) = o; } }
        }
    }
    SEAM(1);

    if (IN(2)) REPS(2) { if (rep_) GRID_SYNC();
        pg8::Gemm g{D, D, D}; pg8::StaticOrder S; S.init(M, INC, G, bid, H1, D, WIN, D);
        EpiIn E{UCONV, A2S, SGC, SGS};
        GEMM_CALL(EpiIn, pg8::StaticOrder)(lds, g, S, E);
        {
            constexpr int NU = (M / 256) * (INC / 256), I_CP = (CW / 64) * (D / 32), I_GLU = (SW / 64) * (2 * D / 32), I_OUT = (D / 64) * (D / 32);
            int first = NU % G, nhelp = G - first; if (first == 0) nhelp = G;
            if (bid >= first) {
                LAS float* scr = (LAS float*)(lds + wave * 16384);
                const int hw0 = (bid - first) * NWAVES + wave, hnw = nhelp * NWAVES;
                for (int it = hw0; it < I_GLU + I_OUT + I_CP; it += hnw) {
                    if (it < I_GLU) transpose_item(ssm_glu, SW, 2 * D, WGLU, 2, scr, it, lane);
                    else if (it < I_GLU + I_OUT) transpose_item(w_out, D, D, WOUT, 0, scr, it - I_GLU, lane);
                    else transpose_item(conv_proj, CW, D, WCP, 0, scr, it - I_GLU - I_OUT, lane);
                }
                for (int v = hw0; v < 2 * FH; v += hnw) {
                    const v4u w0 = *(const v4u*)(WFI + (size_t)v * D + lane * 8), w1 = *(const v4u*)(WFI + (size_t)v * D + 512 + lane * 8);
                    f32x4 a0, a1, b0, b1; unpack8(w0, a0, a1); unpack8(w1, b0, b1);
        #pragma unroll
                    for (int b = 0; b < BATCH; ++b) { const float* sh = MOD + b * NMOD6 + 3 * D;
                        const f32x4 s0 = *(const f32x4*)(sh + lane * 8), s1 = *(const f32x4*)(sh + lane * 8 + 4), s2 = *(const f32x4*)(sh + 512 + lane * 8), s3 = *(const f32x4*)(sh + 512 + lane * 8 + 4);
                        const f32x4 pr = a0 * s0 + a1 * s1 + b0 * s2 + b1 * s3; const float t = wave_sum((pr[0] + pr[1]) + (pr[2] + pr[3]));
                        if (lane == 0) SHW[b * (2 * FH) + v] = t; }
                }
            }
        }
    }
    SEAM(2);

    if (IN(3)) REPS(3) { if (rep_) GRID_SYNC();
        {
            const int cp = tid & 255, th = tid >> 8;
            LAS float* OUTT = (LAS float*)(lds + 65536);
            const bool bal = (G == 256);
            const int nmine = bal ? (bid < NG * 4 ? 0 : 4) : (M / 32 - bid + G - 1) / G;
            for (int ii = 0; ii < nmine; ++ii) {
                const int item = bal ? (bid - NG * 4) * 4 + ii : bid + ii * G;
                const int t0 = item * 32, pos0 = t0 & (SEQ - 1);
                __syncthreads();
                for (int e = tid; e < 62 * 64; e += NTHR) { const int r = e >> 6, ch = e & 63; v4u v = {0u, 0u, 0u, 0u};
                    if (pos0 - 30 + r >= 0) v = *(const v4u*)(UCONV + (size_t)(t0 - 30 + r) * CW + ch * 8);
                    *(LAS v4u*)(lds + r * 1024 + ch * 16) = v; }
                f32x2 w[CK];
#pragma unroll
                for (int j = 0; j < CK; ++j) w[j] = *(const f32x2*)(conv_w + j * CW + 2 * cp);
                f32x2 acc[16]; const f32x2 bias = *(const f32x2*)(conv_b + 2 * cp);
#pragma unroll
                for (int q = 0; q < 16; ++q) acc[q] = bias;
                __syncthreads();
#pragma unroll
                for (int i = 0; i < 46; ++i) { const unsigned uv = *(const LAS unsigned*)(lds + (th * 16 + i) * 1024 + cp * 4); const f32x2 vv = {bf_lo(uv), bf_hi(uv)};
#pragma unroll
                    for (int q = 0; q < 16; ++q) { const int j = i - q; if (j >= 0 && j < CK) acc[q] += vv * w[j]; } }
#pragma unroll
                for (int q = 0; q < 16; ++q) *(LAS f32x2*)(OUTT + (th * 16 + q) * 512 + 2 * cp) = acc[q];
                __syncthreads();
#pragma unroll
                for (int q = 0; q < 4; ++q) { const int tt = wave * 4 + q; const LAS float* rowp = OUTT + tt * 512;
                    f32x4 a = *(const LAS f32x4*)(rowp + lane * 4), b = *(const LAS f32x4*)(rowp + 256 + lane * 4);
                    const float mu = wave_sum((a[0] + a[1]) + (a[2] + a[3]) + (b[0] + b[1]) + (b[2] + b[3])) * (1.0f / CW);
                    a -= mu; b -= mu;
                    const float var = wave_sum((a[0] * a[0] + a[1] * a[1]) + (a[2] * a[2] + a[3] * a[3]) + (b[0] * b[0] + b[1] * b[1]) + (b[2] * b[2] + b[3] * b[3])) * (1.0f / CW);
                    const float rstd = rsqrtf(var + EPS);
                    a = a * rstd * (*(const f32x4*)(cln_g + lane * 4)) + *(const f32x4*)(cln_b + lane * 4);
                    b = b * rstd * (*(const f32x4*)(cln_g + 256 + lane * 4)) + *(const f32x4*)(cln_b + 256 + lane * 4);
                    v2u o0, o1; o0.x = cvt_pk_bf16(silu_f(a[0]), silu_f(a[1])); o0.y = cvt_pk_bf16(silu_f(a[2]), silu_f(a[3])); o1.x = cvt_pk_bf16(silu_f(b[0]), silu_f(b[1])); o1.y = cvt_pk_bf16(silu_f(b[2]), silu_f(b[3]));
                    bf16* dst = ACONV + (size_t)(t0 + tt) * CW; *(v2u*)(dst + lane * 4) = o0; *(v2u*)(dst + 256 + lane * 4) = o1; }
            }
            __syncthreads();
        }
        if (bid < NG * 4) {
            const int L = bid, g = L >> 2, b = L & 3;
            {
                pg8::Gemm gg{256, KA2, 256}; BatchOrder S{4, NG * 4, 1 << 20, L, (const char*)A2S, (const char*)W1T, (size_t)NCH * KA2 * 2, (size_t)256 * KA2 * 2, (size_t)256 * 256 * 2};
                EpiStateLds E{};
                GEMM_CALL(EpiStateLds, BatchOrder)(lds, gg, S, E);
            }
            __syncthreads();
            {
                double er, ei, ar, ai; ssm_abar(a_re, a_im, log_dt, g, lane, er, ei, ar, ai);
#pragma unroll
                for (int j = 0; j < 4; ++j) { const double t = er * er - ei * ei; ei = 2.0 * er * ei; er = t; }
                const float alr = (float)er, ali = (float)ei;
#pragma unroll
                for (int j = 0; j < 5; ++j) { const double t = er * er - ei * ei; ei = 2.0 * er * ei; er = t; }
                const float a32r = (float)er, a32i = (float)ei;
                const LAS float* sl = (const LAS float*)lds + wave * 32 * 128; LAS f32x2* EE = (LAS f32x2*)(lds + RING_BYTES + 2048);
                float xr = 0.f, xi = 0.f;
#pragma unroll 8
                for (int c = 0; c < 32; ++c) { const float sr = sl[c * 128 + lane], si = sl[c * 128 + 64 + lane]; const float nr = alr * xr - ali * xi + sr, ni = alr * xi + ali * xr + si; xr = nr; xi = ni; }
                EE[wave * 64 + lane] = (f32x2){xr, xi};
                __syncthreads();
                xr = 0.f; xi = 0.f;
                for (int v = 0; v < wave; ++v) { const f32x2 e = EE[v * 64 + lane]; const float nr = a32r * xr - a32i * xi + e.x, ni = a32r * xi + a32i * xr + e.y; xr = nr; xi = ni; }
                bf16* dst = A2S + (size_t)(g * NCH + b * CPB + wave * 32) * KA2 + 256 + lane;
#pragma unroll 8
                for (int c = 0; c < 32; ++c) {
                    const unsigned pk = cvt_pk_bf16(xr, xi); dst[(size_t)c * KA2] = (bf16)(pk & 0xffffu); dst[(size_t)c * KA2 + 64] = (bf16)(pk >> 16);
                    const float sr = sl[c * 128 + lane], si = sl[c * 128 + 64 + lane];
                    const float nr = alr * xr - ali * xi + sr, ni = alr * xi + ali * xr + si; xr = nr; xi = ni;
                }
            }
            asm volatile("s_waitcnt vmcnt(0)" ::: "memory");
            __syncthreads(); __builtin_amdgcn_fence(__ATOMIC_ACQUIRE, "agent");
            {
                pg8::Gemm gg{KA2, KA2, KA2}; BatchOrder S{4, NG * 4, 1 << 20, L, (const char*)A2S, (const char*)B2T, (size_t)NCH * KA2 * 2, (size_t)256 * KA2 * 2, (size_t)256 * KA2 * 2};
                EpiSsmOut E{A2S, ssm_d, ASSM};
                GEMM_CALL(EpiSsmOut, BatchOrder)(lds, gg, S, E);
            }
        }
    }
    SEAM(3);

    if (IN(4)) REPS(4) { if (rep_) GRID_SYNC();
        pg8::Gemm g{SW, SW, SW}; TripleOrder S; S.base.init(M, D, G, bid, ACONV, CW, WCP, CW); S.A1 = (const char*)ASSM; S.B1 = (const char*)WGLU; S.tsA = (size_t)256 * SW * 2; S.tsB = (size_t)256 * SW * 2;
        EpiMix E{SGC, SGS, MG};
        GEMM_CALL(EpiMix, TripleOrder)(lds, g, S, E);
    }
    SEAM(4);

    if (IN(5)) REPS(5) { if (rep_) GRID_SYNC();
        pg8::Gemm g{D, D, D}; pg8::StaticOrder S; S.init(M, D, G, bid, MG, D, WOUT, D);
        EpiOut E{x, MOD, n2g, X1B, H1, RSS1};
        GEMM_CALL(EpiOut, pg8::StaticOrder)(lds, g, S, E);
    }
    SEAM(5);

    if (IN(6)) REPS(6) { if (rep_) GRID_SYNC();
        pg8::Gemm g{D, D, D}; pg8::StaticOrder S; S.init(M, 2 * FH, G, bid, H1, D, WFI, D);
        EpiFfnIn E{RSS1, SHW, HID};
        GEMM_CALL(EpiFfnIn, pg8::StaticOrder)(lds, g, S, E);
        {
            constexpr int NU = (M / 256) * (2 * FH / 256), I_FO = (FH / 64) * (D / 32);
            int first = NU % G, nhelp = G - first; if (first == 0) nhelp = G;
            if (bid >= first) {
                LAS float* scr = (LAS float*)(lds + wave * 16384);
                for (int it = (bid - first) * NWAVES + wave; it < I_FO; it += nhelp * NWAVES) transpose_item(w_ffn_out, FH, D, WFO, 0, scr, it, lane);
            }
        }
    }
    SEAM(6);

    if (IN(7)) REPS(7) { if (rep_) GRID_SYNC();
        pg8::Gemm g{FH, FH, FH}; pg8::StaticOrder S; S.init(M, D, G, bid, HID, FH, WFO, FH);
        EpiFfnOut E{MOD, final_g, n2g, H1, out, RSS2, (unsigned*)(ws + WS_PCNT)};
        GEMM_CALL(EpiFfnOut, pg8::StaticOrder)(lds, g, S, E);
    }

#undef IN
#undef SEAM
}

extern "C" void kernel_launch(void* const* d_in, const int* in_sizes, int n_in, void* d_out, int out_size, void* d_ws, size_t ws_size, hipStream_t stream) {
    static int grid = 0;
    if (grid == 0) {
        if (n_in != 25 || out_size != M * D || ws_size < WS_END) { fprintf(stderr, "kernel_launch: unexpected shapes (n_in %d out %d ws %zu)\n", n_in, out_size, ws_size); grid = -1; return; }
        int dev = 0, cus = 0, per_cu = 0;
        (void)hipGetDevice(&dev); (void)hipDeviceGetAttribute(&cus, hipDeviceAttributeMultiprocessorCount, dev);
        if (hipFuncSetAttribute((const void*)fwd_megakernel, hipFuncAttributeMaxDynamicSharedMemorySize, LDS_BYTES) != hipSuccess) { fprintf(stderr, "kernel_launch: hipFuncSetAttribute failed\n"); grid = -1; return; }
        if (hipOccupancyMaxActiveBlocksPerMultiprocessor(&per_cu, (const void*)fwd_megakernel, NTHR, LDS_BYTES) != hipSuccess || per_cu < 1) { fprintf(stderr, "kernel_launch: occupancy query failed (%d)\n", per_cu); (void)hipGetLastError(); per_cu = 1; }
        grid = cus * (per_cu > 1 ? 1 : per_cu);
        if (grid <= 0) grid = 256;
    }
    if (grid < 0) return;
    (void)hipMemsetAsync((char*)d_ws + WS_BAR, 0, BAR_BYTES, stream);
    Args a{};
    for (int i = 0; i < 25; ++i) a.in[i] = (const float*)d_in[i];
    a.out = (float*)d_out; a.ws = (unsigned char*)d_ws;
#if MK_PER_PHASE
    for (int ph = 0; ph < NPHASE; ++ph) { a.ph_lo = ph; a.ph_hi = ph + 1; hipLaunchKernelGGL(fwd_megakernel, dim3(grid), dim3(NTHR), LDS_BYTES, stream, a); }
#else
    a.ph_lo = 0; a.ph_hi = NPHASE;
    void* kargs[] = {&a};
    hipError_t e = hipLaunchCooperativeKernel((const void*)fwd_megakernel, dim3(grid), dim3(NTHR), kargs, LDS_BYTES, stream);
    if (e != hipSuccess) fprintf(stderr, "kernel_launch: cooperative launch failed: %s (grid %d)\n", hipGetErrorString(e), grid);
#endif
}
```

```cpp
#include <hip/hip_runtime.h>
#include <hip/hip_cooperative_groups.h>
#include <cstdio>
#include <cstdint>
namespace cg = cooperative_groups;
#define PG8_ALIGN true
#define PG8_SP2 true
#ifndef DUP_MASK
#define DUP_MASK 0x000
#endif
#ifndef EXTRA_SYNCS
#define EXTRA_SYNCS 0
#endif
#ifndef GEMM_SIMPLE
#define GEMM_SIMPLE 0
#endif
#if GEMM_SIMPLE
#define GEMM_CALL(E_, S_) pg8::gemm_simple<E_, S_>
#else
#define GEMM_CALL(E_, S_) pg8::gemm_phase<E_, S_, PG8_ALIGN, PG8_SP2>
#endif
#ifndef MK_PER_PHASE
#define MK_PER_PHASE 0
#endif
namespace pg8 {
#define PG8_LAS __attribute__((address_space(3)))
typedef unsigned short bf16_t;
typedef short bf16x8 __attribute__((ext_vector_type(8)));
typedef float f32x4 __attribute__((ext_vector_type(4)));
typedef unsigned u32x4 __attribute__((ext_vector_type(4)));
constexpr int BM = 256, BK = 64, HALF = 128, HTB = HALF * BK * 2  , STAGE_BYTES = 8 * HTB, NXCD = 8, WGM = 8;

__host__ __device__ __forceinline__ int lds_byte(int r, int c) { const int st = (r >> 4) * 2 + (c >> 5), rr = r & 15, cc = c & 31, ob = rr * 64 + cc * 2; return st * 1024 + (ob ^ (((ob >> 9) & 1) << 5)); }
__host__ __device__ __forceinline__ void stage_rc(int b, int& R, int& C) { const int st = b / 1024, sb = b % 1024, swz = sb ^ (((sb >> 9) & 1) << 5); R = (st >> 1) * 16 + swz / 64; C = (st & 1) * 32 + (swz % 64) / 2; }
__host__ __device__ __forceinline__ int perm32(int rho) { const int n = rho >> 4, i = rho & 15; return 8 * (i >> 2) + 4 * n + (i & 3); }

struct Unit { int pm, pn, z; };
struct Gemm { int K, lda, ldb; };

struct StaticOrder {
    int nM, nN, nwg, G, c; const char* A; const char* B; size_t tsA, tsB;
    __host__ __device__ void init(int M, int N, int G_, int c_, const void* A_, int lda, const void* B_, int ldb) { nM = M / BM; nN = N / BM; nwg = nM * nN; G = G_; c = c_; A = (const char*)A_; B = (const char*)B_; tsA = (size_t)BM * lda * 2; tsB = (size_t)BM * ldb * 2; }
    __device__ __forceinline__ const char* pa(const Unit& u) const { return A + (size_t)u.pm * tsA; }
    __device__ __forceinline__ const char* pb(const Unit& u) const { return B + (size_t)u.pn * tsB; }
    __host__ __device__ bool next(int i, Unit& u) const {
        const long L = (long)i * G + c; if (L >= nwg) return false;
        int wgid = (int)L; { const int q = nwg / NXCD, r = nwg % NXCD, xcd = wgid % NXCD, off = wgid / NXCD; wgid = (xcd < r ? xcd * (q + 1) : r * (q + 1) + (xcd - r) * q) + off; }
        const int nig = WGM * nN, gid = wgid / nig, fm = gid * WGM, gsz = (nM - fm) < WGM ? (nM - fm) : WGM;
        u.pm = fm + ((wgid % nig) % gsz); u.pn = (wgid % nig) / gsz; u.z = 0; return true;
    }
    __device__ __forceinline__ void a_ready(const Unit&) const {}
    __device__ __forceinline__ void done(const Unit&) const {}
};

__device__ __forceinline__ unsigned cvt_pk_bf16(float lo, float hi) { unsigned r; asm volatile("s_nop 1\n\tv_cvt_pk_bf16_f32 %0, %1, %2" : "=v"(r) : "v"(lo), "v"(hi)); return r; }
template <class Epi, class Sched, bool ALIGN_EPI = false, bool SP2 = false>
__device__ __forceinline__ void gemm_phase(PG8_LAS unsigned char* lds, const Gemm g, const Sched& S, const Epi& E) {
    const int tid = threadIdx.x, wid = __builtin_amdgcn_readfirstlane(tid >> 6), lane = tid & 63, wr = wid >> 2, wc = wid & 3, fr = lane & 15, fq = lane >> 4;
    const int K = g.K, nt = K / BK;
    unsigned voffA[2], voffB[2];
#pragma unroll
    for (int i = 0; i < 2; ++i) { int R, C; stage_rc(tid * 16 + i * 8192, R, C); const int Rb = Epi::PERM ? ((R & ~31) + perm32(R & 31)) : R;
        voffA[i] = (unsigned)(R * g.lda + C) * 2u; voffB[i] = (unsigned)(Rb * g.ldb + C) * 2u; }
    const size_t kstep = (size_t)(BK * 2);
    const size_t hstepA = (size_t)HALF * g.lda * 2, hstepB = (size_t)HALF * g.ldb * 2;
    const unsigned ldsw = (unsigned)wid * 1024u;
    const int aoff = lds_byte(wr * 64 + fr, fq * 8), boff = lds_byte(wc * 32 + fr, fq * 8);
#define PG8_SA(b, h) (((b) * 2 + (h)) * HTB)
#define PG8_SB(b, h) ((4 + (b) * 2 + (h)) * HTB)
#define PG8_STAGE(bufoff, gbase, voff) do { _Pragma("unroll") for (int _i = 0; _i < 2; ++_i) \
        __builtin_amdgcn_global_load_lds((const unsigned*)((const char*)(gbase) + (voff)[_i]), (PG8_LAS unsigned*)(lds + (bufoff) + ldsw + _i * 8192), 16, 0, 0); } while (0)
#define PG8_LDA(dst, b, h) do { _Pragma("unroll") for (int m = 0; m < 4; ++m) _Pragma("unroll") for (int k = 0; k < 2; ++k) dst[m][k] = *(const PG8_LAS bf16x8*)(lds + PG8_SA(b, h) + aoff + m * 2048 + k * 1024); } while (0)
#define PG8_LDB(dst, b, h) do { _Pragma("unroll") for (int n = 0; n < 2; ++n) _Pragma("unroll") for (int k = 0; k < 2; ++k) dst[n][k] = *(const PG8_LAS bf16x8*)(lds + PG8_SB(b, h) + boff + n * 2048 + k * 1024); } while (0)
#define PG8_MMA(ai, bj, At, Bt) do { __builtin_amdgcn_s_setprio(1); _Pragma("unroll") for (int m = 0; m < 4; ++m) _Pragma("unroll") for (int n = 0; n < 2; ++n) _Pragma("unroll") for (int k = 0; k < 2; ++k) \
        acc[ai][bj][m][n] = __builtin_amdgcn_mfma_f32_16x16x32_bf16(Bt[n][k], At[m][k], acc[ai][bj][m][n], 0, 0, 0); __builtin_amdgcn_s_setprio(0); } while (0)
#define PG8_WAIT_V(n) asm volatile("s_waitcnt vmcnt(" #n ")" ::: "memory")
#define PG8_WAIT_L(n) asm volatile("s_waitcnt lgkmcnt(" #n ")" ::: "memory")
#define PG8_BAR __builtin_amdgcn_s_barrier()
#define PG8_SCHED __builtin_amdgcn_sched_barrier(0)
    Unit cur, nxt; int ui = 0;
    if (!S.next(0, cur)) return;
    f32x4 acc[2][2][4][2];
#pragma unroll
    for (int a = 0; a < 2; ++a)
#pragma unroll
        for (int b = 0; b < 2; ++b)
#pragma unroll
            for (int m = 0; m < 4; ++m)
#pragma unroll
                for (int n = 0; n < 2; ++n) acc[a][b][m][n] = (f32x4){0.f, 0.f, 0.f, 0.f};
    bf16x8 At[4][2], B0[2][2], B1[2][2];
    const char* cA = S.pa(cur); const char* cB = S.pb(cur);
    S.a_ready(cur);
    if constexpr (SP2) {
        PG8_STAGE(PG8_SB(0, 0), cB, voffB); PG8_STAGE(PG8_SB(0, 1), cB + hstepB, voffB); PG8_STAGE(PG8_SA(0, 0), cA, voffA); PG8_STAGE(PG8_SA(0, 1), cA + hstepA, voffA);
        if (wr == 1) PG8_BAR;
        PG8_WAIT_V(2); PG8_BAR;
        PG8_STAGE(PG8_SB(1, 0), cB + kstep, voffB); PG8_STAGE(PG8_SA(1, 0), cA + kstep, voffA); PG8_STAGE(PG8_SB(1, 1), cB + hstepB + kstep, voffB);
        PG8_WAIT_V(6); PG8_BAR;
    } else {
        PG8_STAGE(PG8_SB(0, 0), cB, voffB); PG8_STAGE(PG8_SA(0, 0), cA, voffA); PG8_STAGE(PG8_SB(0, 1), cB + hstepB, voffB); PG8_STAGE(PG8_SA(0, 1), cA + hstepA, voffA);
        if (wr == 1) PG8_BAR;
        PG8_WAIT_V(4); PG8_BAR;
        PG8_STAGE(PG8_SB(1, 0), cB + kstep, voffB); PG8_STAGE(PG8_SA(1, 0), cA + kstep, voffA); PG8_STAGE(PG8_SB(1, 1), cB + hstepB + kstep, voffB);
        PG8_WAIT_V(6); PG8_BAR;
    }
    for (;;) {
        const bool has_next = S.next(ui + 1, nxt);
        const char* nA = has_next ? S.pa(nxt) : cA; const char* nB = has_next ? S.pb(nxt) : cB;
#pragma unroll 1
        for (int t = 0; t < nt; t += 2) {
            const bool last = (t == nt - 2);
            const char* a1 = cA + (size_t)(t + 1) * kstep;
            const char* a2 = last ? nA : cA + (size_t)(t + 2) * kstep; const char* b2 = last ? nB : cB + (size_t)(t + 2) * kstep;
            const char* a3 = a2 + kstep; const char* b3 = b2 + kstep;
            if (last && has_next) S.a_ready(nxt);
            if constexpr (SP2) {
            PG8_LDB(B0, 0, 0); PG8_LDB(B1, 0, 1); PG8_SCHED; PG8_LDA(At, 0, 0); PG8_STAGE(PG8_SA(1, 1), a1 + hstepA, voffA);
            PG8_WAIT_V(8); PG8_WAIT_L(0); PG8_BAR; PG8_MMA(0, 0, At, B0); if constexpr (!Epi::HALF_N) PG8_MMA(0, 1, At, B1); PG8_BAR; PG8_SCHED;
            PG8_LDA(At, 0, 1); PG8_STAGE(PG8_SB(0, 0), b2, voffB); PG8_STAGE(PG8_SB(0, 1), b2 + hstepB, voffB); PG8_STAGE(PG8_SA(0, 0), a2, voffA);
            PG8_WAIT_V(8); PG8_WAIT_L(0); PG8_BAR; PG8_MMA(1, 0, At, B0); if constexpr (!Epi::HALF_N) PG8_MMA(1, 1, At, B1); PG8_BAR; PG8_SCHED;
            PG8_LDB(B0, 1, 0); PG8_LDB(B1, 1, 1); PG8_SCHED; PG8_LDA(At, 1, 0); PG8_STAGE(PG8_SA(0, 1), a2 + hstepA, voffA);
            PG8_WAIT_V(8); PG8_WAIT_L(0); PG8_BAR; PG8_MMA(0, 0, At, B0); if constexpr (!Epi::HALF_N) PG8_MMA(0, 1, At, B1); PG8_BAR; PG8_SCHED;
            PG8_LDA(At, 1, 1); PG8_STAGE(PG8_SB(1, 0), b3, voffB); PG8_STAGE(PG8_SB(1, 1), b3 + hstepB, voffB); PG8_STAGE(PG8_SA(1, 0), a3, voffA);
            PG8_WAIT_V(8); PG8_WAIT_L(0); PG8_BAR; PG8_MMA(1, 0, At, B0); if constexpr (!Epi::HALF_N) PG8_MMA(1, 1, At, B1); PG8_BAR; PG8_SCHED;
            } else {
            PG8_LDB(B0, 0, 0); PG8_SCHED; PG8_LDA(At, 0, 0); PG8_STAGE(PG8_SA(1, 1), a1 + hstepA, voffA);
            PG8_WAIT_L(8); PG8_BAR; PG8_WAIT_L(0); PG8_MMA(0, 0, At, B0); PG8_BAR; PG8_SCHED;
            PG8_LDB(B1, 0, 1); PG8_STAGE(PG8_SB(0, 0), b2, voffB);
            PG8_BAR; PG8_WAIT_L(0); PG8_MMA(0, 1, At, B1); PG8_BAR;
            PG8_LDA(At, 0, 1); PG8_STAGE(PG8_SA(0, 0), a2, voffA);
            PG8_BAR; PG8_WAIT_L(0); PG8_MMA(1, 0, At, B0); PG8_BAR; PG8_SCHED;
            PG8_STAGE(PG8_SB(0, 1), b2 + hstepB, voffB);
            PG8_WAIT_V(6); PG8_BAR; PG8_MMA(1, 1, At, B1); PG8_BAR;
            PG8_LDB(B0, 1, 0); PG8_SCHED; PG8_LDA(At, 1, 0); PG8_STAGE(PG8_SA(0, 1), a2 + hstepA, voffA);
            PG8_WAIT_L(8); PG8_BAR; PG8_WAIT_L(0); PG8_MMA(0, 0, At, B0); PG8_BAR; PG8_SCHED;
            PG8_LDB(B1, 1, 1); PG8_STAGE(PG8_SB(1, 0), b3, voffB);
            PG8_BAR; PG8_WAIT_L(0); PG8_MMA(0, 1, At, B1); PG8_BAR;
            PG8_LDA(At, 1, 1); PG8_STAGE(PG8_SA(1, 0), a3, voffA);
            PG8_BAR; PG8_WAIT_L(0); PG8_MMA(1, 0, At, B0); PG8_BAR; PG8_SCHED;
            PG8_STAGE(PG8_SB(1, 1), b3 + hstepB, voffB);
            PG8_WAIT_V(6); PG8_BAR; PG8_MMA(1, 1, At, B1); PG8_BAR;
            }
        }
        if constexpr (ALIGN_EPI) { if (wr == 0) PG8_BAR; }
        if constexpr (!Epi::AFTER_DRAIN) { E(acc, cur, wr, wc, fr, fq); S.done(cur); }
        if (!has_next) break;
#pragma unroll
        for (int a = 0; a < 2; ++a)
#pragma unroll
            for (int b = 0; b < 2; ++b)
#pragma unroll
                for (int m = 0; m < 4; ++m)
#pragma unroll
                    for (int n = 0; n < 2; ++n) acc[a][b][m][n] = (f32x4){0.f, 0.f, 0.f, 0.f};
        cur = nxt; cA = nA; cB = nB; ++ui;
        if constexpr (ALIGN_EPI) { if (wr == 1) PG8_BAR; }
    }
    PG8_WAIT_V(0);
    if constexpr (!ALIGN_EPI) { if (wr == 0) PG8_BAR; }
    PG8_BAR;
    if constexpr (Epi::AFTER_DRAIN) { E.fused(acc, cur, wr, wc, fr, fq, lds, wid, lane); S.done(cur); }
#undef PG8_SA
#undef PG8_SB
#undef PG8_STAGE
#undef PG8_LDA
#undef PG8_LDB
#undef PG8_MMA
#undef PG8_WAIT_V
#undef PG8_WAIT_L
#undef PG8_BAR
#undef PG8_SCHED
}

template <class Epi, class Sched>
__device__ __forceinline__ void gemm_simple(PG8_LAS unsigned char* lds, const Gemm g, const Sched& S, const Epi& E) {
    const int tid = threadIdx.x, wid = __builtin_amdgcn_readfirstlane(tid >> 6), lane = tid & 63, wr = wid >> 2, wc = wid & 3, fr = lane & 15, fq = lane >> 4;
    const int nt = g.K / BK;
    unsigned voffA[2], voffB[2];
#pragma unroll
    for (int i = 0; i < 2; ++i) { int R, C; stage_rc(tid * 16 + i * 8192, R, C); const int Rb = Epi::PERM ? ((R & ~31) + perm32(R & 31)) : R;
        voffA[i] = (unsigned)(R * g.lda + C) * 2u; voffB[i] = (unsigned)(Rb * g.ldb + C) * 2u; }
    const size_t kstep = (size_t)(BK * 2), hstepA = (size_t)HALF * g.lda * 2, hstepB = (size_t)HALF * g.ldb * 2;
    const unsigned ldst = (unsigned)tid * 16u;
    const int aoff = lds_byte(wr * 64 + fr, fq * 8), boff = lds_byte(wc * 32 + fr, fq * 8);
#define SG_SA(b, h) (((b) * 2 + (h)) * HTB)
#define SG_SB(b, h) ((4 + (b) * 2 + (h)) * HTB)
#define SG_LDB(dst, b, h) do { _Pragma("unroll") for (int n = 0; n < 2; ++n) _Pragma("unroll") for (int k = 0; k < 2; ++k) dst[n][k] = *(const PG8_LAS bf16x8*)(lds + SG_SB(b, h) + boff + n * 2048 + k * 1024); } while (0)
#define SG_AFRAG(b, st, k) (*(const PG8_LAS bf16x8*)(lds + SG_SA(b, (st) >> 2) + aoff + ((st) & 3) * 2048 + (k) * 1024))
#define SG_AHALF(b, ai) do { bf16x8 c0 = SG_AFRAG(b, (ai) * 4, 0), c1 = SG_AFRAG(b, (ai) * 4, 1); \
        _Pragma("unroll") for (int m = 0; m < 4; ++m) { bf16x8 n0 = c0, n1 = c1; \
            if (m < 3) { n0 = SG_AFRAG(b, (ai) * 4 + m + 1, 0); n1 = SG_AFRAG(b, (ai) * 4 + m + 1, 1); } \
            __builtin_amdgcn_sched_barrier(0); \
            _Pragma("unroll") for (int n = 0; n < 2; ++n) { \
                acc[ai][0][m][n] = __builtin_amdgcn_mfma_f32_16x16x32_bf16(B0[n][0], c0, acc[ai][0][m][n], 0, 0, 0); acc[ai][0][m][n] = __builtin_amdgcn_mfma_f32_16x16x32_bf16(B0[n][1], c1, acc[ai][0][m][n], 0, 0, 0); \
                acc[ai][1][m][n] = __builtin_amdgcn_mfma_f32_16x16x32_bf16(B1[n][0], c0, acc[ai][1][m][n], 0, 0, 0); acc[ai][1][m][n] = __builtin_amdgcn_mfma_f32_16x16x32_bf16(B1[n][1], c1, acc[ai][1][m][n], 0, 0, 0); } \
            __builtin_amdgcn_sched_barrier(0); c0 = n0; c1 = n1; } } while (0)
#define SG_LOADA(t) do { _Pragma("unroll") for (int h = 0; h < 2; ++h) _Pragma("unroll") for (int i = 0; i < 2; ++i) rr[h][i] = *(const u32x4*)(cA + h * hstepA + (size_t)(t) * kstep + voffA[i]); } while (0)
#define SG_LOADB(t) do { _Pragma("unroll") for (int h = 0; h < 2; ++h) _Pragma("unroll") for (int i = 0; i < 2; ++i) rr[h][i] = *(const u32x4*)(cB + h * hstepB + (size_t)(t) * kstep + voffB[i]); } while (0)
#define SG_STOREA(b) do { _Pragma("unroll") for (int h = 0; h < 2; ++h) _Pragma("unroll") for (int i = 0; i < 2; ++i) *(PG8_LAS u32x4*)(lds + SG_SA(b, h) + i * 8192 + ldst) = rr[h][i]; } while (0)
#define SG_STOREB(b) do { _Pragma("unroll") for (int h = 0; h < 2; ++h) _Pragma("unroll") for (int i = 0; i < 2; ++i) *(PG8_LAS u32x4*)(lds + SG_SB(b, h) + i * 8192 + ldst) = rr[h][i]; } while (0)
#define SG_KTILE(b, tn, more) do { bf16x8 B0[2][2], B1[2][2]; if (more) SG_LOADA(tn); SG_LDB(B0, b, 0); SG_LDB(B1, b, 1); SG_AHALF(b, 0); \
        if (more) { SG_STOREA((b) ^ 1); SG_LOADB(tn); } SG_AHALF(b, 1); if (more) SG_STOREB((b) ^ 1); __syncthreads(); } while (0)
    Unit cur;
    for (int ui = 0; S.next(ui, cur); ++ui) {
        f32x4 acc[2][2][4][2];
#pragma unroll
        for (int a = 0; a < 2; ++a)
#pragma unroll
            for (int b = 0; b < 2; ++b)
#pragma unroll
                for (int m = 0; m < 4; ++m)
#pragma unroll
                    for (int n = 0; n < 2; ++n) acc[a][b][m][n] = (f32x4){0.f, 0.f, 0.f, 0.f};
        const char* cA = S.pa(cur); const char* cB = S.pb(cur);
        u32x4 rr[2][2];
        __syncthreads();
        SG_LOADA(0); SG_STOREA(0); SG_LOADB(0); SG_STOREB(0);
        __syncthreads();
#pragma unroll 1
        for (int t = 0; t < nt; t += 2) {
            SG_KTILE(0, t + 1, true);
            const bool more = (t + 2 < nt);
            SG_KTILE(1, t + 2, more);
        }
        E(acc, cur, wr, wc, fr, fq);
    }
#undef SG_SA
#undef SG_SB
#undef SG_LDB
#undef SG_AFRAG
#undef SG_AHALF
#undef SG_LOADA
#undef SG_LOADB
#undef SG_STOREA
#undef SG_STOREB
#undef SG_KTILE
}
}

constexpr int BATCH = 4, SEQ = 4096, D = 1024, M = BATCH * SEQ;
constexpr int CW = 512, CK = 31, SW = 512, NG = 32, SP = 64, FH = 2816, INC = 3584, NMOD6 = 6 * D;
constexpr int LC = 16, NCH = M / LC, CPB = SEQ / LC, KA2 = 384;
constexpr float EPS = 1e-6f;
constexpr int NWAVES = 8, NTHR = 512;
constexpr int NPHASE = 8;

constexpr size_t MiB = 1u << 20;
constexpr size_t WS_CTL = 0, CTL_ZERO_BYTES = 1 * MiB;
constexpr size_t WS_BAR = 512 * 1024, WS_PCNT = 512 * 1024 + 16384, WS_GCNT = 512 * 1024 + 32768, BAR_BYTES = 32768 + 256;
constexpr size_t WS_MOD = 0, WS_RSS1 = 30 * MiB, WS_RSS2 = 31 * MiB;
constexpr size_t WS_WIN = 1 * MiB, WS_WCP = 8 * MiB, WS_WGLU = 9 * MiB, WS_WOUT = 11 * MiB, WS_WFI = 13 * MiB, WS_WFO = 24 * MiB;
constexpr size_t WS_SHW = 29 * MiB + 512 * 1024;
constexpr size_t WS_W1 = 30 * MiB, WS_B2 = 34 * MiB;
constexpr size_t WS_H1 = 40 * MiB;
constexpr size_t WS_UCONV = 72 * MiB, WS_A2S = 88 * MiB, WS_SGC = 112 * MiB, WS_SGS = 144 * MiB, WS_ACONV = 176 * MiB, WS_ASSM = 192 * MiB, WS_S = 208 * MiB, WS_MERGED = 224 * MiB;
constexpr size_t WS_X1B = 72 * MiB;
constexpr size_t WS_HID = 136 * MiB;
constexpr size_t WS_END = 256 * MiB;
static_assert(WS_HID + (size_t)M * FH * 2 <= WS_MERGED && WS_WFO + (size_t)D * FH * 2 <= WS_SHW && WS_B2 + (size_t)NG * 256 * KA2 * 2 <= WS_H1, "ws map");

constexpr int RING_BYTES = 131072, LDS_BYTES = 147456;

#define GAS __attribute__((address_space(1)))
#define LAS __attribute__((address_space(3)))
typedef unsigned short bf16;
typedef unsigned v4u __attribute__((ext_vector_type(4)));
typedef unsigned v2u __attribute__((ext_vector_type(2)));
typedef float f32x4 __attribute__((ext_vector_type(4)));
typedef float f32x2 __attribute__((ext_vector_type(2)));
using pg8::cvt_pk_bf16;
__device__ __forceinline__ float bf_lo(unsigned w) { return __uint_as_float(w << 16); }
__device__ __forceinline__ float bf_hi(unsigned w) { return __uint_as_float(w & 0xffff0000u); }
__device__ __forceinline__ float sigm(float x) { return __builtin_amdgcn_rcpf(1.0f + __expf(-x)); }
__device__ __forceinline__ float silu_f(float x) { return x * sigm(x); }
__device__ __forceinline__ float gelu_tanh(float x) { return x * sigm(1.5957691216057308f * (x + 0.044715f * x * x * x)); }
__device__ __forceinline__ float wave_sum(float v) {
#pragma unroll
    for (int o = 1; o < 64; o <<= 1) v += __shfl_xor(v, o);
    return v;
}
__device__ __forceinline__ v4u pack8(const f32x4 a, const f32x4 b) { v4u w; w.x = cvt_pk_bf16(a[0], a[1]); w.y = cvt_pk_bf16(a[2], a[3]); w.z = cvt_pk_bf16(b[0], b[1]); w.w = cvt_pk_bf16(b[2], b[3]); return w; }
__device__ __forceinline__ void unpack8(const v4u w, f32x4& a, f32x4& b) { a = (f32x4){bf_lo(w.x), bf_hi(w.x), bf_lo(w.y), bf_hi(w.y)}; b = (f32x4){bf_lo(w.z), bf_hi(w.z), bf_lo(w.w), bf_hi(w.w)}; }

struct BatchOrder {
    int nM, nwg, G, c; const char* A; const char* B; size_t zsA, tsA, zsB;
    __device__ __forceinline__ bool next(int i, pg8::Unit& u) const { const int L = i * G + c; if (L >= nwg) return false; u.z = L / nM; u.pm = L % nM; u.pn = 0; return true; }
    __device__ __forceinline__ const char* pa(const pg8::Unit& u) const { return A + (size_t)u.z * zsA + (size_t)u.pm * tsA; }
    __device__ __forceinline__ const char* pb(const pg8::Unit& u) const { return B + (size_t)u.z * zsB; }
    __device__ __forceinline__ void a_ready(const pg8::Unit&) const {}
    __device__ __forceinline__ void done(const pg8::Unit&) const {}
};

#define EPI_HEAD static constexpr bool PERM = true, AFTER_DRAIN = false, HALF_N = false
typedef f32x4 AccT[2][2][4][2];

struct EpiIn {
    EPI_HEAD; bf16* uconv; bf16* a2s; bf16* sgc; bf16* sgs;
    __device__ __forceinline__ void operator()(const AccT& acc, const pg8::Unit& u, int wr, int wc, int fr, int fq) const {
        const int row0 = u.pm * 256 + wr * 64 + fr;
        if (u.pn < 4) {
            const int col = u.pn * 128 + wc * 32 + 8 * fq;
#pragma unroll
            for (int ai = 0; ai < 2; ++ai)
#pragma unroll
                for (int m = 0; m < 4; ++m) { const int row = row0 + ai * 128 + m * 16; f32x4 o0, o1;
#pragma unroll
                    for (int e = 0; e < 4; ++e) { o0[e] = acc[ai][0][m][0][e] * sigm(acc[ai][1][m][0][e]); o1[e] = acc[ai][0][m][1][e] * sigm(acc[ai][1][m][1][e]); }
                    *(v4u*)(uconv + (size_t)row * CW + col) = pack8(o0, o1); }
        } else if (u.pn < 6) {
#pragma unroll
            for (int bj = 0; bj < 2; ++bj) { const int cc = (u.pn - 4) * 256 + bj * 128 + wc * 32 + 8 * fq, g = cc >> 4, h0 = cc & 15;
#pragma unroll
                for (int ai = 0; ai < 2; ++ai)
#pragma unroll
                    for (int m = 0; m < 4; ++m) { const int row = row0 + ai * 128 + m * 16;
                        *(v4u*)(a2s + ((size_t)(g * NCH + (row >> 4)) * KA2 + (row & 15) * 16 + h0)) = pack8(acc[ai][bj][m][0], acc[ai][bj][m][1]); } }
        } else {
#pragma unroll
            for (int bj = 0; bj < 2; ++bj) { const int gc = (u.pn - 6) * 256 + bj * 128 + wc * 32 + 8 * fq; bf16* dst = gc < D ? sgc + gc : sgs + (gc - D);
#pragma unroll
                for (int ai = 0; ai < 2; ++ai)
#pragma unroll
                    for (int m = 0; m < 4; ++m) { const int row = row0 + ai * 128 + m * 16; f32x4 o0, o1;
#pragma unroll
                        for (int e = 0; e < 4; ++e) { o0[e] = sigm(acc[ai][bj][m][0][e]); o1[e] = sigm(acc[ai][bj][m][1][e]); }
                        *(v4u*)(dst + (size_t)row * D) = pack8(o0, o1); } }
        }
    }
};
struct EpiState {
    EPI_HEAD; float* S;
    __device__ __forceinline__ void operator()(const AccT& acc, const pg8::Unit& u, int wr, int wc, int fr, int fq) const {
        const int col = wc * 32 + 8 * fq;
#pragma unroll
        for (int ai = 0; ai < 2; ++ai)
#pragma unroll
            for (int m = 0; m < 4; ++m) { const int rr = u.pm * 256 + ai * 128 + wr * 64 + m * 16 + fr; float* p = S + ((size_t)(u.z * NCH + rr)) * 128 + col;
                *(f32x4*)p = acc[ai][0][m][0]; *(f32x4*)(p + 4) = acc[ai][0][m][1]; }
    }
};
struct EpiStateLds {
    static constexpr bool PERM = true, AFTER_DRAIN = true, HALF_N = true;
    __device__ __forceinline__ void fused(const AccT& acc, const pg8::Unit& u, int wr, int wc, int fr, int fq, LAS unsigned char* lds, int wid, int lane) const {
        const int col = wc * 32 + 8 * fq;
#pragma unroll
        for (int ai = 0; ai < 2; ++ai)
#pragma unroll
            for (int m = 0; m < 4; ++m) { LAS float* p = (LAS float*)lds + (ai * 128 + wr * 64 + m * 16 + fr) * 128 + col;
                *(LAS f32x4*)p = acc[ai][0][m][0]; *(LAS f32x4*)(p + 4) = acc[ai][0][m][1]; }
    }
};
struct EpiSsmOut {
    EPI_HEAD; const bf16* a2s; const float* dvec; bf16* assm;
    __device__ __forceinline__ void operator()(const AccT& acc, const pg8::Unit& u, int wr, int wc, int fr, int fq) const {
        const int g = u.z; asm volatile("" : "+v"(fq), "+v"(fr));
#pragma unroll
        for (int bj = 0; bj < 2; ++bj) { const int c = bj * 128 + wc * 32 + 8 * fq, t = c >> 4, h0 = c & 15;
            const f32x4 d0 = *(const f32x4*)(dvec + g * 16 + h0), d1 = *(const f32x4*)(dvec + g * 16 + h0 + 4);
            v4u uu[2][4];
#pragma unroll
            for (int ai = 0; ai < 2; ++ai)
#pragma unroll
                for (int m = 0; m < 4; ++m) uu[ai][m] = *(const v4u*)(a2s + ((size_t)(g * NCH + u.pm * 256 + ai * 128 + wr * 64 + m * 16 + fr) * KA2 + c));
#pragma unroll
            for (int ai = 0; ai < 2; ++ai)
#pragma unroll
                for (int m = 0; m < 4; ++m) { const int rr = u.pm * 256 + ai * 128 + wr * 64 + m * 16 + fr;
                    f32x4 u0, u1; unpack8(uu[ai][m], u0, u1);
                    f32x4 y0 = acc[ai][bj][m][0] + d0 * u0, y1 = acc[ai][bj][m][1] + d1 * u1;
#pragma unroll
                    for (int e = 0; e < 4; ++e) { y0[e] = gelu_tanh(y0[e]); y1[e] = gelu_tanh(y1[e]); }
                    *(v4u*)(assm + ((size_t)(rr * LC + t) * SW + g * 16 + h0)) = pack8(y0, y1); }
            asm volatile("" ::: "memory"); }
    }
};
struct EpiConvProj {
    EPI_HEAD; const bf16* sgc; bf16* mg;
    __device__ __forceinline__ void operator()(const AccT& acc, const pg8::Unit& u, int wr, int wc, int fr, int fq) const {
#pragma unroll
        for (int bj = 0; bj < 2; ++bj) { const int col = u.pn * 256 + bj * 128 + wc * 32 + 8 * fq;
            v4u gg[2][4];
#pragma unroll
            for (int ai = 0; ai < 2; ++ai)
#pragma unroll
                for (int m = 0; m < 4; ++m) gg[ai][m] = *(const v4u*)(sgc + (size_t)(u.pm * 256 + ai * 128 + wr * 64 + m * 16 + fr) * D + col);
#pragma unroll
            for (int ai = 0; ai < 2; ++ai)
#pragma unroll
                for (int m = 0; m < 4; ++m) { const size_t off = (size_t)(u.pm * 256 + ai * 128 + wr * 64 + m * 16 + fr) * D + col;
                    f32x4 g0, g1; unpack8(gg[ai][m], g0, g1);
                    *(v4u*)(mg + off) = pack8(g0 * acc[ai][bj][m][0], g1 * acc[ai][bj][m][1]); }
            asm volatile("" ::: "memory"); }
    }
};
struct EpiSsmGlu {
    EPI_HEAD; const bf16* sgs; bf16* mg;
    __device__ __forceinline__ void operator()(const AccT& acc, const pg8::Unit& u, int wr, int wc, int fr, int fq) const {
        const int col = u.pn * 128 + wc * 32 + 8 * fq;
#pragma unroll
        for (int ai = 0; ai < 2; ++ai) {
            v4u gg[4], pp[4];
#pragma unroll
            for (int m = 0; m < 4; ++m) { const size_t off = (size_t)(u.pm * 256 + ai * 128 + wr * 64 + m * 16 + fr) * D + col; gg[m] = *(const v4u*)(sgs + off); pp[m] = *(const v4u*)(mg + off); }
#pragma unroll
            for (int m = 0; m < 4; ++m) { const size_t off = (size_t)(u.pm * 256 + ai * 128 + wr * 64 + m * 16 + fr) * D + col;
                f32x4 g0, g1, p0, p1; unpack8(gg[m], g0, g1); unpack8(pp[m], p0, p1);
#pragma unroll
                for (int e = 0; e < 4; ++e) { p0[e] += g0[e] * acc[ai][0][m][0][e] * sigm(acc[ai][1][m][0][e]); p1[e] += g1[e] * acc[ai][0][m][1][e] * sigm(acc[ai][1][m][1][e]); }
                *(v4u*)(mg + off) = pack8(p0, p1); }
            asm volatile("" ::: "memory"); }
    }
};
struct EpiOut {
    EPI_HEAD; const float* x; const float* mod; const float* n2g; bf16* x1; bf16* a2; float* rss;
    __device__ __forceinline__ void operator()(const AccT& acc, const pg8::Unit& u, int wr, int wc, int fr, int fq) const {
        const float* mb = mod + (u.pm >> 4) * NMOD6;
        float ss[2][4];
#pragma unroll
        for (int ai = 0; ai < 2; ++ai)
#pragma unroll
            for (int m = 0; m < 4; ++m) ss[ai][m] = 0.f;
#pragma unroll
        for (int bj = 0; bj < 2; ++bj) { const int col = u.pn * 256 + bj * 128 + wc * 32 + 8 * fq;
            const f32x4 gv0 = *(const f32x4*)(mb + 2 * D + col), gv1 = *(const f32x4*)(mb + 2 * D + col + 4);
            const f32x4 cs0 = *(const f32x4*)(n2g + col) * (*(const f32x4*)(mb + 4 * D + col) + 1.0f), cs1 = *(const f32x4*)(n2g + col + 4) * (*(const f32x4*)(mb + 4 * D + col + 4) + 1.0f);
#pragma unroll
            for (int ai = 0; ai < 2; ++ai) {
                f32x4 xx[4][2];
#pragma unroll
                for (int m = 0; m < 4; ++m) { const size_t off = (size_t)(u.pm * 256 + ai * 128 + wr * 64 + m * 16 + fr) * D + col;
                    xx[m][0] = __builtin_nontemporal_load((const f32x4*)(x + off)); xx[m][1] = __builtin_nontemporal_load((const f32x4*)(x + off + 4)); }
#pragma unroll
                for (int m = 0; m < 4; ++m) { const size_t off = (size_t)(u.pm * 256 + ai * 128 + wr * 64 + m * 16 + fr) * D + col;
                    const f32x4 v0 = xx[m][0] + gv0 * acc[ai][bj][m][0], v1 = xx[m][1] + gv1 * acc[ai][bj][m][1];
                    *(v4u*)(a2 + off) = pack8(v0 * cs0, v1 * cs1);
                    ss[ai][m] += (v0[0] * v0[0] + v0[1] * v0[1]) + (v0[2] * v0[2] + v0[3] * v0[3]) + (v1[0] * v1[0] + v1[1] * v1[1]) + (v1[2] * v1[2] + v1[3] * v1[3]); }
                asm volatile("" ::: "memory"); } }
#pragma unroll
        for (int ai = 0; ai < 2; ++ai)
#pragma unroll
            for (int m = 0; m < 4; ++m) { float t = ss[ai][m]; t += __shfl_xor(t, 16); t += __shfl_xor(t, 32);
                if (fq == 0) rss[(u.pm * 256 + ai * 128 + wr * 64 + m * 16 + fr) * 16 + u.pn * 4 + wc] = t; }
    }
};
struct EpiFfnIn {
    EPI_HEAD; const float* rss; const float* shw; bf16* hid;
    __device__ __forceinline__ void operator()(const AccT& acc, const pg8::Unit& u, int wr, int wc, int fr, int fq) const {
        const float* sb = shw + (u.pm >> 4) * (2 * FH) + u.pn * 256 + wc * 32 + 8 * fq;
        const f32x4 sg0 = *(const f32x4*)sb, sg1 = *(const f32x4*)(sb + 4), su0 = *(const f32x4*)(sb + 128), su1 = *(const f32x4*)(sb + 132);
        f32x4 qq[2][4];
#pragma unroll
        for (int ai = 0; ai < 2; ++ai)
#pragma unroll
            for (int m = 0; m < 4; ++m) qq[ai][m] = *(const f32x4*)(rss + (u.pm * 256 + ai * 128 + wr * 64 + m * 16 + fr) * 16 + 4 * fq);
#pragma unroll
        for (int ai = 0; ai < 2; ++ai)
#pragma unroll
            for (int m = 0; m < 4; ++m) { const int row = u.pm * 256 + ai * 128 + wr * 64 + m * 16 + fr;
                float t = (qq[ai][m][0] + qq[ai][m][1]) + (qq[ai][m][2] + qq[ai][m][3]); t += __shfl_xor(t, 16); t += __shfl_xor(t, 32);
                const float inv = rsqrtf(t * (1.0f / D) + EPS);
                const f32x4 g0 = acc[ai][0][m][0] * inv + sg0, g1 = acc[ai][0][m][1] * inv + sg1, u0 = acc[ai][1][m][0] * inv + su0, u1 = acc[ai][1][m][1] * inv + su1; f32x4 o0, o1;
#pragma unroll
                for (int e = 0; e < 4; ++e) { o0[e] = silu_f(g0[e]) * u0[e]; o1[e] = silu_f(g1[e]) * u1[e]; }
                *(v4u*)(hid + (size_t)row * FH + u.pn * 128 + wc * 32 + 8 * fq) = pack8(o0, o1); }
    }
};
struct EpiFfnOut {
    EPI_HEAD; const float* mod; const float* fg; const float* n2g; const bf16* x1; float* xo; float* rss; unsigned* cnt;
    __device__ __forceinline__ void operator()(AccT& acc, const pg8::Unit& u, int wr, int wc, int fr, int fq) const {
        const float* mb = mod + (u.pm >> 4) * NMOD6;
        {
            f32x4 gv[2][2], rc[2][2];
#pragma unroll
            for (int bj = 0; bj < 2; ++bj)
#pragma unroll
                for (int n = 0; n < 2; ++n) { const int col = u.pn * 256 + bj * 128 + wc * 32 + 8 * fq + 4 * n; gv[bj][n] = *(const f32x4*)(mb + 5 * D + col);
                    const f32x4 cs = *(const f32x4*)(n2g + col) * (*(const f32x4*)(mb + 4 * D + col) + 1.0f); rc[bj][n] = (f32x4){1.0f / cs[0], 1.0f / cs[1], 1.0f / cs[2], 1.0f / cs[3]}; }
#pragma unroll
            for (int ai = 0; ai < 2; ++ai)
#pragma unroll
                for (int m = 0; m < 4; ++m) { const int row = u.pm * 256 + ai * 128 + wr * 64 + m * 16 + fr; float ss = 0.f;
#pragma unroll
                    for (int bj = 0; bj < 2; ++bj) { const size_t off = (size_t)row * D + u.pn * 256 + bj * 128 + wc * 32 + 8 * fq;
                        f32x4 r0, r1; unpack8(*(const v4u*)(x1 + off), r0, r1);
                        const f32x4 v0 = r0 * rc[bj][0] + gv[bj][0] * acc[ai][bj][m][0], v1 = r1 * rc[bj][1] + gv[bj][1] * acc[ai][bj][m][1];
                        acc[ai][bj][m][0] = v0; acc[ai][bj][m][1] = v1;
                        ss += (v0[0] * v0[0] + v0[1] * v0[1]) + (v0[2] * v0[2] + v0[3] * v0[3]) + (v1[0] * v1[0] + v1[1] * v1[1]) + (v1[2] * v1[2] + v1[3] * v1[3]); }
                    ss += __shfl_xor(ss, 16); ss += __shfl_xor(ss, 32);
                    if (fq == 0) __hip_atomic_store(rss + row * 16 + u.pn * 4 + wc, ss, __ATOMIC_RELAXED, __HIP_MEMORY_SCOPE_AGENT); }
        }
        asm volatile("s_waitcnt vmcnt(0)" ::: "memory");
        unsigned* cw = cnt + 64 * u.pm;
        if (fr == 0 && fq == 0) __hip_atomic_fetch_add(cw, 1u, __ATOMIC_RELAXED, __HIP_MEMORY_SCOPE_AGENT);
        { unsigned sp = 0; while ((unsigned)__builtin_amdgcn_readfirstlane(__hip_atomic_load(cw, __ATOMIC_RELAXED, __HIP_MEMORY_SCOPE_AGENT)) < 32u) { __builtin_amdgcn_s_sleep(2); if (++sp > (1u << 22)) break; } }
        __builtin_amdgcn_fence(__ATOMIC_ACQUIRE, "agent");
        asm volatile("s_waitcnt vmcnt(0)" ::: "memory");
        f32x4 fv[2][2];
#pragma unroll
        for (int bj = 0; bj < 2; ++bj)
#pragma unroll
            for (int n = 0; n < 2; ++n) fv[bj][n] = *(const f32x4*)(fg + u.pn * 256 + bj * 128 + wc * 32 + 8 * fq + 4 * n);
#pragma unroll
        for (int ai = 0; ai < 2; ++ai)
#pragma unroll
            for (int m = 0; m < 4; ++m) { const int row = u.pm * 256 + ai * 128 + wr * 64 + m * 16 + fr;
                const unsigned long long* pp = (const unsigned long long*)(rss + row * 16 + 4 * fq);
                const unsigned long long w0 = __hip_atomic_load(pp, __ATOMIC_RELAXED, __HIP_MEMORY_SCOPE_AGENT), w1 = __hip_atomic_load(pp + 1, __ATOMIC_RELAXED, __HIP_MEMORY_SCOPE_AGENT);
                float t = (__uint_as_float((unsigned)w0) + __uint_as_float((unsigned)(w0 >> 32))) + (__uint_as_float((unsigned)w1) + __uint_as_float((unsigned)(w1 >> 32)));
                t += __shfl_xor(t, 16); t += __shfl_xor(t, 32);
                const float inv = rsqrtf(t * (1.0f / D) + EPS);
#pragma unroll
                for (int bj = 0; bj < 2; ++bj) { const size_t off = (size_t)row * D + u.pn * 256 + bj * 128 + wc * 32 + 8 * fq;
                    __builtin_nontemporal_store(acc[ai][bj][m][0] * inv * fv[bj][0], (f32x4*)(xo + off)); __builtin_nontemporal_store(acc[ai][bj][m][1] * inv * fv[bj][1], (f32x4*)(xo + off + 4)); } }
    }
};

struct TripleOrder {
    pg8::StaticOrder base; const char* A1; const char* B1; size_t tsA, tsB;
    __device__ __forceinline__ bool next(int i, pg8::Unit& u) const { pg8::Unit t; if (!base.next(i / 3, t)) return false; const int sub = i % 3; u.pm = t.pm;
        if (sub == 0) { u.pn = t.pn; u.z = 0; } else { u.pn = 2 * t.pn + (sub - 1); u.z = 1; } return true; }
    __device__ __forceinline__ const char* pa(const pg8::Unit& u) const { return u.z ? A1 + (size_t)u.pm * tsA : base.pa(u); }
    __device__ __forceinline__ const char* pb(const pg8::Unit& u) const { return u.z ? B1 + (size_t)u.pn * tsB : base.pb(u); }
    __device__ __forceinline__ void a_ready(const pg8::Unit&) const {}
    __device__ __forceinline__ void done(const pg8::Unit&) const {}
};
struct EpiMix {
    EPI_HEAD; const bf16* sgc; const bf16* sgs; bf16* mg;
    __device__ __forceinline__ void operator()(const AccT& acc, const pg8::Unit& u, int wr, int wc, int fr, int fq) const {
        if (u.z == 0) { const EpiConvProj e{sgc, mg}; e(acc, u, wr, wc, fr, fq); } else { const EpiSsmGlu e{sgs, mg}; e(acc, u, wr, wc, fr, fq); }
    }
};

__device__ __forceinline__ int ileave(int n0, int half) { return n0 < half ? 256 * (n0 >> 7) + (n0 & 127) : 256 * ((n0 - half) >> 7) + 128 + ((n0 - half) & 127); }
__device__ __forceinline__ void transpose_item(const float* W, int K, int N, bf16* WT, int mode, LAS float* scr, int item, int lane) {
    const int nblk = N / 32, kb = item / nblk, nb = item % nblk, k0 = 64 * kb, n0 = 32 * nb;
    int r0 = n0;
    if (mode == 1) r0 = n0 < 1024 ? ileave(n0, 512) : n0;
    else if (mode == 2) r0 = ileave(n0, 1024);
    else if (mode == 3) r0 = ileave(n0, FH);
    float tv[32];
#pragma unroll
    for (int i = 0; i < 32; ++i) tv[i] = __builtin_nontemporal_load(W + (size_t)(k0 + 2 * i + (lane >> 5)) * N + n0 + (lane & 31));
#pragma unroll
    for (int i = 0; i < 32; ++i) scr[(2 * i + (lane >> 5)) * 33 + (lane & 31)] = tv[i];
    asm volatile("s_waitcnt lgkmcnt(0)" ::: "memory");
    const int c = lane & 7;
#pragma unroll
    for (int j = 0; j < 4; ++j) { const int n = (lane >> 3) + 8 * j; const LAS float* s = scr + (8 * c) * 33 + n;
        v4u o; o.x = cvt_pk_bf16(s[0 * 33], s[1 * 33]); o.y = cvt_pk_bf16(s[2 * 33], s[3 * 33]); o.z = cvt_pk_bf16(s[4 * 33], s[5 * 33]); o.w = cvt_pk_bf16(s[6 * 33], s[7 * 33]);
        *(v4u*)(WT + (size_t)(r0 + n) * K + k0 + 8 * c) = o; }
    asm volatile("s_waitcnt lgkmcnt(0)" ::: "memory");
}
__device__ __forceinline__ void sincos_d(double x, double& s, double& c) {
    const double k = rint(x * 0.63661977236758134308);
    double r = fma(-k, 1.57079632679489655800e+00, x); r = fma(-k, 6.12323399573676603587e-17, r);
    const int q = ((int)k) & 3; const double r2 = r * r;
    double sp = -1.0 / 1307674368000.0; sp = fma(sp, r2, 1.0 / 6227020800.0); sp = fma(sp, r2, -1.0 / 39916800.0); sp = fma(sp, r2, 1.0 / 362880.0); sp = fma(sp, r2, -1.0 / 5040.0); sp = fma(sp, r2, 1.0 / 120.0); sp = fma(sp, r2, -1.0 / 6.0); sp = fma(sp * r2, r, r);
    double cp = 1.0 / 20922789888000.0; cp = fma(cp, r2, -1.0 / 87178291200.0); cp = fma(cp, r2, 1.0 / 479001600.0); cp = fma(cp, r2, -1.0 / 3628800.0); cp = fma(cp, r2, 1.0 / 40320.0); cp = fma(cp, r2, -1.0 / 720.0); cp = fma(cp, r2, 1.0 / 24.0); cp = fma(cp, r2, -0.5); cp = fma(cp, r2, 1.0);
    s = (q == 0) ? sp : (q == 1) ? cp : (q == 2) ? -sp : -cp;
    c = (q == 0) ? cp : (q == 1) ? -sp : (q == 2) ? -cp : sp;
}
__device__ __forceinline__ void ssm_abar(const float* a_re, const float* a_im, const float* log_dt, int g, int p, double& er, double& ei, double& ar, double& ai) {
    const double dt = (double)expf(log_dt[g]); ar = (double)a_re[g * SP + p]; ai = (double)a_im[g * SP + p];
    const double x = dt * ar;
    double mag = 1.0 / 362880.0; mag = fma(mag, x, 1.0 / 40320.0); mag = fma(mag, x, 1.0 / 5040.0); mag = fma(mag, x, 1.0 / 720.0); mag = fma(mag, x, 1.0 / 120.0); mag = fma(mag, x, 1.0 / 24.0); mag = fma(mag, x, 1.0 / 6.0); mag = fma(mag, x, 0.5); mag = fma(mag, x, 1.0); mag = fma(mag, x, 1.0);
    double s, c; sincos_d(dt * ai, s, c); er = mag * c; ei = mag * s;
}

#define XB_TMO      128
#define XB_XCNT(j)  (256  + 64 * (j))
#define XB_XSUB(j)  (1280 + 64 * (j))
#define XB_XGEN(j)  (2304 + 64 * (j))
#define XB_TOP      3328
#define XB_TOPGEN   3392
#define XCD_BAR_WORDS 3456
#define XB_SPIN_CAP (1u << 18)

__device__ __forceinline__ unsigned xb_ld(unsigned* p)              { return __hip_atomic_load(p, __ATOMIC_RELAXED, __HIP_MEMORY_SCOPE_AGENT); }
__device__ __forceinline__ unsigned xb_add(unsigned* p, unsigned v) { return __hip_atomic_fetch_add(p, v, __ATOMIC_RELAXED, __HIP_MEMORY_SCOPE_AGENT); }
__device__ __forceinline__ unsigned xb_xcc_id() { return (unsigned)__builtin_amdgcn_s_getreg((3 << 11) | 20) & 0xFu; }
#define XB_SPIN(cond, bar) do { unsigned _sp = 0; while (cond) { __builtin_amdgcn_s_sleep(1); \
    if ((++_sp & 255u) == 0u) { if (xb_ld(&(bar)[XB_TMO])) break; if (_sp > XB_SPIN_CAP) { atomicAdd(&(bar)[XB_TMO], 1u); break; } } } } while (0)

struct XcdBarrier {
    unsigned* bar; unsigned x;
    volatile LAS unsigned* st;
};

__device__ __forceinline__ XcdBarrier xcd_barrier_post(unsigned* bar, volatile LAS unsigned* st) {
    XcdBarrier b; b.bar = bar; b.x = xb_xcc_id(); b.st = st;
    if (threadIdx.x == 0) (void)xb_add(&bar[XB_XCNT(b.x)], 1u);
    return b;
}
__device__ __forceinline__ void xcd_barrier_complete(unsigned* bar, unsigned x, unsigned& nloc, unsigned& nx) {
    const unsigned G = gridDim.x * gridDim.y * gridDim.z;
    unsigned sum, cnt, mine, sp = 0u;
    for (;;) {
        sum = 0u; cnt = 0u; mine = 0u;
#pragma unroll
        for (unsigned j = 0; j < 16; ++j) { const unsigned c = xb_ld(&bar[XB_XCNT(j)]); sum += c; cnt += (c > 0u) ? 1u : 0u; mine = (j == x) ? c : mine; }
        if (sum == G) break;
        __builtin_amdgcn_s_sleep(1);
        if ((++sp & 255u) == 0u) { if (xb_ld(&bar[XB_TMO])) break; if (sp > XB_SPIN_CAP) { atomicAdd(&bar[XB_TMO], 1u); break; } }
    }
    nloc = mine > 0u ? mine : 1u; nx = cnt > 0u ? cnt : 1u;
}

__device__ __forceinline__ void xcd_barrier(const XcdBarrier& b) {
    asm volatile("s_waitcnt vmcnt(0)" ::: "memory");
    __syncthreads();
    if (threadIdx.x == 0) {
        unsigned* bar = b.bar;
        __builtin_amdgcn_s_waitcnt(0);
        unsigned nloc = b.st[0], nx = b.st[1];
        if (nloc == 0u) { xcd_barrier_complete(bar, b.x, nloc, nx); b.st[0] = nloc; b.st[1] = nx; }
        const unsigned old = xb_add(&bar[XB_XSUB(b.x)], 1u);
        const unsigned gen = old / nloc;
        if (old + 1u == (gen + 1u) * nloc) {
            __builtin_amdgcn_fence(__ATOMIC_RELEASE, "agent");
            asm volatile("s_waitcnt vmcnt(0)" ::: "memory");
            const unsigned og = xb_add(&bar[XB_TOP], 1u);
            const unsigned tg = og / nx;
            if (og + 1u == (tg + 1u) * nx) xb_add(&bar[XB_TOPGEN], 1u);
            else XB_SPIN(xb_ld(&bar[XB_TOPGEN]) == tg, bar);
            __builtin_amdgcn_fence(__ATOMIC_ACQUIRE, "agent");
            xb_add(&bar[XB_XGEN(b.x)], 1u);
            asm volatile("s_waitcnt vmcnt(0)" ::: "memory");
        } else {
            XB_SPIN(xb_ld(&bar[XB_TOPGEN]) == gen, bar);
            __builtin_amdgcn_fence(__ATOMIC_ACQUIRE, "agent");
            asm volatile("s_waitcnt vmcnt(0)" ::: "memory");
        }
    }
    __syncthreads();
}

struct Args { const float* in[25]; float* out; unsigned char* ws; int ph_lo, ph_hi; };
static_assert(sizeof(Args) == 25 * 8 + 8 + 8 + 8, "Args has no padding");

__global__ void __launch_bounds__(NTHR, 2) fwd_megakernel(Args args) {
    extern __shared__ __attribute__((aligned(16))) unsigned char lds_raw[];
    LAS unsigned char* lds = (LAS unsigned char*)lds_raw;
    const int tid = threadIdx.x, lane = tid & 63, wave = __builtin_amdgcn_readfirstlane(tid >> 6);
    const int G = gridDim.x, bid = blockIdx.x;
    const int gw = bid * NWAVES + wave, NGW = G * NWAVES;
    unsigned char* ws = args.ws;
    const float* x = args.in[0]; const float* cvec = args.in[1]; const float* w_ada = args.in[2]; const float* b_ada = args.in[3]; const float* n1g = args.in[4];
    const float* w_in = args.in[5]; const float* conv_w = args.in[6]; const float* conv_b = args.in[7]; const float* cln_g = args.in[8]; const float* cln_b = args.in[9];
    const float* conv_proj = args.in[10]; const float* a_re = args.in[11]; const float* a_im = args.in[12]; const float* b_re = args.in[13]; const float* b_im = args.in[14];
    const float* c_re = args.in[15]; const float* c_im = args.in[16]; const float* ssm_d = args.in[17]; const float* log_dt = args.in[18]; const float* ssm_glu = args.in[19];
    const float* w_out = args.in[20]; const float* n2g = args.in[21]; const float* w_ffn_in = args.in[22]; const float* w_ffn_out = args.in[23]; const float* final_g = args.in[24];
    float* out = args.out;
    float* MOD = (float*)(ws + WS_MOD); float* RSS1 = (float*)(ws + WS_RSS1); float* RSS2 = (float*)(ws + WS_RSS2); float* SHW = (float*)(ws + WS_SHW);
    bf16* WIN = (bf16*)(ws + WS_WIN); bf16* WCP = (bf16*)(ws + WS_WCP); bf16* WGLU = (bf16*)(ws + WS_WGLU); bf16* WOUT = (bf16*)(ws + WS_WOUT); bf16* WFI = (bf16*)(ws + WS_WFI); bf16* WFO = (bf16*)(ws + WS_WFO);
    bf16* W1T = (bf16*)(ws + WS_W1); bf16* B2T = (bf16*)(ws + WS_B2); bf16* H1 = (bf16*)(ws + WS_H1);
    bf16* UCONV = (bf16*)(ws + WS_UCONV); bf16* A2S = (bf16*)(ws + WS_A2S); bf16* SGC = (bf16*)(ws + WS_SGC); bf16* SGS = (bf16*)(ws + WS_SGS);
    bf16* ACONV = (bf16*)(ws + WS_ACONV); bf16* ASSM = (bf16*)(ws + WS_ASSM); float* SST = (float*)(ws + WS_S); bf16* MG = (bf16*)(ws + WS_MERGED); bf16* HID = (bf16*)(ws + WS_HID); bf16* X1B = (bf16*)(ws + WS_X1B);
    cg::grid_group grid = cg::this_grid();
    const int lo = args.ph_lo, hi = args.ph_hi;
    volatile LAS unsigned* bst = (volatile LAS unsigned*)(lds + RING_BYTES + 1024);
    if (tid < 2) bst[tid] = 0u;
    __syncthreads();
    XcdBarrier xbar = xcd_barrier_post((unsigned*)(ws + WS_BAR), bst);
    if (lo == 0x7fffffff) grid.sync();
#ifndef PHMASK
#define PHMASK 0xFF
#endif
#define IN(k) ((((PHMASK) >> (k)) & 1) && lo <= (k) && (k) < hi)
#define GRID_SYNC() do { xcd_barrier(xbar); } while (0)
#define SEAM(k) do { if (IN(k) && IN((k) + 1)) GRID_SYNC(); } while (0)
#define REPS(k) _Pragma("unroll 1") for (int rep_ = 0; rep_ < ((((DUP_MASK) >> (k)) & 1) ? 2 : 1); ++rep_)

    if (IN(0)) REPS(0) { if (rep_) GRID_SYNC();
        {
            LAS float* scr = (LAS float*)(lds + wave * 16384);
            constexpr int I_IN = (D / 64) * (INC / 32), I_CP = (CW / 64) * (D / 32), I_GLU = (SW / 64) * (2 * D / 32), I_OUT = (D / 64) * (D / 32), I_FI = (D / 64) * (2 * FH / 32), I_FO = (FH / 64) * (D / 32);
            constexpr int NITEMS = I_IN + I_FI;
            const int ngv = NMOD6 / 64;
            const int tw0 = (G >= 2 * ngv) ? (bid - ngv) * NWAVES + wave : gw, tnw = (G >= 2 * ngv) ? (G - ngv) * NWAVES : NGW;
            for (int it = (tw0 >= 0 ? tw0 : NITEMS); it < NITEMS; it += tnw) {
                if (it < I_FI) transpose_item(w_ffn_in, D, 2 * FH, WFI, 3, scr, it, lane);
                else transpose_item(w_in, D, INC, WIN, 1, scr, it - I_FI, lane);
            }
        }
        {
            __syncthreads();
            LAS float* red = (LAS float*)lds;
            LAS float* sc = (LAS float*)(lds + 8192);
            if (bid < NMOD6 / 64) { for (int e = tid; e < BATCH * D; e += NTHR) sc[e] = silu_f(cvec[e]); }
            __syncthreads();
            for (int it = bid; it < NMOD6 / 64; it += G) {
                const int col = it * 64 + lane; float a0 = 0.f, a1 = 0.f, a2 = 0.f, a3 = 0.f;
#pragma unroll 1
                for (int k0 = wave * 128; k0 < wave * 128 + 128; k0 += 32) { float wv[32];
#pragma unroll
                    for (int j = 0; j < 32; ++j) wv[j] = __builtin_nontemporal_load(w_ada + (size_t)(k0 + j) * NMOD6 + col);
#pragma unroll
                    for (int j = 0; j < 32; ++j) { a0 += wv[j] * sc[k0 + j]; a1 += wv[j] * sc[D + k0 + j]; a2 += wv[j] * sc[2 * D + k0 + j]; a3 += wv[j] * sc[3 * D + k0 + j]; } }
                red[(wave * 4 + 0) * 64 + lane] = a0; red[(wave * 4 + 1) * 64 + lane] = a1; red[(wave * 4 + 2) * 64 + lane] = a2; red[(wave * 4 + 3) * 64 + lane] = a3;
                __syncthreads();
                if (tid < 256) { const int b = tid >> 6, c = tid & 63; float t = b_ada[it * 64 + c];
#pragma unroll
                    for (int w = 0; w < 8; ++w) t += red[(w * 4 + b) * 64 + c];
                    __hip_atomic_store(MOD + b * NMOD6 + it * 64 + c, t, __ATOMIC_RELAXED, __HIP_MEMORY_SCOPE_AGENT); }
                asm volatile("s_waitcnt vmcnt(0)" ::: "memory");
                __syncthreads();
                if (tid == 0) __hip_atomic_fetch_add((unsigned*)(ws + WS_GCNT), 1u, __ATOMIC_RELAXED, __HIP_MEMORY_SCOPE_AGENT);
            }
        }
        {
            LAS f32x2* PW = (LAS f32x2*)(lds);
            LAS f32x2* QQ = (LAS f32x2*)(lds + 8704);
            LAS f32x2* BB = (LAS f32x2*)(lds + 9216);
            LAS f32x2* CC = (LAS f32x2*)(lds + 17408);
            LAS float* KT = (LAS float*)(lds + 25600);
            for (int it = bid; it < NG * 8; it += G) {
                const int g = it >> 3, rb = it & 7;
                __syncthreads();
                if (tid < 64) {
                    double er, ei, ar, ai; ssm_abar(a_re, a_im, log_dt, g, tid, er, ei, ar, ai);
                    const double nr = er - 1.0, ni = ei, den = ar * ar + ai * ai;
                    QQ[tid] = (f32x2){(float)((nr * ar + ni * ai) / den), (float)((ni * ar - nr * ai) / den)};
                    double pr = 1.0, pi = 0.0;
                    for (int j = 0; j <= 16; ++j) { PW[j * 64 + tid] = (f32x2){(float)pr, (float)pi}; const double t = pr * er - pi * ei; pi = pr * ei + pi * er; pr = t; }
                }
                for (int e = tid; e < 1024; e += NTHR) CC[e] = (f32x2){c_re[g * 1024 + e], c_im[g * 1024 + e]};
                __syncthreads();
                for (int e = tid; e < 1024; e += NTHR) { const f32x2 q = QQ[e >> 4]; const float br = b_re[g * 1024 + e], bi = b_im[g * 1024 + e]; BB[e] = (f32x2){q.x * br - q.y * bi, q.x * bi + q.y * br}; }
                __syncthreads();
                if (rb < 4) {
                    const int nl = 4 * rb + 4, pair = tid & 255, ho = pair >> 4, hi = pair & 15;
                    for (int j = tid >> 8; j < nl; j += 2) {
                        float s = 0.f;
                        for (int p = 0; p < 64; ++p) { const f32x2 c = CC[ho * 64 + p], w = PW[j * 64 + p], b = BB[p * 16 + hi];
                            const float cr = c.x * w.x - c.y * w.y, ci = c.x * w.y + c.y * w.x; s += cr * b.x - ci * b.y; }
                        KT[j * 256 + pair] = s;
                    }
                    __syncthreads();
                    for (int r = wave * 8; r < wave * 8 + 8; ++r) { const int n = 64 * rb + r, t = n >> 4, ho = n & 15;
#pragma unroll
                        for (int i = 0; i < 3; ++i) { const int kp = lane + 64 * i; float v[2];
#pragma unroll
                            for (int h = 0; h < 2; ++h) { const int k = 2 * kp + h;
                                if (k < 256) { const int s = k >> 4, hi = k & 15; v[h] = (s <= t) ? KT[(t - s) * 256 + ho * 16 + hi] : 0.f; }
                                else { const int p = (k - 256) & 63; const f32x2 c = CC[ho * 64 + p], w = PW[(t + 1) * 64 + p]; v[h] = (k < 320) ? (c.x * w.x - c.y * w.y) : -(c.x * w.y + c.y * w.x); } }
                            *(unsigned*)(B2T + ((size_t)(g * 256 + n) * KA2 + 2 * kp)) = cvt_pk_bf16(v[0], v[1]); } }
                } else {
                    for (int r = wave * 8; r < wave * 8 + 8; ++r) { const int n = 64 * (rb - 4) + r, p = n & 63;
#pragma unroll
                        for (int i = 0; i < 2; ++i) { const int kp = lane + 64 * i; float v[2];
#pragma unroll
                            for (int h = 0; h < 2; ++h) { const int k = 2 * kp + h, s = k >> 4, hi = k & 15; const f32x2 w = PW[(15 - s) * 64 + p], b = BB[p * 16 + hi];
                                v[h] = (n < 64) ? (w.x * b.x - w.y * b.y) : (n < 128) ? (w.x * b.y + w.y * b.x) : 0.f; }
                            *(unsigned*)(W1T + ((size_t)(g * 256 + n) * 256 + 2 * kp)) = cvt_pk_bf16(v[0], v[1]); } }
                }
            }
            __syncthreads();
        }
    }
    if (IN(0) && IN(1)) {
        if (tid == 0) { unsigned sp = 0; while (__hip_atomic_load((unsigned*)(ws + WS_GCNT), __ATOMIC_RELAXED, __HIP_MEMORY_SCOPE_AGENT) < (unsigned)(NMOD6 / 64)) { __builtin_amdgcn_s_sleep(2); if (++sp > (1u << 22)) break; }
            __builtin_amdgcn_fence(__ATOMIC_ACQUIRE, "agent"); asm volatile("s_waitcnt vmcnt(0)" ::: "memory"); }
        __syncthreads();
    }
    for (int xs_ = 0; xs_ < EXTRA_SYNCS; ++xs_) GRID_SYNC();

    if (IN(1)) REPS(1) { if (rep_) GRID_SYNC();
        for (int rb = gw * 8; rb < M; rb += NGW * 8) {
            const float* mb = MOD + (rb >> 12) * NMOD6;
            f32x4 v[8][4]; float inv[8];
#pragma unroll
            for (int q = 0; q < 8; ++q) { const f32x4* xr = (const f32x4*)(x + (size_t)(rb + q) * D) + lane;
#pragma unroll
                for (int j = 0; j < 4; ++j) v[q][j] = __builtin_nontemporal_load(xr + 64 * j); }
#pragma unroll
            for (int q = 0; q < 8; ++q) { float s = 0.f;
#pragma unroll
                for (int j = 0; j < 4; ++j) s += (v[q][j][0] * v[q][j][0] + v[q][j][1] * v[q][j][1]) + (v[q][j][2] * v[q][j][2] + v[q][j][3] * v[q][j][3]);
                inv[q] = rsqrtf(wave_sum(s) * (1.0f / D) + EPS); }
#pragma unroll
            for (int j = 0; j < 4; ++j) { const int col = lane * 4 + 256 * j;
                const f32x4 gsc = (*(const f32x4*)(n1g + col)) * (*(const f32x4*)(mb + D + col) + 1.0f), sh = *(const f32x4*)(mb + col);
#pragma unroll
                for (int q = 0; q < 8; ++q) { const f32x4 h = v[q][j] * inv[q] * gsc + sh;
                    v2u o; o.x = cvt_pk_bf16(h[0], h[1]); o.y = cvt_pk_bf16(h[2], h[3]); *(v2u*)(H1 + (size_t)(rb + q) * D + col) = o; } }
        }
    }
    SEAM(1);

    if (IN(2)) REPS(2) { if (rep_) GRID_SYNC();
        pg8::Gemm g{D, D, D}; pg8::StaticOrder S; S.init(M, INC, G, bid, H1, D, WIN, D);
        EpiIn E{UCONV, A2S, SGC, SGS};
        GEMM_CALL(EpiIn, pg8::StaticOrder)(lds, g, S, E);
        {
            constexpr int NU = (M / 256) * (INC / 256), I_CP = (CW / 64) * (D / 32), I_GLU = (SW / 64) * (2 * D / 32), I_OUT = (D / 64) * (D / 32);
            int first = NU % G, nhelp = G - first; if (first == 0) nhelp = G;
            if (bid >= first) {
                LAS float* scr = (LAS float*)(lds + wave * 16384);
                const int hw0 = (bid - first) * NWAVES + wave, hnw = nhelp * NWAVES;
                for (int it = hw0; it < I_GLU + I_OUT + I_CP; it += hnw) {
                    if (it < I_GLU) transpose_item(ssm_glu, SW, 2 * D, WGLU, 2, scr, it, lane);
                    else if (it < I_GLU + I_OUT) transpose_item(w_out, D, D, WOUT, 0, scr, it - I_GLU, lane);
                    else transpose_item(conv_proj, CW, D, WCP, 0, scr, it - I_GLU - I_OUT, lane);
                }
                for (int v = hw0; v < 2 * FH; v += hnw) {
                    const v4u w0 = *(const v4u*)(WFI + (size_t)v * D + lane * 8), w1 = *(const v4u*)(WFI + (size_t)v * D + 512 + lane * 8);
                    f32x4 a0, a1, b0, b1; unpack8(w0, a0, a1); unpack8(w1, b0, b1);
        #pragma unroll
                    for (int b = 0; b < BATCH; ++b) { const float* sh = MOD + b * NMOD6 + 3 * D;
                        const f32x4 s0 = *(const f32x4*)(sh + lane * 8), s1 = *(const f32x4*)(sh + lane * 8 + 4), s2 = *(const f32x4*)(sh + 512 + lane * 8), s3 = *(const f32x4*)(sh + 512 + lane * 8 + 4);
                        const f32x4 pr = a0 * s0 + a1 * s1 + b0 * s2 + b1 * s3; const float t = wave_sum((pr[0] + pr[1]) + (pr[2] + pr[3]));
                        if (lane == 0) SHW[b * (2 * FH) + v] = t; }
                }
            }
        }
    }
    SEAM(2);

    if (IN(3)) REPS(3) { if (rep_) GRID_SYNC();
        {
            const int cp = tid & 255, th = tid >> 8;
            LAS float* OUTT = (LAS float*)(lds + 65536);
            const bool bal = (G == 256);
            const int nmine = bal ? (bid < NG * 4 ? 0 : 4) : (M / 32 - bid + G - 1) / G;
            for (int ii = 0; ii < nmine; ++ii) {
                const int item = bal ? (bid - NG * 4) * 4 + ii : bid + ii * G;
                const int t0 = item * 32, pos0 = t0 & (SEQ - 1);
                __syncthreads();
                for (int e = tid; e < 62 * 64; e += NTHR) { const int r = e >> 6, ch = e & 63; v4u v = {0u, 0u, 0u, 0u};
                    if (pos0 - 30 + r >= 0) v = *(const v4u*)(UCONV + (size_t)(t0 - 30 + r) * CW + ch * 8);
                    *(LAS v4u*)(lds + r * 1024 + ch * 16) = v; }
                f32x2 w[CK];
#pragma unroll
                for (int j = 0; j < CK; ++j) w[j] = *(const f32x2*)(conv_w + j * CW + 2 * cp);
                f32x2 acc[16]; const f32x2 bias = *(const f32x2*)(conv_b + 2 * cp);
#pragma unroll
                for (int q = 0; q < 16; ++q) acc[q] = bias;
                __syncthreads();
#pragma unroll
                for (int i = 0; i < 46; ++i) { const unsigned uv = *(const LAS unsigned*)(lds + (th * 16 + i) * 1024 + cp * 4); const f32x2 vv = {bf_lo(uv), bf_hi(uv)};
#pragma unroll
                    for (int q = 0; q < 16; ++q) { const int j = i - q; if (j >= 0 && j < CK) acc[q] += vv * w[j]; } }
#pragma unroll
                for (int q = 0; q < 16; ++q) *(LAS f32x2*)(OUTT + (th * 16 + q) * 512 + 2 * cp) = acc[q];
                __syncthreads();
#pragma unroll
                for (int q = 0; q < 4; ++q) { const int tt = wave * 4 + q; const LAS float* rowp = OUTT + tt * 512;
                    f32x4 a = *(const LAS f32x4*)(rowp + lane * 4), b = *(const LAS f32x4*)(rowp + 256 + lane * 4);
                    const float mu = wave_sum((a[0] + a[1]) + (a[2] + a[3]) + (b[0] + b[1]) + (b[2] + b[3])) * (1.0f / CW);
                    a -= mu; b -= mu;
                    const float var = wave_sum((a[0] * a[0] + a[1] * a[1]) + (a[2] * a[2] + a[3] * a[3]) + (b[0] * b[0] + b[1] * b[1]) + (b[2] * b[2] + b[3] * b[3])) * (1.0f / CW);
                    const float rstd = rsqrtf(var + EPS);
                    a = a * rstd * (*(const f32x4*)(cln_g + lane * 4)) + *(const f32x4*)(cln_b + lane * 4);
                    b = b * rstd * (*(const f32x4*)(cln_g + 256 + lane * 4)) + *(const f32x4*)(cln_b + 256 + lane * 4);
                    v2u o0, o1; o0.x = cvt_pk_bf16(silu_f(a[0]), silu_f(a[1])); o0.y = cvt_pk_bf16(silu_f(a[2]), silu_f(a[3])); o1.x = cvt_pk_bf16(silu_f(b[0]), silu_f(b[1])); o1.y = cvt_pk_bf16(silu_f(b[2]), silu_f(b[3]));
                    bf16* dst = ACONV + (size_t)(t0 + tt) * CW; *(v2u*)(dst + lane * 4) = o0; *(v2u*)(dst + 256 + lane * 4) = o1; }
            }
            __syncthreads();
        }
        if (bid < NG * 4) {
            const int L = bid, g = L >> 2, b = L & 3;
            {
                pg8::Gemm gg{256, KA2, 256}; BatchOrder S{4, NG * 4, 1 << 20, L, (const char*)A2S, (const char*)W1T, (size_t)NCH * KA2 * 2, (size_t)256 * KA2 * 2, (size_t)256 * 256 * 2};
                EpiStateLds E{};
                GEMM_CALL(EpiStateLds, BatchOrder)(lds, gg, S, E);
            }
            __syncthreads();
            {
                double er, ei, ar, ai; ssm_abar(a_re, a_im, log_dt, g, lane, er, ei, ar, ai);
#pragma unroll
                for (int j = 0; j < 4; ++j) { const double t = er * er - ei * ei; ei = 2.0 * er * ei; er = t; }
                const float alr = (float)er, ali = (float)ei;
#pragma unroll
                for (int j = 0; j < 5; ++j) { const double t = er * er - ei * ei; ei = 2.0 * er * ei; er = t; }
                const float a32r = (float)er, a32i = (float)ei;
                const LAS float* sl = (const LAS float*)lds + wave * 32 * 128; LAS f32x2* EE = (LAS f32x2*)(lds + RING_BYTES + 2048);
                float xr = 0.f, xi = 0.f;
#pragma unroll 8
                for (int c = 0; c < 32; ++c) { const float sr = sl[c * 128 + lane], si = sl[c * 128 + 64 + lane]; const float nr = alr * xr - ali * xi + sr, ni = alr * xi + ali * xr + si; xr = nr; xi = ni; }
                EE[wave * 64 + lane] = (f32x2){xr, xi};
                __syncthreads();
                xr = 0.f; xi = 0.f;
                for (int v = 0; v < wave; ++v) { const f32x2 e = EE[v * 64 + lane]; const float nr = a32r * xr - a32i * xi + e.x, ni = a32r * xi + a32i * xr + e.y; xr = nr; xi = ni; }
                bf16* dst = A2S + (size_t)(g * NCH + b * CPB + wave * 32) * KA2 + 256 + lane;
#pragma unroll 8
                for (int c = 0; c < 32; ++c) {
                    const unsigned pk = cvt_pk_bf16(xr, xi); dst[(size_t)c * KA2] = (bf16)(pk & 0xffffu); dst[(size_t)c * KA2 + 64] = (bf16)(pk >> 16);
                    const float sr = sl[c * 128 + lane], si = sl[c * 128 + 64 + lane];
                    const float nr = alr * xr - ali * xi + sr, ni = alr * xi + ali * xr + si; xr = nr; xi = ni;
                }
            }
            asm volatile("s_waitcnt vmcnt(0)" ::: "memory");
            __syncthreads(); __builtin_amdgcn_fence(__ATOMIC_ACQUIRE, "agent");
            {
                pg8::Gemm gg{KA2, KA2, KA2}; BatchOrder S{4, NG * 4, 1 << 20, L, (const char*)A2S, (const char*)B2T, (size_t)NCH * KA2 * 2, (size_t)256 * KA2 * 2, (size_t)256 * KA2 * 2};
                EpiSsmOut E{A2S, ssm_d, ASSM};
                GEMM_CALL(EpiSsmOut, BatchOrder)(lds, gg, S, E);
            }
        }
    }
    SEAM(3);

    if (IN(4)) REPS(4) { if (rep_) GRID_SYNC();
        pg8::Gemm g{SW, SW, SW}; TripleOrder S; S.base.init(M, D, G, bid, ACONV, CW, WCP, CW); S.A1 = (const char*)ASSM; S.B1 = (const char*)WGLU; S.tsA = (size_t)256 * SW * 2; S.tsB = (size_t)256 * SW * 2;
        EpiMix E{SGC, SGS, MG};
        GEMM_CALL(EpiMix, TripleOrder)(lds, g, S, E);
    }
    SEAM(4);

    if (IN(5)) REPS(5) { if (rep_) GRID_SYNC();
        pg8::Gemm g{D, D, D}; pg8::StaticOrder S; S.init(M, D, G, bid, MG, D, WOUT, D);
        EpiOut E{x, MOD, n2g, X1B, H1, RSS1};
        GEMM_CALL(EpiOut, pg8::StaticOrder)(lds, g, S, E);
    }
    SEAM(5);

    if (IN(6)) REPS(6) { if (rep_) GRID_SYNC();
        pg8::Gemm g{D, D, D}; pg8::StaticOrder S; S.init(M, 2 * FH, G, bid, H1, D, WFI, D);
        EpiFfnIn E{RSS1, SHW, HID};
        GEMM_CALL(EpiFfnIn, pg8::StaticOrder)(lds, g, S, E);
        {
            constexpr int NU = (M / 256) * (2 * FH / 256), I_FO = (FH / 64) * (D / 32);
            int first = NU % G, nhelp = G - first; if (first == 0) nhelp = G;
            if (bid >= first) {
                LAS float* scr = (LAS float*)(lds + wave * 16384);
                for (int it = (bid - first) * NWAVES + wave; it < I_FO; it += nhelp * NWAVES) transpose_item(w_ffn_out, FH, D, WFO, 0, scr, it, lane);
            }
        }
    }
    SEAM(6);

    if (IN(7)) REPS(7) { if (rep_) GRID_SYNC();
        pg8::Gemm g{FH, FH, FH}; pg8::StaticOrder S; S.init(M, D, G, bid, HID, FH, WFO, FH);
        EpiFfnOut E{MOD, final_g, n2g, H1, out, RSS2, (unsigned*)(ws + WS_PCNT)};
        GEMM_CALL(EpiFfnOut, pg8::StaticOrder)(lds, g, S, E);
    }

#undef IN
#undef SEAM
}

extern "C" void kernel_launch(void* const* d_in, const int* in_sizes, int n_in, void* d_out, int out_size, void* d_ws, size_t ws_size, hipStream_t stream) {
    static int grid = 0;
    if (grid == 0) {
        if (n_in != 25 || out_size != M * D || ws_size < WS_END) { fprintf(stderr, "kernel_launch: unexpected shapes (n_in %d out %d ws %zu)\n", n_in, out_size, ws_size); grid = -1; return; }
        int dev = 0, cus = 0, per_cu = 0;
        (void)hipGetDevice(&dev); (void)hipDeviceGetAttribute(&cus, hipDeviceAttributeMultiprocessorCount, dev);
        if (hipFuncSetAttribute((const void*)fwd_megakernel, hipFuncAttributeMaxDynamicSharedMemorySize, LDS_BYTES) != hipSuccess) { fprintf(stderr, "kernel_launch: hipFuncSetAttribute failed\n"); grid = -1; return; }
        if (hipOccupancyMaxActiveBlocksPerMultiprocessor(&per_cu, (const void*)fwd_megakernel, NTHR, LDS_BYTES) != hipSuccess || per_cu < 1) { fprintf(stderr, "kernel_launch: occupancy query failed (%d)\n", per_cu); (void)hipGetLastError(); per_cu = 1; }
        grid = cus * (per_cu > 1 ? 1 : per_cu);
        if (grid <= 0) grid = 256;
    }
    if (grid < 0) return;
    (void)hipMemsetAsync((char*)d_ws + WS_BAR, 0, BAR_BYTES, stream);
    Args a{};
    for (int i = 0; i < 25; ++i) a.in[i] = (const float*)d_in[i];
    a.out = (float*)d_out; a.ws = (unsigned char*)d_ws;
#if MK_PER_PHASE
    for (int ph = 0; ph < NPHASE; ++ph) { a.ph_lo = ph; a.ph_hi = ph + 1; hipLaunchKernelGGL(fwd_megakernel, dim3(grid), dim3(NTHR), LDS_BYTES, stream, a); }
#else
    a.ph_lo = 0; a.ph_hi = NPHASE;
    void* kargs[] = {&a};
    hipError_t e = hipLaunchCooperativeKernel((const void*)fwd_megakernel, dim3(grid), dim3(NTHR), kargs, LDS_BYTES, stream);
    if (e != hipSuccess) fprintf(stderr, "kernel_launch: cooperative launch failed: %s (grid %d)\n", hipGetErrorString(e), grid);
#endif
}
```

```cpp
#include <hip/hip_runtime.h>
#include <hip/hip_cooperative_groups.h>
#include <cstdio>
#include <cstdint>
namespace cg = cooperative_groups;
#define PG8_ALIGN true
#define PG8_SP2 true
#ifndef DUP_MASK
#define DUP_MASK 0x000
#endif
#ifndef EXTRA_SYNCS
#define EXTRA_SYNCS 0
#endif
#ifndef GEMM_SIMPLE
#define GEMM_SIMPLE 0
#endif
#if GEMM_SIMPLE
#define GEMM_CALL(E_, S_) pg8::gemm_simple<E_, S_>
#else
#define GEMM_CALL(E_, S_) pg8::gemm_phase<E_, S_, PG8_ALIGN, PG8_SP2>
#endif
#ifndef MK_PER_PHASE
#define MK_PER_PHASE 0
#endif
namespace pg8 {
#define PG8_LAS __attribute__((address_space(3)))
typedef unsigned short bf16_t;
typedef short bf16x8 __attribute__((ext_vector_type(8)));
typedef float f32x4 __attribute__((ext_vector_type(4)));
typedef unsigned u32x4 __attribute__((ext_vector_type(4)));
constexpr int BM = 256, BK = 64, HALF = 128, HTB = HALF * BK * 2  , STAGE_BYTES = 8 * HTB, NXCD = 8, WGM = 8;

__host__ __device__ __forceinline__ int lds_byte(int r, int c) { const int st = (r >> 4) * 2 + (c >> 5), rr = r & 15, cc = c & 31, ob = rr * 64 + cc * 2; return st * 1024 + (ob ^ (((ob >> 9) & 1) << 5)); }
__host__ __device__ __forceinline__ void stage_rc(int b, int& R, int& C) { const int st = b / 1024, sb = b % 1024, swz = sb ^ (((sb >> 9) & 1) << 5); R = (st >> 1) * 16 + swz / 64; C = (st & 1) * 32 + (swz % 64) / 2; }
__host__ __device__ __forceinline__ int perm32(int rho) { const int n = rho >> 4, i = rho & 15; return 8 * (i >> 2) + 4 * n + (i & 3); }

struct Unit { int pm, pn, z; };
struct Gemm { int K, lda, ldb; };

struct StaticOrder {
    int nM, nN, nwg, G, c; const char* A; const char* B; size_t tsA, tsB;
    __host__ __device__ void init(int M, int N, int G_, int c_, const void* A_, int lda, const void* B_, int ldb) { nM = M / BM; nN = N / BM; nwg = nM * nN; G = G_; c = c_; A = (const char*)A_; B = (const char*)B_; tsA = (size_t)BM * lda * 2; tsB = (size_t)BM * ldb * 2; }
    __device__ __forceinline__ const char* pa(const Unit& u) const { return A + (size_t)u.pm * tsA; }
    __device__ __forceinline__ const char* pb(const Unit& u) const { return B + (size_t)u.pn * tsB; }
    __host__ __device__ bool next(int i, Unit& u) const {
        const long L = (long)i * G + c; if (L >= nwg) return false;
        int wgid = (int)L; { const int q = nwg / NXCD, r = nwg % NXCD, xcd = wgid % NXCD, off = wgid / NXCD; wgid = (xcd < r ? xcd * (q + 1) : r * (q + 1) + (xcd - r) * q) + off; }
        const int nig = WGM * nN, gid = wgid / nig, fm = gid * WGM, gsz = (nM - fm) < WGM ? (nM - fm) : WGM;
        u.pm = fm + ((wgid % nig) % gsz); u.pn = (wgid % nig) / gsz; u.z = 0; return true;
    }
    __device__ __forceinline__ void a_ready(const Unit&) const {}
    __device__ __forceinline__ void done(const Unit&) const {}
};

__device__ __forceinline__ unsigned cvt_pk_bf16(float lo, float hi) { unsigned r; asm volatile("s_nop 1\n\tv_cvt_pk_bf16_f32 %0, %1, %2" : "=v"(r) : "v"(lo), "v"(hi)); return r; }
template <class Epi, class Sched, bool ALIGN_EPI = false, bool SP2 = false>
__device__ __forceinline__ void gemm_phase(PG8_LAS unsigned char* lds, const Gemm g, const Sched& S, const Epi& E) {
    const int tid = threadIdx.x, wid = __builtin_amdgcn_readfirstlane(tid >> 6), lane = tid & 63, wr = wid >> 2, wc = wid & 3, fr = lane & 15, fq = lane >> 4;
    const int K = g.K, nt = K / BK;
    unsigned voffA[2], voffB[2];
#pragma unroll
    for (int i = 0; i < 2; ++i) { int R, C; stage_rc(tid * 16 + i * 8192, R, C); const int Rb = Epi::PERM ? ((R & ~31) + perm32(R & 31)) : R;
        voffA[i] = (unsigned)(R * g.lda + C) * 2u; voffB[i] = (unsigned)(Rb * g.ldb + C) * 2u; }
    const size_t kstep = (size_t)(BK * 2);
    const size_t hstepA = (size_t)HALF * g.lda * 2, hstepB = (size_t)HALF * g.ldb * 2;
    const unsigned ldsw = (unsigned)wid * 1024u;
    const int aoff = lds_byte(wr * 64 + fr, fq * 8), boff = lds_byte(wc * 32 + fr, fq * 8);
#define PG8_SA(b, h) (((b) * 2 + (h)) * HTB)
#define PG8_SB(b, h) ((4 + (b) * 2 + (h)) * HTB)
#define PG8_STAGE(bufoff, gbase, voff) do { _Pragma("unroll") for (int _i = 0; _i < 2; ++_i) \
        __builtin_amdgcn_global_load_lds((const unsigned*)((const char*)(gbase) + (voff)[_i]), (PG8_LAS unsigned*)(lds + (bufoff) + ldsw + _i * 8192), 16, 0, 0); } while (0)
#define PG8_LDA(dst, b, h) do { _Pragma("unroll") for (int m = 0; m < 4; ++m) _Pragma("unroll") for (int k = 0; k < 2; ++k) dst[m][k] = *(const PG8_LAS bf16x8*)(lds + PG8_SA(b, h) + aoff + m * 2048 + k * 1024); } while (0)
#define PG8_LDB(dst, b, h) do { _Pragma("unroll") for (int n = 0; n < 2; ++n) _Pragma("unroll") for (int k = 0; k < 2; ++k) dst[n][k] = *(const PG8_LAS bf16x8*)(lds + PG8_SB(b, h) + boff + n * 2048 + k * 1024); } while (0)
#define PG8_MMA(ai, bj, At, Bt) do { __builtin_amdgcn_s_setprio(1); _Pragma("unroll") for (int m = 0; m < 4; ++m) _Pragma("unroll") for (int n = 0; n < 2; ++n) _Pragma("unroll") for (int k = 0; k < 2; ++k) \
        acc[ai][bj][m][n] = __builtin_amdgcn_mfma_f32_16x16x32_bf16(Bt[n][k], At[m][k], acc[ai][bj][m][n], 0, 0, 0); __builtin_amdgcn_s_setprio(0); } while (0)
#define PG8_WAIT_V(n) asm volatile("s_waitcnt vmcnt(" #n ")" ::: "memory")
#define PG8_WAIT_L(n) asm volatile("s_waitcnt lgkmcnt(" #n ")" ::: "memory")
#define PG8_BAR __builtin_amdgcn_s_barrier()
#define PG8_SCHED __builtin_amdgcn_sched_barrier(0)
    Unit cur, nxt; int ui = 0;
    if (!S.next(0, cur)) return;
    f32x4 acc[2][2][4][2];
#pragma unroll
    for (int a = 0; a < 2; ++a)
#pragma unroll
        for (int b = 0; b < 2; ++b)
#pragma unroll
            for (int m = 0; m < 4; ++m)
#pragma unroll
                for (int n = 0; n < 2; ++n) acc[a][b][m][n] = (f32x4){0.f, 0.f, 0.f, 0.f};
    bf16x8 At[4][2], B0[2][2], B1[2][2];
    const char* cA = S.pa(cur); const char* cB = S.pb(cur);
    S.a_ready(cur);
    if constexpr (SP2) {
        PG8_STAGE(PG8_SB(0, 0), cB, voffB); PG8_STAGE(PG8_SB(0, 1), cB + hstepB, voffB); PG8_STAGE(PG8_SA(0, 0), cA, voffA); PG8_STAGE(PG8_SA(0, 1), cA + hstepA, voffA);
        if (wr == 1) PG8_BAR;
        PG8_WAIT_V(2); PG8_BAR;
        PG8_STAGE(PG8_SB(1, 0), cB + kstep, voffB); PG8_STAGE(PG8_SA(1, 0), cA + kstep, voffA); PG8_STAGE(PG8_SB(1, 1), cB + hstepB + kstep, voffB);
        PG8_WAIT_V(6); PG8_BAR;
    } else {
        PG8_STAGE(PG8_SB(0, 0), cB, voffB); PG8_STAGE(PG8_SA(0, 0), cA, voffA); PG8_STAGE(PG8_SB(0, 1), cB + hstepB, voffB); PG8_STAGE(PG8_SA(0, 1), cA + hstepA, voffA);
        if (wr == 1) PG8_BAR;
        PG8_WAIT_V(4); PG8_BAR;
        PG8_STAGE(PG8_SB(1, 0), cB + kstep, voffB); PG8_STAGE(PG8_SA(1, 0), cA + kstep, voffA); PG8_STAGE(PG8_SB(1, 1), cB + hstepB + kstep, voffB);
        PG8_WAIT_V(6); PG8_BAR;
    }
    for (;;) {
        const bool has_next = S.next(ui + 1, nxt);
        const char* nA = has_next ? S.pa(nxt) : cA; const char* nB = has_next ? S.pb(nxt) : cB;
#pragma unroll 1
        for (int t = 0; t < nt; t += 2) {
            const bool last = (t == nt - 2);
            const char* a1 = cA + (size_t)(t + 1) * kstep;
            const char* a2 = last ? nA : cA + (size_t)(t + 2) * kstep; const char* b2 = last ? nB : cB + (size_t)(t + 2) * kstep;
            const char* a3 = a2 + kstep; const char* b3 = b2 + kstep;
            if (last && has_next) S.a_ready(nxt);
            if constexpr (SP2) {
            PG8_LDB(B0, 0, 0); PG8_LDB(B1, 0, 1); PG8_SCHED; PG8_LDA(At, 0, 0); PG8_STAGE(PG8_SA(1, 1), a1 + hstepA, voffA);
            PG8_WAIT_V(8); PG8_WAIT_L(0); PG8_BAR; PG8_MMA(0, 0, At, B0); if constexpr (!Epi::HALF_N) PG8_MMA(0, 1, At, B1); PG8_BAR; PG8_SCHED;
            PG8_LDA(At, 0, 1); PG8_STAGE(PG8_SB(0, 0), b2, voffB); PG8_STAGE(PG8_SB(0, 1), b2 + hstepB, voffB); PG8_STAGE(PG8_SA(0, 0), a2, voffA);
            PG8_WAIT_V(8); PG8_WAIT_L(0); PG8_BAR; PG8_MMA(1, 0, At, B0); if constexpr (!Epi::HALF_N) PG8_MMA(1, 1, At, B1); PG8_BAR; PG8_SCHED;
            PG8_LDB(B0, 1, 0); PG8_LDB(B1, 1, 1); PG8_SCHED; PG8_LDA(At, 1, 0); PG8_STAGE(PG8_SA(0, 1), a2 + hstepA, voffA);
            PG8_WAIT_V(8); PG8_WAIT_L(0); PG8_BAR; PG8_MMA(0, 0, At, B0); if constexpr (!Epi::HALF_N) PG8_MMA(0, 1, At, B1); PG8_BAR; PG8_SCHED;
            PG8_LDA(At, 1, 1); PG8_STAGE(PG8_SB(1, 0), b3, voffB); PG8_STAGE(PG8_SB(1, 1), b3 + hstepB, voffB); PG8_STAGE(PG8_SA(1, 0), a3, voffA);
            PG8_WAIT_V(8); PG8_WAIT_L(0); PG8_BAR; PG8_MMA(1, 0, At, B0); if constexpr (!Epi::HALF_N) PG8_MMA(1, 1, At, B1); PG8_BAR; PG8_SCHED;
            } else {
            PG8_LDB(B0, 0, 0); PG8_SCHED; PG8_LDA(At, 0, 0); PG8_STAGE(PG8_SA(1, 1), a1 + hstepA, voffA);
            PG8_WAIT_L(8); PG8_BAR; PG8_WAIT_L(0); PG8_MMA(0, 0, At, B0); PG8_BAR; PG8_SCHED;
            PG8_LDB(B1, 0, 1); PG8_STAGE(PG8_SB(0, 0), b2, voffB);
            PG8_BAR; PG8_WAIT_L(0); PG8_MMA(0, 1, At, B1); PG8_BAR;
            PG8_LDA(At, 0, 1); PG8_STAGE(PG8_SA(0, 0), a2, voffA);
            PG8_BAR; PG8_WAIT_L(0); PG8_MMA(1, 0, At, B0); PG8_BAR; PG8_SCHED;
            PG8_STAGE(PG8_SB(0, 1), b2 + hstepB, voffB);
            PG8_WAIT_V(6); PG8_BAR; PG8_MMA(1, 1, At, B1); PG8_BAR;
            PG8_LDB(B0, 1, 0); PG8_SCHED; PG8_LDA(At, 1, 0); PG8_STAGE(PG8_SA(0, 1), a2 + hstepA, voffA);
            PG8_WAIT_L(8); PG8_BAR; PG8_WAIT_L(0); PG8_MMA(0, 0, At, B0); PG8_BAR; PG8_SCHED;
            PG8_LDB(B1, 1, 1); PG8_STAGE(PG8_SB(1, 0), b3, voffB);
            PG8_BAR; PG8_WAIT_L(0); PG8_MMA(0, 1, At, B1); PG8_BAR;
            PG8_LDA(At, 1, 1); PG8_STAGE(PG8_SA(1, 0), a3, voffA);
            PG8_BAR; PG8_WAIT_L(0); PG8_MMA(1, 0, At, B0); PG8_BAR; PG8_SCHED;
            PG8_STAGE(PG8_SB(1, 1), b3 + hstepB, voffB);
            PG8_WAIT_V(6); PG8_BAR; PG8_MMA(1, 1, At, B1); PG8_BAR;
            }
        }
        if constexpr (ALIGN_EPI) { if (wr == 0) PG8_BAR; }
        if constexpr (!Epi::AFTER_DRAIN) { E(acc, cur, wr, wc, fr, fq); S.done(cur); }
        if (!has_next) break;
#pragma unroll
        for (int a = 0; a < 2; ++a)
#pragma unroll
            for (int b = 0; b < 2; ++b)
#pragma unroll
                for (int m = 0; m < 4; ++m)
#pragma unroll
                    for (int n = 0; n < 2; ++n) acc[a][b][m][n] = (f32x4){0.f, 0.f, 0.f, 0.f};
        cur = nxt; cA = nA; cB = nB; ++ui;
        if constexpr (ALIGN_EPI) { if (wr == 1) PG8_BAR; }
    }
    PG8_WAIT_V(0);
    if constexpr (!ALIGN_EPI) { if (wr == 0) PG8_BAR; }
    PG8_BAR;
    if constexpr (Epi::AFTER_DRAIN) { E.fused(acc, cur, wr, wc, fr, fq, lds, wid, lane); S.done(cur); }
#undef PG8_SA
#undef PG8_SB
#undef PG8_STAGE
#undef PG8_LDA
#undef PG8_LDB
#undef PG8_MMA
#undef PG8_WAIT_V
#undef PG8_WAIT_L
#undef PG8_BAR
#undef PG8_SCHED
}

template <class Epi, class Sched>
__device__ __forceinline__ void gemm_simple(PG8_LAS unsigned char* lds, const Gemm g, const Sched& S, const Epi& E) {
    const int tid = threadIdx.x, wid = __builtin_amdgcn_readfirstlane(tid >> 6), lane = tid & 63, wr = wid >> 2, wc = wid & 3, fr = lane & 15, fq = lane >> 4;
    const int nt = g.K / BK;
    unsigned voffA[2], voffB[2];
#pragma unroll
    for (int i = 0; i < 2; ++i) { int R, C; stage_rc(tid * 16 + i * 8192, R, C); const int Rb = Epi::PERM ? ((R & ~31) + perm32(R & 31)) : R;
        voffA[i] = (unsigned)(R * g.lda + C) * 2u; voffB[i] = (unsigned)(Rb * g.ldb + C) * 2u; }
    const size_t kstep = (size_t)(BK * 2), hstepA = (size_t)HALF * g.lda * 2, hstepB = (size_t)HALF * g.ldb * 2;
    const unsigned ldst = (unsigned)tid * 16u;
    const int aoff = lds_byte(wr * 64 + fr, fq * 8), boff = lds_byte(wc * 32 + fr, fq * 8);
#define SG_SA(b, h) (((b) * 2 + (h)) * HTB)
#define SG_SB(b, h) ((4 + (b) * 2 + (h)) * HTB)
#define SG_LDB(dst, b, h) do { _Pragma("unroll") for (int n = 0; n < 2; ++n) _Pragma("unroll") for (int k = 0; k < 2; ++k) dst[n][k] = *(const PG8_LAS bf16x8*)(lds + SG_SB(b, h) + boff + n * 2048 + k * 1024); } while (0)
#define SG_AFRAG(b, st, k) (*(const PG8_LAS bf16x8*)(lds + SG_SA(b, (st) >> 2) + aoff + ((st) & 3) * 2048 + (k) * 1024))
#define SG_AHALF(b, ai) do { bf16x8 c0 = SG_AFRAG(b, (ai) * 4, 0), c1 = SG_AFRAG(b, (ai) * 4, 1); \
        _Pragma("unroll") for (int m = 0; m < 4; ++m) { bf16x8 n0 = c0, n1 = c1; \
            if (m < 3) { n0 = SG_AFRAG(b, (ai) * 4 + m + 1, 0); n1 = SG_AFRAG(b, (ai) * 4 + m + 1, 1); } \
            __builtin_amdgcn_sched_barrier(0); \
            _Pragma("unroll") for (int n = 0; n < 2; ++n) { \
                acc[ai][0][m][n] = __builtin_amdgcn_mfma_f32_16x16x32_bf16(B0[n][0], c0, acc[ai][0][m][n], 0, 0, 0); acc[ai][0][m][n] = __builtin_amdgcn_mfma_f32_16x16x32_bf16(B0[n][1], c1, acc[ai][0][m][n], 0, 0, 0); \
                acc[ai][1][m][n] = __builtin_amdgcn_mfma_f32_16x16x32_bf16(B1[n][0], c0, acc[ai][1][m][n], 0, 0, 0); acc[ai][1][m][n] = __builtin_amdgcn_mfma_f32_16x16x32_bf16(B1[n][1], c1, acc[ai][1][m][n], 0, 0, 0); } \
            __builtin_amdgcn_sched_barrier(0); c0 = n0; c1 = n1; } } while (0)
#define SG_LOADA(t) do { _Pragma("unroll") for (int h = 0; h < 2; ++h) _Pragma("unroll") for (int i = 0; i < 2; ++i) rr[h][i] = *(const u32x4*)(cA + h * hstepA + (size_t)(t) * kstep + voffA[i]); } while (0)
#define SG_LOADB(t) do { _Pragma("unroll") for (int h = 0; h < 2; ++h) _Pragma("unroll") for (int i = 0; i < 2; ++i) rr[h][i] = *(const u32x4*)(cB + h * hstepB + (size_t)(t) * kstep + voffB[i]); } while (0)
#define SG_STOREA(b) do { _Pragma("unroll") for (int h = 0; h < 2; ++h) _Pragma("unroll") for (int i = 0; i < 2; ++i) *(PG8_LAS u32x4*)(lds + SG_SA(b, h) + i * 8192 + ldst) = rr[h][i]; } while (0)
#define SG_STOREB(b) do { _Pragma("unroll") for (int h = 0; h < 2; ++h) _Pragma("unroll") for (int i = 0; i < 2; ++i) *(PG8_LAS u32x4*)(lds + SG_SB(b, h) + i * 8192 + ldst) = rr[h][i]; } while (0)
#define SG_KTILE(b, tn, more) do { bf16x8 B0[2][2], B1[2][2]; if (more) SG_LOADA(tn); SG_LDB(B0, b, 0); SG_LDB(B1, b, 1); SG_AHALF(b, 0); \
        if (more) { SG_STOREA((b) ^ 1); SG_LOADB(tn); } SG_AHALF(b, 1); if (more) SG_STOREB((b) ^ 1); __syncthreads(); } while (0)
    Unit cur;
    for (int ui = 0; S.next(ui, cur); ++ui) {
        f32x4 acc[2][2][4][2];
#pragma unroll
        for (int a = 0; a < 2; ++a)
#pragma unroll
            for (int b = 0; b < 2; ++b)
#pragma unroll
                for (int m = 0; m < 4; ++m)
#pragma unroll
                    for (int n = 0; n < 2; ++n) acc[a][b][m][n] = (f32x4){0.f, 0.f, 0.f, 0.f};
        const char* cA = S.pa(cur); const char* cB = S.pb(cur);
        u32x4 rr[2][2];
        __syncthreads();
        SG_LOADA(0); SG_STOREA(0); SG_LOADB(0); SG_STOREB(0);
        __syncthreads();
#pragma unroll 1
        for (int t = 0; t < nt; t += 2) {
            SG_KTILE(0, t + 1, true);
            const bool more = (t + 2 < nt);
            SG_KTILE(1, t + 2, more);
        }
        E(acc, cur, wr, wc, fr, fq);
    }
#undef SG_SA
#undef SG_SB
#undef SG_LDB
#undef SG_AFRAG
#undef SG_AHALF
#undef SG_LOADA
#undef SG_LOADB
#undef SG_STOREA
#undef SG_STOREB
#undef SG_KTILE
}
}

constexpr int BATCH = 4, SEQ = 4096, D = 1024, M = BATCH * SEQ;
constexpr int CW = 512, CK = 31, SW = 512, NG = 32, SP = 64, FH = 2816, INC = 3584, NMOD6 = 6 * D;
constexpr int LC = 16, NCH = M / LC, CPB = SEQ / LC, KA2 = 384;
constexpr float EPS = 1e-6f;
constexpr int NWAVES = 8, NTHR = 512;
constexpr int NPHASE = 8;

constexpr size_t MiB = 1u << 20;
constexpr size_t WS_CTL = 0, CTL_ZERO_BYTES = 1 * MiB;
constexpr size_t WS_BAR = 512 * 1024, WS_PCNT = 512 * 1024 + 16384, WS_GCNT = 512 * 1024 + 32768, BAR_BYTES = 32768 + 256;
constexpr size_t WS_MOD = 0, WS_RSS1 = 30 * MiB, WS_RSS2 = 31 * MiB;
constexpr size_t WS_WIN = 1 * MiB, WS_WCP = 8 * MiB, WS_WGLU = 9 * MiB, WS_WOUT = 11 * MiB, WS_WFI = 13 * MiB, WS_WFO = 24 * MiB;
constexpr size_t WS_SHW = 29 * MiB + 512 * 1024;
constexpr size_t WS_W1 = 30 * MiB, WS_B2 = 34 * MiB;
constexpr size_t WS_H1 = 40 * MiB;
constexpr size_t WS_UCONV = 72 * MiB, WS_A2S = 88 * MiB, WS_SGC = 112 * MiB, WS_SGS = 144 * MiB, WS_ACONV = 176 * MiB, WS_ASSM = 192 * MiB, WS_S = 208 * MiB, WS_MERGED = 224 * MiB;
constexpr size_t WS_X1B = 72 * MiB;
constexpr size_t WS_HID = 136 * MiB;
constexpr size_t WS_END = 256 * MiB;
static_assert(WS_HID + (size_t)M * FH * 2 <= WS_MERGED && WS_WFO + (size_t)D * FH * 2 <= WS_SHW && WS_B2 + (size_t)NG * 256 * KA2 * 2 <= WS_H1, "ws map");

constexpr int RING_BYTES = 131072, LDS_BYTES = 147456;

#define GAS __attribute__((address_space(1)))
#define LAS __attribute__((address_space(3)))
typedef unsigned short bf16;
typedef unsigned v4u __attribute__((ext_vector_type(4)));
typedef unsigned v2u __attribute__((ext_vector_type(2)));
typedef float f32x4 __attribute__((ext_vector_type(4)));
typedef float f32x2 __attribute__((ext_vector_type(2)));
using pg8::cvt_pk_bf16;
__device__ __forceinline__ float bf_lo(unsigned w) { return __uint_as_float(w << 16); }
__device__ __forceinline__ float bf_hi(unsigned w) { return __uint_as_float(w & 0xffff0000u); }
__device__ __forceinline__ float sigm(float x) { return __builtin_amdgcn_rcpf(1.0f + __expf(-x)); }
__device__ __forceinline__ float silu_f(float x) { return x * sigm(x); }
__device__ __forceinline__ float gelu_tanh(float x) { return x * sigm(1.5957691216057308f * (x + 0.044715f * x * x * x)); }
__device__ __forceinline__ float wave_sum(float v) {
#pragma unroll
    for (int o = 1; o < 64; o <<= 1) v += __shfl_xor(v, o);
    return v;
}
__device__ __forceinline__ v4u pack8(const f32x4 a, const f32x4 b) { v4u w; w.x = cvt_pk_bf16(a[0], a[1]); w.y = cvt_pk_bf16(a[2], a[3]); w.z = cvt_pk_bf16(b[0], b[1]); w.w = cvt_pk_bf16(b[2], b[3]); return w; }
__device__ __forceinline__ void unpack8(const v4u w, f32x4& a, f32x4& b) { a = (f32x4){bf_lo(w.x), bf_hi(w.x), bf_lo(w.y), bf_hi(w.y)}; b = (f32x4){bf_lo(w.z), bf_hi(w.z), bf_lo(w.w), bf_hi(w.w)}; }

struct BatchOrder {
    int nM, nwg, G, c; const char* A; const char* B; size_t zsA, tsA, zsB;
    __device__ __forceinline__ bool next(int i, pg8::Unit& u) const { const int L = i * G + c; if (L >= nwg) return false; u.z = L / nM; u.pm = L % nM; u.pn = 0; return true; }
    __device__ __forceinline__ const char* pa(const pg8::Unit& u) const { return A + (size_t)u.z * zsA + (size_t)u.pm * tsA; }
    __device__ __forceinline__ const char* pb(const pg8::Unit& u) const { return B + (size_t)u.z * zsB; }
    __device__ __forceinline__ void a_ready(const pg8::Unit&) const {}
    __device__ __forceinline__ void done(const pg8::Unit&) const {}
};

#define EPI_HEAD static constexpr bool PERM = true, AFTER_DRAIN = false, HALF_N = false
typedef f32x4 AccT[2][2][4][2];

struct EpiIn {
    EPI_HEAD; bf16* uconv; bf16* a2s; bf16* sgc; bf16* sgs;
    __device__ __forceinline__ void operator()(const AccT& acc, const pg8::Unit& u, int wr, int wc, int fr, int fq) const {
        const int row0 = u.pm * 256 + wr * 64 + fr;
        if (u.pn < 4) {
            const int col = u.pn * 128 + wc * 32 + 8 * fq;
#pragma unroll
            for (int ai = 0; ai < 2; ++ai)
#pragma unroll
                for (int m = 0; m < 4; ++m) { const int row = row0 + ai * 128 + m * 16; f32x4 o0, o1;
#pragma unroll
                    for (int e = 0; e < 4; ++e) { o0[e] = acc[ai][0][m][0][e] * sigm(acc[ai][1][m][0][e]); o1[e] = acc[ai][0][m][1][e] * sigm(acc[ai][1][m][1][e]); }
                    *(v4u*)(uconv + (size_t)row * CW + col) = pack8(o0, o1); }
        } else if (u.pn < 6) {
#pragma unroll
            for (int bj = 0; bj < 2; ++bj) { const int cc = (u.pn - 4) * 256 + bj * 128 + wc * 32 + 8 * fq, g = cc >> 4, h0 = cc & 15;
#pragma unroll
                for (int ai = 0; ai < 2; ++ai)
#pragma unroll
                    for (int m = 0; m < 4; ++m) { const int row = row0 + ai * 128 + m * 16;
                        *(v4u*)(a2s + ((size_t)(g * NCH + (row >> 4)) * KA2 + (row & 15) * 16 + h0)) = pack8(acc[ai][bj][m][0], acc[ai][bj][m][1]); } }
        } else {
#pragma unroll
            for (int bj = 0; bj < 2; ++bj) { const int gc = (u.pn - 6) * 256 + bj * 128 + wc * 32 + 8 * fq; bf16* dst = gc < D ? sgc + gc : sgs + (gc - D);
#pragma unroll
                for (int ai = 0; ai < 2; ++ai)
#pragma unroll
                    for (int m = 0; m < 4; ++m) { const int row = row0 + ai * 128 + m * 16; f32x4 o0, o1;
#pragma unroll
                        for (int e = 0; e < 4; ++e) { o0[e] = sigm(acc[ai][bj][m][0][e]); o1[e] = sigm(acc[ai][bj][m][1][e]); }
                        *(v4u*)(dst + (size_t)row * D) = pack8(o0, o1); } }
        }
    }
};
struct EpiState {
    EPI_HEAD; float* S;
    __device__ __forceinline__ void operator()(const AccT& acc, const pg8::Unit& u, int wr, int wc, int fr, int fq) const {
        const int col = wc * 32 + 8 * fq;
#pragma unroll
        for (int ai = 0; ai < 2; ++ai)
#pragma unroll
            for (int m = 0; m < 4; ++m) { const int rr = u.pm * 256 + ai * 128 + wr * 64 + m * 16 + fr; float* p = S + ((size_t)(u.z * NCH + rr)) * 128 + col;
                *(f32x4*)p = acc[ai][0][m][0]; *(f32x4*)(p + 4) = acc[ai][0][m][1]; }
    }
};
struct EpiStateLds {
    static constexpr bool PERM = true, AFTER_DRAIN = true, HALF_N = true;
    __device__ __forceinline__ void fused(const AccT& acc, const pg8::Unit& u, int wr, int wc, int fr, int fq, LAS unsigned char* lds, int wid, int lane) const {
        const int col = wc * 32 + 8 * fq;
#pragma unroll
        for (int ai = 0; ai < 2; ++ai)
#pragma unroll
            for (int m = 0; m < 4; ++m) { LAS float* p = (LAS float*)lds + (ai * 128 + wr * 64 + m * 16 + fr) * 128 + col;
                *(LAS f32x4*)p = acc[ai][0][m][0]; *(LAS f32x4*)(p + 4) = acc[ai][0][m][1]; }
    }
};
struct EpiSsmOut {
    EPI_HEAD; const bf16* a2s; const float* dvec; bf16* assm;
    __device__ __forceinline__ void operator()(const AccT& acc, const pg8::Unit& u, int wr, int wc, int fr, int fq) const {
        const int g = u.z; asm volatile("" : "+v"(fq), "+v"(fr));
#pragma unroll
        for (int bj = 0; bj < 2; ++bj) { const int c = bj * 128 + wc * 32 + 8 * fq, t = c >> 4, h0 = c & 15;
            const f32x4 d0 = *(const f32x4*)(dvec + g * 16 + h0), d1 = *(const f32x4*)(dvec + g * 16 + h0 + 4);
            v4u uu[2][4];
#pragma unroll
            for (int ai = 0; ai < 2; ++ai)
#pragma unroll
                for (int m = 0; m < 4; ++m) uu[ai][m] = *(const v4u*)(a2s + ((size_t)(g * NCH + u.pm * 256 + ai * 128 + wr * 64 + m * 16 + fr) * KA2 + c));
#pragma unroll
            for (int ai = 0; ai < 2; ++ai)
#pragma unroll
                for (int m = 0; m < 4; ++m) { const int rr = u.pm * 256 + ai * 128 + wr * 64 + m * 16 + fr;
                    f32x4 u0, u1; unpack8(uu[ai][m], u0, u1);
                    f32x4 y0 = acc[ai][bj][m][0] + d0 * u0, y1 = acc[ai][bj][m][1] + d1 * u1;
#pragma unroll
                    for (int e = 0; e < 4; ++e) { y0[e] = gelu_tanh(y0[e]); y1[e] = gelu_tanh(y1[e]); }
                    *(v4u*)(assm + ((size_t)(rr * LC + t) * SW + g * 16 + h0)) = pack8(y0, y1); }
            asm volatile("" ::: "memory"); }
    }
};
struct EpiConvProj {
    EPI_HEAD; const bf16* sgc; bf16* mg;
    __device__ __forceinline__ void operator()(const AccT& acc, const pg8::Unit& u, int wr, int wc, int fr, int fq) const {
#pragma unroll
        for (int bj = 0; bj < 2; ++bj) { const int col = u.pn * 256 + bj * 128 + wc * 32 + 8 * fq;
            v4u gg[2][4];
#pragma unroll
            for (int ai = 0; ai < 2; ++ai)
#pragma unroll
                for (int m = 0; m < 4; ++m) gg[ai][m] = *(const v4u*)(sgc + (size_t)(u.pm * 256 + ai * 128 + wr * 64 + m * 16 + fr) * D + col);
#pragma unroll
            for (int ai = 0; ai < 2; ++ai)
#pragma unroll
                for (int m = 0; m < 4; ++m) { const size_t off = (size_t)(u.pm * 256 + ai * 128 + wr * 64 + m * 16 + fr) * D + col;
                    f32x4 g0, g1; unpack8(gg[ai][m], g0, g1);
                    *(v4u*)(mg + off) = pack8(g0 * acc[ai][bj][m][0], g1 * acc[ai][bj][m][1]); }
            asm volatile("" ::: "memory"); }
    }
};
struct EpiSsmGlu {
    EPI_HEAD; const bf16* sgs; bf16* mg;
    __device__ __forceinline__ void operator()(const AccT& acc, const pg8::Unit& u, int wr, int wc, int fr, int fq) const {
        const int col = u.pn * 128 + wc * 32 + 8 * fq;
#pragma unroll
        for (int ai = 0; ai < 2; ++ai) {
            v4u gg[4], pp[4];
#pragma unroll
            for (int m = 0; m < 4; ++m) { const size_t off = (size_t)(u.pm * 256 + ai * 128 + wr * 64 + m * 16 + fr) * D + col; gg[m] = *(const v4u*)(sgs + off); pp[m] = *(const v4u*)(mg + off); }
#pragma unroll
            for (int m = 0; m < 4; ++m) { const size_t off = (size_t)(u.pm * 256 + ai * 128 + wr * 64 + m * 16 + fr) * D + col;
                f32x4 g0, g1, p0, p1; unpack8(gg[m], g0, g1); unpack8(pp[m], p0, p1);
#pragma unroll
                for (int e = 0; e < 4; ++e) { p0[e] += g0[e] * acc[ai][0][m][0][e] * sigm(acc[ai][1][m][0][e]); p1[e] += g1[e] * acc[ai][0][m][1][e] * sigm(acc[ai][1][m][1][e]); }
                *(v4u*)(mg + off) = pack8(p0, p1); }
            asm volatile("" ::: "memory"); }
    }
};
struct EpiOut {
    EPI_HEAD; const float* x; const float* mod; const float* n2g; bf16* x1; bf16* a2; float* rss;
    __device__ __forceinline__ void operator()(const AccT& acc, const pg8::Unit& u, int wr, int wc, int fr, int fq) const {
        const float* mb = mod + (u.pm >> 4) * NMOD6;
        float ss[2][4];
#pragma unroll
        for (int ai = 0; ai < 2; ++ai)
#pragma unroll
            for (int m = 0; m < 4; ++m) ss[ai][m] = 0.f;
#pragma unroll
        for (int bj = 0; bj < 2; ++bj) { const int col = u.pn * 256 + bj * 128 + wc * 32 + 8 * fq;
            const f32x4 gv0 = *(const f32x4*)(mb + 2 * D + col), gv1 = *(const f32x4*)(mb + 2 * D + col + 4);
            const f32x4 cs0 = *(const f32x4*)(n2g + col) * (*(const f32x4*)(mb + 4 * D + col) + 1.0f), cs1 = *(const f32x4*)(n2g + col + 4) * (*(const f32x4*)(mb + 4 * D + col + 4) + 1.0f);
#pragma unroll
            for (int ai = 0; ai < 2; ++ai) {
                f32x4 xx[4][2];
#pragma unroll
                for (int m = 0; m < 4; ++m) { const size_t off = (size_t)(u.pm * 256 + ai * 128 + wr * 64 + m * 16 + fr) * D + col;
                    xx[m][0] = __builtin_nontemporal_load((const f32x4*)(x + off)); xx[m][1] = __builtin_nontemporal_load((const f32x4*)(x + off + 4)); }
#pragma unroll
                for (int m = 0; m < 4; ++m) { const size_t off = (size_t)(u.pm * 256 + ai * 128 + wr * 64 + m * 16 + fr) * D + col;
                    const f32x4 v0 = xx[m][0] + gv0 * acc[ai][bj][m][0], v1 = xx[m][1] + gv1 * acc[ai][bj][m][1];
                    *(v4u*)(a2 + off) = pack8(v0 * cs0, v1 * cs1);
                    ss[ai][m] += (v0[0] * v0[0] + v0[1] * v0[1]) + (v0[2] * v0[2] + v0[3] * v0[3]) + (v1[0] * v1[0] + v1[1] * v1[1]) + (v1[2] * v1[2] + v1[3] * v1[3]); }
                asm volatile("" ::: "memory"); } }
#pragma unroll
        for (int ai = 0; ai < 2; ++ai)
#pragma unroll
            for (int m = 0; m < 4; ++m) { float t = ss[ai][m]; t += __shfl_xor(t, 16); t += __shfl_xor(t, 32);
                if (fq == 0) rss[(u.pm * 256 + ai * 128 + wr * 64 + m * 16 + fr) * 16 + u.pn * 4 + wc] = t; }
    }
};
struct EpiFfnIn {
    EPI_HEAD; const float* rss; const float* shw; bf16* hid;
    __device__ __forceinline__ void operator()(const AccT& acc, const pg8::Unit& u, int wr, int wc, int fr, int fq) const {
        const float* sb = shw + (u.pm >> 4) * (2 * FH) + u.pn * 256 + wc * 32 + 8 * fq;
        const f32x4 sg0 = *(const f32x4*)sb, sg1 = *(const f32x4*)(sb + 4), su0 = *(const f32x4*)(sb + 128), su1 = *(const f32x4*)(sb + 132);
        f32x4 qq[2][4];
#pragma unroll
        for (int ai = 0; ai < 2; ++ai)
#pragma unroll
            for (int m = 0; m < 4; ++m) qq[ai][m] = *(const f32x4*)(rss + (u.pm * 256 + ai * 128 + wr * 64 + m * 16 + fr) * 16 + 4 * fq);
#pragma unroll
        for (int ai = 0; ai < 2; ++ai)
#pragma unroll
            for (int m = 0; m < 4; ++m) { const int row = u.pm * 256 + ai * 128 + wr * 64 + m * 16 + fr;
                float t = (qq[ai][m][0] + qq[ai][m][1]) + (qq[ai][m][2] + qq[ai][m][3]); t += __shfl_xor(t, 16); t += __shfl_xor(t, 32);
                const float inv = rsqrtf(t * (1.0f / D) + EPS);
                const f32x4 g0 = acc[ai][0][m][0] * inv + sg0, g1 = acc[ai][0][m][1] * inv + sg1, u0 = acc[ai][1][m][0] * inv + su0, u1 = acc[ai][1][m][1] * inv + su1; f32x4 o0, o1;
#pragma unroll
                for (int e = 0; e < 4; ++e) { o0[e] = silu_f(g0[e]) * u0[e]; o1[e] = silu_f(g1[e]) * u1[e]; }
                *(v4u*)(hid + (size_t)row * FH + u.pn * 128 + wc * 32 + 8 * fq) = pack8(o0, o1); }
    }
};
struct EpiFfnOut {
    EPI_HEAD; const float* mod; const float* fg; const float* n2g; const bf16* x1; float* xo; float* rss; unsigned* cnt;
    __device__ __forceinline__ void operator()(AccT& acc, const pg8::Unit& u, int wr, int wc, int fr, int fq) const {
        const float* mb = mod + (u.pm >> 4) * NMOD6;
        {
            f32x4 gv[2][2], rc[2][2];
#pragma unroll
            for (int bj = 0; bj < 2; ++bj)
#pragma unroll
                for (int n = 0; n < 2; ++n) { const int col = u.pn * 256 + bj * 128 + wc * 32 + 8 * fq + 4 * n; gv[bj][n] = *(const f32x4*)(mb + 5 * D + col);
                    const f32x4 cs = *(const f32x4*)(n2g + col) * (*(const f32x4*)(mb + 4 * D + col) + 1.0f); rc[bj][n] = (f32x4){1.0f / cs[0], 1.0f / cs[1], 1.0f / cs[2], 1.0f / cs[3]}; }
#pragma unroll
            for (int ai = 0; ai < 2; ++ai)
#pragma unroll
                for (int m = 0; m < 4; ++m) { const int row = u.pm * 256 + ai * 128 + wr * 64 + m * 16 + fr; float ss = 0.f;
#pragma unroll
                    for (int bj = 0; bj < 2; ++bj) { const size_t off = (size_t)row * D + u.pn * 256 + bj * 128 + wc * 32 + 8 * fq;
                        f32x4 r0, r1; unpack8(*(const v4u*)(x1 + off), r0, r1);
                        const f32x4 v0 = r0 * rc[bj][0] + gv[bj][0] * acc[ai][bj][m][0], v1 = r1 * rc[bj][1] + gv[bj][1] * acc[ai][bj][m][1];
                        acc[ai][bj][m][0] = v0; acc[ai][bj][m][1] = v1;
                        ss += (v0[0] * v0[0] + v0[1] * v0[1]) + (v0[2] * v0[2] + v0[3] * v0[3]) + (v1[0] * v1[0] + v1[1] * v1[1]) + (v1[2] * v1[2] + v1[3] * v1[3]); }
                    ss += __shfl_xor(ss, 16); ss += __shfl_xor(ss, 32);
                    if (fq == 0) __hip_atomic_store(rss + row * 16 + u.pn * 4 + wc, ss, __ATOMIC_RELAXED, __HIP_MEMORY_SCOPE_AGENT); }
        }
        asm volatile("s_waitcnt vmcnt(0)" ::: "memory");
        unsigned* cw = cnt + 64 * u.pm;
        if (fr == 0 && fq == 0) __hip_atomic_fetch_add(cw, 1u, __ATOMIC_RELAXED, __HIP_MEMORY_SCOPE_AGENT);
        { unsigned sp = 0; while ((unsigned)__builtin_amdgcn_readfirstlane(__hip_atomic_load(cw, __ATOMIC_RELAXED, __HIP_MEMORY_SCOPE_AGENT)) < 32u) { __builtin_amdgcn_s_sleep(2); if (++sp > (1u << 22)) break; } }
        __builtin_amdgcn_fence(__ATOMIC_ACQUIRE, "agent");
        asm volatile("s_waitcnt vmcnt(0)" ::: "memory");
        f32x4 fv[2][2];
#pragma unroll
        for (int bj = 0; bj < 2; ++bj)
#pragma unroll
            for (int n = 0; n < 2; ++n) fv[bj][n] = *(const f32x4*)(fg + u.pn * 256 + bj * 128 + wc * 32 + 8 * fq + 4 * n);
#pragma unroll
        for (int ai = 0; ai < 2; ++ai)
#pragma unroll
            for (int m = 0; m < 4; ++m) { const int row = u.pm * 256 + ai * 128 + wr * 64 + m * 16 + fr;
                const unsigned long long* pp = (const unsigned long long*)(rss + row * 16 + 4 * fq);
                const unsigned long long w0 = __hip_atomic_load(pp, __ATOMIC_RELAXED, __HIP_MEMORY_SCOPE_AGENT), w1 = __hip_atomic_load(pp + 1, __ATOMIC_RELAXED, __HIP_MEMORY_SCOPE_AGENT);
                float t = (__uint_as_float((unsigned)w0) + __uint_as_float((unsigned)(w0 >> 32))) + (__uint_as_float((unsigned)w1) + __uint_as_float((unsigned)(w1 >> 32)));
                t += __shfl_xor(t, 16); t += __shfl_xor(t, 32);
                const float inv = rsqrtf(t * (1.0f / D) + EPS);
#pragma unroll
                for (int bj = 0; bj < 2; ++bj) { const size_t off = (size_t)row * D + u.pn * 256 + bj * 128 + wc * 32 + 8 * fq;
                    __builtin_nontemporal_store(acc[ai][bj][m][0] * inv * fv[bj][0], (f32x4*)(xo + off)); __builtin_nontemporal_store(acc[ai][bj][m][1] * inv * fv[bj][1], (f32x4*)(xo + off + 4)); } }
    }
};

struct TripleOrder {
    pg8::StaticOrder base; const char* A1; const char* B1; size_t tsA, tsB;
    __device__ __forceinline__ bool next(int i, pg8::Unit& u) const { pg8::Unit t; if (!base.next(i / 3, t)) return false; const int sub = i % 3; u.pm = t.pm;
        if (sub == 0) { u.pn = t.pn; u.z = 0; } else { u.pn = 2 * t.pn + (sub - 1); u.z = 1; } return true; }
    __device__ __forceinline__ const char* pa(const pg8::Unit& u) const { return u.z ? A1 + (size_t)u.pm * tsA : base.pa(u); }
    __device__ __forceinline__ const char* pb(const pg8::Unit& u) const { return u.z ? B1 + (size_t)u.pn * tsB : base.pb(u); }
    __device__ __forceinline__ void a_ready(const pg8::Unit&) const {}
    __device__ __forceinline__ void done(const pg8::Unit&) const {}
};
struct EpiMix {
    EPI_HEAD; const bf16* sgc; const bf16* sgs; bf16* mg;
    __device__ __forceinline__ void operator()(const AccT& acc, const pg8::Unit& u, int wr, int wc, int fr, int fq) const {
        if (u.z == 0) { const EpiConvProj e{sgc, mg}; e(acc, u, wr, wc, fr, fq); } else { const EpiSsmGlu e{sgs, mg}; e(acc, u, wr, wc, fr, fq); }
    }
};

__device__ __forceinline__ int ileave(int n0, int half) { return n0 < half ? 256 * (n0 >> 7) + (n0 & 127) : 256 * ((n0 - half) >> 7) + 128 + ((n0 - half) & 127); }
__device__ __forceinline__ void transpose_item(const float* W, int K, int N, bf16* WT, int mode, LAS float* scr, int item, int lane) {
    const int nblk = N / 32, kb = item / nblk, nb = item % nblk, k0 = 64 * kb, n0 = 32 * nb;
    int r0 = n0;
    if (mode == 1) r0 = n0 < 1024 ? ileave(n0, 512) : n0;
    else if (mode == 2) r0 = ileave(n0, 1024);
    else if (mode == 3) r0 = ileave(n0, FH);
    float tv[32];
#pragma unroll
    for (int i = 0; i < 32; ++i) tv[i] = __builtin_nontemporal_load(W + (size_t)(k0 + 2 * i + (lane >> 5)) * N + n0 + (lane & 31));
#pragma unroll
    for (int i = 0; i < 32; ++i) scr[(2 * i + (lane >> 5)) * 33 + (lane & 31)] = tv[i];
    asm volatile("s_waitcnt lgkmcnt(0)" ::: "memory");
    const int c = lane & 7;
#pragma unroll
    for (int j = 0; j < 4; ++j) { const int n = (lane >> 3) + 8 * j; const LAS float* s = scr + (8 * c) * 33 + n;
        v4u o; o.x = cvt_pk_bf16(s[0 * 33], s[1 * 33]); o.y = cvt_pk_bf16(s[2 * 33], s[3 * 33]); o.z = cvt_pk_bf16(s[4 * 33], s[5 * 33]); o.w = cvt_pk_bf16(s[6 * 33], s[7 * 33]);
        *(v4u*)(WT + (size_t)(r0 + n) * K + k0 + 8 * c) = o; }
    asm volatile("s_waitcnt lgkmcnt(0)" ::: "memory");
}
__device__ __forceinline__ void sincos_d(double x, double& s, double& c) {
    const double k = rint(x * 0.63661977236758134308);
    double r = fma(-k, 1.57079632679489655800e+00, x); r = fma(-k, 6.12323399573676603587e-17, r);
    const int q = ((int)k) & 3; const double r2 = r * r;
    double sp = -1.0 / 1307674368000.0; sp = fma(sp, r2, 1.0 / 6227020800.0); sp = fma(sp, r2, -1.0 / 39916800.0); sp = fma(sp, r2, 1.0 / 362880.0); sp = fma(sp, r2, -1.0 / 5040.0); sp = fma(sp, r2, 1.0 / 120.0); sp = fma(sp, r2, -1.0 / 6.0); sp = fma(sp * r2, r, r);
    double cp = 1.0 / 20922789888000.0; cp = fma(cp, r2, -1.0 / 87178291200.0); cp = fma(cp, r2, 1.0 / 479001600.0); cp = fma(cp, r2, -1.0 / 3628800.0); cp = fma(cp, r2, 1.0 / 40320.0); cp = fma(cp, r2, -1.0 / 720.0); cp = fma(cp, r2, 1.0 / 24.0); cp = fma(cp, r2, -0.5); cp = fma(cp, r2, 1.0);
    s = (q == 0) ? sp : (q == 1) ? cp : (q == 2) ? -sp : -cp;
    c = (q == 0) ? cp : (q == 1) ? -sp : (q == 2) ? -cp : sp;
}
__device__ __forceinline__ void ssm_abar(const float* a_re, const float* a_im, const float* log_dt, int g, int p, double& er, double& ei, double& ar, double& ai) {
    const double dt = (double)expf(log_dt[g]); ar = (double)a_re[g * SP + p]; ai = (double)a_im[g * SP + p];
    const double x = dt * ar;
    double mag = 1.0 / 362880.0; mag = fma(mag, x, 1.0 / 40320.0); mag = fma(mag, x, 1.0 / 5040.0); mag = fma(mag, x, 1.0 / 720.0); mag = fma(mag, x, 1.0 / 120.0); mag = fma(mag, x, 1.0 / 24.0); mag = fma(mag, x, 1.0 / 6.0); mag = fma(mag, x, 0.5); mag = fma(mag, x, 1.0); mag = fma(mag, x, 1.0);
    double s, c; sincos_d(dt * ai, s, c); er = mag * c; ei = mag * s;
}

#define XB_TMO      128
#define XB_XCNT(j)  (256  + 64 * (j))
#define XB_XSUB(j)  (1280 + 64 * (j))
#define XB_XGEN(j)  (2304 + 64 * (j))
#define XB_TOP      3328
#define XB_TOPGEN   3392
#define XCD_BAR_WORDS 3456
#define XB_SPIN_CAP (1u << 18)

__device__ __forceinline__ unsigned xb_ld(unsigned* p)              { return __hip_atomic_load(p, __ATOMIC_RELAXED, __HIP_MEMORY_SCOPE_AGENT); }
__device__ __forceinline__ unsigned xb_add(unsigned* p, unsigned v) { return __hip_atomic_fetch_add(p, v, __ATOMIC_RELAXED, __HIP_MEMORY_SCOPE_AGENT); }
__device__ __forceinline__ unsigned xb_xcc_id() { return (unsigned)__builtin_amdgcn_s_getreg((3 << 11) | 20) & 0xFu; }
#define XB_SPIN(cond, bar) do { unsigned _sp = 0; while (cond) { __builtin_amdgcn_s_sleep(1); \
    if ((++_sp & 255u) == 0u) { if (xb_ld(&(bar)[XB_TMO])) break; if (_sp > XB_SPIN_CAP) { atomicAdd(&(bar)[XB_TMO], 1u); break; } } } } while (0)

struct XcdBarrier {
    unsigned* bar; unsigned x;
    volatile LAS unsigned* st;
};

__device__ __forceinline__ XcdBarrier xcd_barrier_post(unsigned* bar, volatile LAS unsigned* st) {
    XcdBarrier b; b.bar = bar; b.x = xb_xcc_id(); b.st = st;
    if (threadIdx.x == 0) (void)xb_add(&bar[XB_XCNT(b.x)], 1u);
    return b;
}
__device__ __forceinline__ void xcd_barrier_complete(unsigned* bar, unsigned x, unsigned& nloc, unsigned& nx) {
    const unsigned G = gridDim.x * gridDim.y * gridDim.z;
    unsigned sum, cnt, mine, sp = 0u;
    for (;;) {
        sum = 0u; cnt = 0u; mine = 0u;
#pragma unroll
        for (unsigned j = 0; j < 16; ++j) { const unsigned c = xb_ld(&bar[XB_XCNT(j)]); sum += c; cnt += (c > 0u) ? 1u : 0u; mine = (j == x) ? c : mine; }
        if (sum == G) break;
        __builtin_amdgcn_s_sleep(1);
        if ((++sp & 255u) == 0u) { if (xb_ld(&bar[XB_TMO])) break; if (sp > XB_SPIN_CAP) { atomicAdd(&bar[XB_TMO], 1u); break; } }
    }
    nloc = mine > 0u ? mine : 1u; nx = cnt > 0u ? cnt : 1u;
}

__device__ __forceinline__ void xcd_barrier(const XcdBarrier& b) {
    asm volatile("s_waitcnt vmcnt(0)" ::: "memory");
    __syncthreads();
    if (threadIdx.x == 0) {
        unsigned* bar = b.bar;
        __builtin_amdgcn_s_waitcnt(0);
        unsigned nloc = b.st[0], nx = b.st[1];
        if (nloc == 0u) { xcd_barrier_complete(bar, b.x, nloc, nx); b.st[0] = nloc; b.st[1] = nx; }
        const unsigned old = xb_add(&bar[XB_XSUB(b.x)], 1u);
        const unsigned gen = old / nloc;
        if (old + 1u == (gen + 1u) * nloc) {
            __builtin_amdgcn_fence(__ATOMIC_RELEASE, "agent");
            asm volatile("s_waitcnt vmcnt(0)" ::: "memory");
            const unsigned og = xb_add(&bar[XB_TOP], 1u);
            const unsigned tg = og / nx;
            if (og + 1u == (tg + 1u) * nx) xb_add(&bar[XB_TOPGEN], 1u);
            else XB_SPIN(xb_ld(&bar[XB_TOPGEN]) == tg, bar);
            __builtin_amdgcn_fence(__ATOMIC_ACQUIRE, "agent");
            xb_add(&bar[XB_XGEN(b.x)], 1u);
            asm volatile("s_waitcnt vmcnt(0)" ::: "memory");
        } else {
            XB_SPIN(xb_ld(&bar[XB_TOPGEN]) == gen, bar);
            __builtin_amdgcn_fence(__ATOMIC_ACQUIRE, "agent");
            asm volatile("s_waitcnt vmcnt(0)" ::: "memory");
        }
    }
    __syncthreads();
}

struct Args { const float* in[25]; float* out; unsigned char* ws; int ph_lo, ph_hi; };
static_assert(sizeof(Args) == 25 * 8 + 8 + 8 + 8, "Args has no padding");

__global__ void __launch_bounds__(NTHR, 2) fwd_megakernel(Args args) {
    extern __shared__ __attribute__((aligned(16))) unsigned char lds_raw[];
    LAS unsigned char* lds = (LAS unsigned char*)lds_raw;
    const int tid = threadIdx.x, lane = tid & 63, wave = __builtin_amdgcn_readfirstlane(tid >> 6);
    const int G = gridDim.x, bid = blockIdx.x;
    const int gw = bid * NWAVES + wave, NGW = G * NWAVES;
    unsigned char* ws = args.ws;
    const float* x = args.in[0]; const float* cvec = args.in[1]; const float* w_ada = args.in[2]; const float* b_ada = args.in[3]; const float* n1g = args.in[4];
    const float* w_in = args.in[5]; const float* conv_w = args.in[6]; const float* conv_b = args.in[7]; const float* cln_g = args.in[8]; const float* cln_b = args.in[9];
    const float* conv_proj = args.in[10]; const float* a_re = args.in[11]; const float* a_im = args.in[12]; const float* b_re = args.in[13]; const float* b_im = args.in[14];
    const float* c_re = args.in[15]; const float* c_im = args.in[16]; const float* ssm_d = args.in[17]; const float* log_dt = args.in[18]; const float* ssm_glu = args.in[19];
    const float* w_out = args.in[20]; const float* n2g = args.in[21]; const float* w_ffn_in = args.in[22]; const float* w_ffn_out = args.in[23]; const float* final_g = args.in[24];
    float* out = args.out;
    float* MOD = (float*)(ws + WS_MOD); float* RSS1 = (float*)(ws + WS_RSS1); float* RSS2 = (float*)(ws + WS_RSS2); float* SHW = (float*)(ws + WS_SHW);
    bf16* WIN = (bf16*)(ws + WS_WIN); bf16* WCP = (bf16*)(ws + WS_WCP); bf16* WGLU = (bf16*)(ws + WS_WGLU); bf16* WOUT = (bf16*)(ws + WS_WOUT); bf16* WFI = (bf16*)(ws + WS_WFI); bf16* WFO = (bf16*)(ws + WS_WFO);
    bf16* W1T = (bf16*)(ws + WS_W1); bf16* B2T = (bf16*)(ws + WS_B2); bf16* H1 = (bf16*)(ws + WS_H1);
    bf16* UCONV = (bf16*)(ws + WS_UCONV); bf16* A2S = (bf16*)(ws + WS_A2S); bf16* SGC = (bf16*)(ws + WS_SGC); bf16* SGS = (bf16*)(ws + WS_SGS);
    bf16* ACONV = (bf16*)(ws + WS_ACONV); bf16* ASSM = (bf16*)(ws + WS_ASSM); float* SST = (float*)(ws + WS_S); bf16* MG = (bf16*)(ws + WS_MERGED); bf16* HID = (bf16*)(ws + WS_HID); bf16* X1B = (bf16*)(ws + WS_X1B);
    cg::grid_group grid = cg::this_grid();
    const int lo = args.ph_lo, hi = args.ph_hi;
    volatile LAS unsigned* bst = (volatile LAS unsigned*)(lds + RING_BYTES + 1024);
    if (tid < 2) bst[tid] = 0u;
    __syncthreads();
    XcdBarrier xbar = xcd_barrier_post((unsigned*)(ws + WS_BAR), bst);
    if (lo == 0x7fffffff) grid.sync();
#ifndef PHMASK
#define PHMASK 0xFF
#endif
#define IN(k) ((((PHMASK) >> (k)) & 1) && lo <= (k) && (k) < hi)
#define GRID_SYNC() do { xcd_barrier(xbar); } while (0)
#define SEAM(k) do { if (IN(k) && IN((k) + 1)) GRID_SYNC(); } while (0)
#define REPS(k) _Pragma("unroll 1") for (int rep_ = 0; rep_ < ((((DUP_MASK) >> (k)) & 1) ? 2 : 1); ++rep_)

    if (IN(0)) REPS(0) { if (rep_) GRID_SYNC();
        {
            LAS float* scr = (LAS float*)(lds + wave * 16384);
            constexpr int I_IN = (D / 64) * (INC / 32), I_CP = (CW / 64) * (D / 32), I_GLU = (SW / 64) * (2 * D / 32), I_OUT = (D / 64) * (D / 32), I_FI = (D / 64) * (2 * FH / 32), I_FO = (FH / 64) * (D / 32);
            constexpr int NITEMS = I_IN + I_FI;
            const int ngv = NMOD6 / 64;
            const int tw0 = (G >= 2 * ngv) ? (bid - ngv) * NWAVES + wave : gw, tnw = (G >= 2 * ngv) ? (G - ngv) * NWAVES : NGW;
            for (int it = (tw0 >= 0 ? tw0 : NITEMS); it < NITEMS; it += tnw) {
                if (it < I_FI) transpose_item(w_ffn_in, D, 2 * FH, WFI, 3, scr, it, lane);
                else transpose_item(w_in, D, INC, WIN, 1, scr, it - I_FI, lane);
            }
        }
        {
            __syncthreads();
            LAS float* red = (LAS float*)lds;
            LAS float* sc = (LAS float*)(lds + 8192);
            if (bid < NMOD6 / 64) { for (int e = tid; e < BATCH * D; e += NTHR) sc[e] = silu_f(cvec[e]); }
            __syncthreads();
            for (int it = bid; it < NMOD6 / 64; it += G) {
                const int col = it * 64 + lane; float a0 = 0.f, a1 = 0.f, a2 = 0.f, a3 = 0.f;
#pragma unroll 1
                for (int k0 = wave * 128; k0 < wave * 128 + 128; k0 += 32) { float wv[32];
#pragma unroll
                    for (int j = 0; j < 32; ++j) wv[j] = __builtin_nontemporal_load(w_ada + (size_t)(k0 + j) * NMOD6 + col);
#pragma unroll
                    for (int j = 0; j < 32; ++j) { a0 += wv[j] * sc[k0 + j]; a1 += wv[j] * sc[D + k0 + j]; a2 += wv[j] * sc[2 * D + k0 + j]; a3 += wv[j] * sc[3 * D + k0 + j]; } }
                red[(wave * 4 + 0) * 64 + lane] = a0; red[(wave * 4 + 1) * 64 + lane] = a1; red[(wave * 4 + 2) * 64 + lane] = a2; red[(wave * 4 + 3) * 64 + lane] = a3;
                __syncthreads();
                if (tid < 256) { const int b = tid >> 6, c = tid & 63; float t = b_ada[it * 64 + c];
#pragma unroll
                    for (int w = 0; w < 8; ++w) t += red[(w * 4 + b) * 64 + c];
                    __hip_atomic_store(MOD + b * NMOD6 + it * 64 + c, t, __ATOMIC_RELAXED, __HIP_MEMORY_SCOPE_AGENT); }
                asm volatile("s_waitcnt vmcnt(0)" ::: "memory");
                __syncthreads();
                if (tid == 0) __hip_atomic_fetch_add((unsigned*)(ws + WS_GCNT), 1u, __ATOMIC_RELAXED, __HIP_MEMORY_SCOPE_AGENT);
            }
        }
        {
            LAS f32x2* PW = (LAS f32x2*)(lds);
            LAS f32x2* QQ = (LAS f32x2*)(lds + 8704);
            LAS f32x2* BB = (LAS f32x2*)(lds + 9216);
            LAS f32x2* CC = (LAS f32x2*)(lds + 17408);
            LAS float* KT = (LAS float*)(lds + 25600);
            for (int it = bid; it < NG * 8; it += G) {
                const int g = it >> 3, rb = it & 7;
                __syncthreads();
                if (tid < 64) {
                    double er, ei, ar, ai; ssm_abar(a_re, a_im, log_dt, g, tid, er, ei, ar, ai);
                    const double nr = er - 1.0, ni = ei, den = ar * ar + ai * ai;
                    QQ[tid] = (f32x2){(float)((nr * ar + ni * ai) / den), (float)((ni * ar - nr * ai) / den)};
                    double pr = 1.0, pi = 0.0;
                    for (int j = 0; j <= 16; ++j) { PW[j * 64 + tid] = (f32x2){(float)pr, (float)pi}; const double t = pr * er - pi * ei; pi = pr * ei + pi * er; pr = t; }
                }
                for (int e = tid; e < 1024; e += NTHR) CC[e] = (f32x2){c_re[g * 1024 + e], c_im[g * 1024 + e]};
                __syncthreads();
                for (int e = tid; e < 1024; e += NTHR) { const f32x2 q = QQ[e >> 4]; const float br = b_re[g * 1024 + e], bi = b_im[g * 1024 + e]; BB[e] = (f32x2){q.x * br - q.y * bi, q.x * bi + q.y * br}; }
                __syncthreads();
                if (rb < 4) {
                    const int nl = 4 * rb + 4, pair = tid & 255, ho = pair >> 4, hi = pair & 15;
                    for (int j = tid >> 8; j < nl; j += 2) {
                        float s = 0.f;
                        for (int p = 0; p < 64; ++p) { const f32x2 c = CC[ho * 64 + p], w = PW[j * 64 + p], b = BB[p * 16 + hi];
                            const float cr = c.x * w.x - c.y * w.y, ci = c.x * w.y + c.y * w.x; s += cr * b.x - ci * b.y; }
                        KT[j * 256 + pair] = s;
                    }
                    __syncthreads();
                    for (int r = wave * 8; r < wave * 8 + 8; ++r) { const int n = 64 * rb + r, t = n >> 4, ho = n & 15;
#pragma unroll
                        for (int i = 0; i < 3; ++i) { const int kp = lane + 64 * i; float v[2];
#pragma unroll
                            for (int h = 0; h < 2; ++h) { const int k = 2 * kp + h;
                                if (k < 256) { const int s = k >> 4, hi = k & 15; v[h] = (s <= t) ? KT[(t - s) * 256 + ho * 16 + hi] : 0.f; }
                                else { const int p = (k - 256) & 63; const f32x2 c = CC[ho * 64 + p], w = PW[(t + 1) * 64 + p]; v[h] = (k < 320) ? (c.x * w.x - c.y * w.y) : -(c.x * w.y + c.y * w.x); } }
                            *(unsigned*)(B2T + ((size_t)(g * 256 + n) * KA2 + 2 * kp)) = cvt_pk_bf16(v[0], v[1]); } }
                } else {
                    for (int r = wave * 8; r < wave * 8 + 8; ++r) { const int n = 64 * (rb - 4) + r, p = n & 63;
#pragma unroll
                        for (int i = 0; i < 2; ++i) { const int kp = lane + 64 * i; float v[2];
#pragma unroll
                            for (int h = 0; h < 2; ++h) { const int k = 2 * kp + h, s = k >> 4, hi = k & 15; const f32x2 w = PW[(15 - s) * 64 + p], b = BB[p * 16 + hi];
                                v[h] = (n < 64) ? (w.x * b.x - w.y * b.y) : (n < 128) ? (w.x * b.y + w.y * b.x) : 0.f; }
                            *(unsigned*)(W1T + ((size_t)(g * 256 + n) * 256 + 2 * kp)) = cvt_pk_bf16(v[0], v[1]); } }
                }
            }
            __syncthreads();
        }
    }
    if (IN(0) && IN(1)) {
        if (tid == 0) { unsigned sp = 0; while (__hip_atomic_load((unsigned*)(ws + WS_GCNT), __ATOMIC_RELAXED, __HIP_MEMORY_SCOPE_AGENT) < (unsigned)(NMOD6 / 64)) { __builtin_amdgcn_s_sleep(2); if (++sp > (1u << 22)) break; }
            __builtin_amdgcn_fence(__ATOMIC_ACQUIRE, "agent"); asm volatile("s_waitcnt vmcnt(0)" ::: "memory"); }
        __syncthreads();
    }
    for (int xs_ = 0; xs_ < EXTRA_SYNCS; ++xs_) GRID_SYNC();

    if (IN(1)) REPS(1) { if (rep_) GRID_SYNC();
        for (int rb = gw * 8; rb < M; rb += NGW * 8) {
            const float* mb = MOD + (rb >> 12) * NMOD6;
            f32x4 v[8][4]; float inv[8];
#pragma unroll
            for (int q = 0; q < 8; ++q) { const f32x4* xr = (const f32x4*)(x + (size_t)(rb + q) * D) + lane;
#pragma unroll
                for (int j = 0; j < 4; ++j) v[q][j] = __builtin_nontemporal_load(xr + 64 * j); }
#pragma unroll
            for (int q = 0; q < 8; ++q) { float s = 0.f;
#pragma unroll
                for (int j = 0; j < 4; ++j) s += (v[q][j][0] * v[q][j][0] + v[q][j][1] * v[q][j][1]) + (v[q][j][2] * v[q][j][2] + v[q][j][3] * v[q][j][3]);
                inv[q] = rsqrtf(wave_sum(s) * (1.0f / D) + EPS); }
#pragma unroll
            for (int j = 0; j < 4; ++j) { const int col = lane * 4 + 256 * j;
                const f32x4 gsc = (*(const f32x4*)(n1g + col)) * (*(const f32x4*)(mb + D + col) + 1.0f), sh = *(const f32x4*)(mb + col);
#pragma unroll
                for (int q = 0; q < 8; ++q) { const f32x4 h = v[q][j] * inv[q] * gsc + sh;
                    v2u o; o.x = cvt_pk_bf16(h[0], h[1]); o.y = cvt_pk_bf16(h[2], h[3]); *(v2u*)(H1 + (size_t)(rb + q) * D + col) = o; } }
        }
    }
    SEAM(1);

    if (IN(2)) REPS(2) { if (rep_) GRID_SYNC();
        pg8::Gemm g{D, D, D}; pg8::StaticOrder S; S.init(M, INC, G, bid, H1, D, WIN, D);
        EpiIn E{UCONV, A2S, SGC, SGS};
        GEMM_CALL(EpiIn, pg8::StaticOrder)(lds, g, S, E);
        {
            constexpr int NU = (M / 256) * (INC / 256), I_CP = (CW / 64) * (D / 32), I_GLU = (SW / 64) * (2 * D / 32), I_OUT = (D / 64) * (D / 32);
            int first = NU % G, nhelp = G - first; if (first == 0) nhelp = G;
            if (bid >= first) {
                LAS float* scr = (LAS float*)(lds + wave * 16384);
                const int hw0 = (bid - first) * NWAVES + wave, hnw = nhelp * NWAVES;
                for (int it = hw0; it < I_GLU + I_OUT + I_CP; it += hnw) {
                    if (it < I_GLU) transpose_item(ssm_glu, SW, 2 * D, WGLU, 2, scr, it, lane);
                    else if (it < I_GLU + I_OUT) transpose_item(w_out, D, D, WOUT, 0, scr, it - I_GLU, lane);
                    else transpose_item(conv_proj, CW, D, WCP, 0, scr, it - I_GLU - I_OUT, lane);
                }
                for (int v = hw0; v < 2 * FH; v += hnw) {
                    const v4u w0 = *(const v4u*)(WFI + (size_t)v * D + lane * 8), w1 = *(const v4u*)(WFI + (size_t)v * D + 512 + lane * 8);
                    f32x4 a0, a1, b0, b1; unpack8(w0, a0, a1); unpack8(w1, b0, b1);
        #pragma unroll
                    for (int b = 0; b < BATCH; ++b) { const float* sh = MOD + b * NMOD6 + 3 * D;
                        const f32x4 s0 = *(const f32x4*)(sh + lane * 8), s1 = *(const f32x4*)(sh + lane * 8 + 4), s2 = *(const f32x4*)(sh + 512 + lane * 8), s3 = *(const f32x4*)(sh + 512 + lane * 8 + 4);
                        const f32x4 pr = a0 * s0 + a1 * s1 + b0 * s2 + b1 * s3; const float t = wave_sum((pr[0] + pr[1]) + (pr[2] + pr[3]));
                        if (lane == 0) SHW[b * (2 * FH) + v] = t; }
                }
            }
        }
    }
    SEAM(2);

    if (IN(3)) REPS(3) { if (rep_) GRID_SYNC();
        {
            const int cp = tid & 255, th = tid >> 8;
            LAS float* OUTT = (LAS float*)(lds + 65536);
            const bool bal = (G == 256);
            const int nmine = bal ? (bid < NG * 4 ? 0 : 4) : (M / 32 - bid + G - 1) / G;
            f32x2 w[CK];
#pragma unroll
            for (int j = 0; j < CK; ++j) w[j] = *(const f32x2*)(conv_w + j * CW + 2 * cp);
            const f32x2 bias = *(const f32x2*)(conv_b + 2 * cp);
#define CONV_ITEM(ii_) (bal ? (bid - NG * 4) * 4 + (ii_) : bid + (ii_) * G)
#define CONV_FETCH(dst, it_) do { const int t0_ = (it_) * 32, pos0_ = t0_ & (SEQ - 1); _Pragma("unroll") for (int k_ = 0; k_ < 8; ++k_) { const int e_ = tid + k_ * NTHR, r_ = e_ >> 6, ch_ = e_ & 63; v4u v_ = {0u, 0u, 0u, 0u}; \
                if (e_ < 62 * 64 && pos0_ - 30 + r_ >= 0) v_ = *(const v4u*)(UCONV + (size_t)(t0_ - 30 + r_) * CW + ch_ * 8); dst[k_] = v_; } } while (0)
            v4u pre[8];
            if (nmine > 0) CONV_FETCH(pre, CONV_ITEM(0));
            for (int ii = 0; ii < nmine; ++ii) {
                const int item = CONV_ITEM(ii);
                const int t0 = item * 32;
                __syncthreads();
#pragma unroll
                for (int k = 0; k < 8; ++k) { const int e = tid + k * NTHR; if (e < 62 * 64) *(LAS v4u*)(lds + (e >> 6) * 1024 + (e & 63) * 16) = pre[k]; }
                if (ii + 1 < nmine) CONV_FETCH(pre, CONV_ITEM(ii + 1));
                f32x2 acc[16];
#pragma unroll
                for (int q = 0; q < 16; ++q) acc[q] = bias;
                __syncthreads();
#pragma unroll
                for (int i = 0; i < 46; ++i) { const unsigned uv = *(const LAS unsigned*)(lds + (th * 16 + i) * 1024 + cp * 4); const f32x2 vv = {bf_lo(uv), bf_hi(uv)};
#pragma unroll
                    for (int q = 0; q < 16; ++q) { const int j = i - q; if (j >= 0 && j < CK) acc[q] += vv * w[j]; } }
#pragma unroll
                for (int q = 0; q < 16; ++q) *(LAS f32x2*)(OUTT + (th * 16 + q) * 512 + 2 * cp) = acc[q];
                __syncthreads();
#pragma unroll
                for (int q = 0; q < 4; ++q) { const int tt = wave * 4 + q; const LAS float* rowp = OUTT + tt * 512;
                    f32x4 a = *(const LAS f32x4*)(rowp + lane * 4), b = *(const LAS f32x4*)(rowp + 256 + lane * 4);
                    const float mu = wave_sum((a[0] + a[1]) + (a[2] + a[3]) + (b[0] + b[1]) + (b[2] + b[3])) * (1.0f / CW);
                    a -= mu; b -= mu;
                    const float var = wave_sum((a[0] * a[0] + a[1] * a[1]) + (a[2] * a[2] + a[3] * a[3]) + (b[0] * b[0] + b[1] * b[1]) + (b[2] * b[2] + b[3] * b[3])) * (1.0f / CW);
                    const float rstd = rsqrtf(var + EPS);
                    a = a * rstd * (*(const f32x4*)(cln_g + lane * 4)) + *(const f32x4*)(cln_b + lane * 4);
                    b = b * rstd * (*(const f32x4*)(cln_g + 256 + lane * 4)) + *(const f32x4*)(cln_b + 256 + lane * 4);
                    v2u o0, o1; o0.x = cvt_pk_bf16(silu_f(a[0]), silu_f(a[1])); o0.y = cvt_pk_bf16(silu_f(a[2]), silu_f(a[3])); o1.x = cvt_pk_bf16(silu_f(b[0]), silu_f(b[1])); o1.y = cvt_pk_bf16(silu_f(b[2]), silu_f(b[3]));
                    bf16* dst = ACONV + (size_t)(t0 + tt) * CW; *(v2u*)(dst + lane * 4) = o0; *(v2u*)(dst + 256 + lane * 4) = o1; }
            }
            __syncthreads();
        }
        if (bid < NG * 4) {
            const int L = bid, g = L >> 2, b = L & 3;
            {
                pg8::Gemm gg{256, KA2, 256}; BatchOrder S{4, NG * 4, 1 << 20, L, (const char*)A2S, (const char*)W1T, (size_t)NCH * KA2 * 2, (size_t)256 * KA2 * 2, (size_t)256 * 256 * 2};
                EpiStateLds E{};
                GEMM_CALL(EpiStateLds, BatchOrder)(lds, gg, S, E);
            }
            __syncthreads();
            {
                double er, ei, ar, ai; ssm_abar(a_re, a_im, log_dt, g, lane, er, ei, ar, ai);
#pragma unroll
                for (int j = 0; j < 4; ++j) { const double t = er * er - ei * ei; ei = 2.0 * er * ei; er = t; }
                const float alr = (float)er, ali = (float)ei;
#pragma unroll
                for (int j = 0; j < 5; ++j) { const double t = er * er - ei * ei; ei = 2.0 * er * ei; er = t; }
                const float a32r = (float)er, a32i = (float)ei;
                const LAS float* sl = (const LAS float*)lds + wave * 32 * 128; LAS f32x2* EE = (LAS f32x2*)(lds + RING_BYTES + 2048);
                float xr = 0.f, xi = 0.f;
#pragma unroll 8
                for (int c = 0; c < 32; ++c) { const float sr = sl[c * 128 + lane], si = sl[c * 128 + 64 + lane]; const float nr = alr * xr - ali * xi + sr, ni = alr * xi + ali * xr + si; xr = nr; xi = ni; }
                EE[wave * 64 + lane] = (f32x2){xr, xi};
                __syncthreads();
                xr = 0.f; xi = 0.f;
                for (int v = 0; v < wave; ++v) { const f32x2 e = EE[v * 64 + lane]; const float nr = a32r * xr - a32i * xi + e.x, ni = a32r * xi + a32i * xr + e.y; xr = nr; xi = ni; }
                bf16* dst = A2S + (size_t)(g * NCH + b * CPB + wave * 32) * KA2 + 256 + lane;
#pragma unroll 8
                for (int c = 0; c < 32; ++c) {
                    const unsigned pk = cvt_pk_bf16(xr, xi); dst[(size_t)c * KA2] = (bf16)(pk & 0xffffu); dst[(size_t)c * KA2 + 64] = (bf16)(pk >> 16);
                    const float sr = sl[c * 128 + lane], si = sl[c * 128 + 64 + lane];
                    const float nr = alr * xr - ali * xi + sr, ni = alr * xi + ali * xr + si; xr = nr; xi = ni;
                }
            }
            asm volatile("s_waitcnt vmcnt(0)" ::: "memory");
            __syncthreads(); __builtin_amdgcn_fence(__ATOMIC_ACQUIRE, "agent");
            {
                pg8::Gemm gg{KA2, KA2, KA2}; BatchOrder S{4, NG * 4, 1 << 20, L, (const char*)A2S, (const char*)B2T, (size_t)NCH * KA2 * 2, (size_t)256 * KA2 * 2, (size_t)256 * KA2 * 2};
                EpiSsmOut E{A2S, ssm_d, ASSM};
                GEMM_CALL(EpiSsmOut, BatchOrder)(lds, gg, S, E);
            }
        }
    }
    SEAM(3);

    if (IN(4)) REPS(4) { if (rep_) GRID_SYNC();
        pg8::Gemm g{SW, SW, SW}; TripleOrder S; S.base.init(M, D, G, bid, ACONV, CW, WCP, CW); S.A1 = (const char*)ASSM; S.B1 = (const char*)WGLU; S.tsA = (size_t)256 * SW * 2; S.tsB = (size_t)256 * SW * 2;
        EpiMix E{SGC, SGS, MG};
        GEMM_CALL(EpiMix, TripleOrder)(lds, g, S, E);
    }
    SEAM(4);

    if (IN(5)) REPS(5) { if (rep_) GRID_SYNC();
        pg8::Gemm g{D, D, D}; pg8::StaticOrder S; S.init(M, D, G, bid, MG, D, WOUT, D);
        EpiOut E{x, MOD, n2g, X1B, H1, RSS1};
        GEMM_CALL(EpiOut, pg8::StaticOrder)(lds, g, S, E);
    }
    SEAM(5);

    if (IN(6)) REPS(6) { if (rep_) GRID_SYNC();
        pg8::Gemm g{D, D, D}; pg8::StaticOrder S; S.init(M, 2 * FH, G, bid, H1, D, WFI, D);
        EpiFfnIn E{RSS1, SHW, HID};
        GEMM_CALL(EpiFfnIn, pg8::StaticOrder)(lds, g, S, E);
        {
            constexpr int NU = (M / 256) * (2 * FH / 256), I_FO = (FH / 64) * (D / 32);
            int first = NU % G, nhelp = G - first; if (first == 0) nhelp = G;
            if (bid >= first) {
                LAS float* scr = (LAS float*)(lds + wave * 16384);
                for (int it = (bid - first) * NWAVES + wave; it < I_FO; it += nhelp * NWAVES) transpose_item(w_ffn_out, FH, D, WFO, 0, scr, it, lane);
            }
        }
    }
    SEAM(6);

    if (IN(7)) REPS(7) { if (rep_) GRID_SYNC();
        pg8::Gemm g{FH, FH, FH}; pg8::StaticOrder S; S.init(M, D, G, bid, HID, FH, WFO, FH);
        EpiFfnOut E{MOD, final_g, n2g, H1, out, RSS2, (unsigned*)(ws + WS_PCNT)};
        GEMM_CALL(EpiFfnOut, pg8::StaticOrder)(lds, g, S, E);
    }

#undef IN
#undef SEAM
}

extern "C" void kernel_launch(void* const* d_in, const int* in_sizes, int n_in, void* d_out, int out_size, void* d_ws, size_t ws_size, hipStream_t stream) {
    static int grid = 0;
    if (grid == 0) {
        if (n_in != 25 || out_size != M * D || ws_size < WS_END) { fprintf(stderr, "kernel_launch: unexpected shapes (n_in %d out %d ws %zu)\n", n_in, out_size, ws_size); grid = -1; return; }
        int dev = 0, cus = 0, per_cu = 0;
        (void)hipGetDevice(&dev); (void)hipDeviceGetAttribute(&cus, hipDeviceAttributeMultiprocessorCount, dev);
        if (hipFuncSetAttribute((const void*)fwd_megakernel, hipFuncAttributeMaxDynamicSharedMemorySize, LDS_BYTES) != hipSuccess) { fprintf(stderr, "kernel_launch: hipFuncSetAttribute failed\n"); grid = -1; return; }
        if (hipOccupancyMaxActiveBlocksPerMultiprocessor(&per_cu, (const void*)fwd_megakernel, NTHR, LDS_BYTES) != hipSuccess || per_cu < 1) { fprintf(stderr, "kernel_launch: occupancy query failed (%d)\n", per_cu); (void)hipGetLastError(); per_cu = 1; }
        grid = cus * (per_cu > 1 ? 1 : per_cu);
        if (grid <= 0) grid = 256;
    }
    if (grid < 0) return;
    (void)hipMemsetAsync((char*)d_ws + WS_BAR, 0, BAR_BYTES, stream);
    Args a{};
    for (int i = 0; i < 25; ++i) a.in[i] = (const float*)d_in[i];
    a.out = (float*)d_out; a.ws = (unsigned char*)d_ws;
#if MK_PER_PHASE
    for (int ph = 0; ph < NPHASE; ++ph) { a.ph_lo = ph; a.ph_hi = ph + 1; hipLaunchKernelGGL(fwd_megakernel, dim3(grid), dim3(NTHR), LDS_BYTES, stream, a); }
#else
    a.ph_lo = 0; a.ph_hi = NPHASE;
    void* kargs[] = {&a};
    hipError_t e = hipLaunchCooperativeKernel((const void*)fwd_megakernel, dim3(grid), dim3(NTHR), kargs, LDS_BYTES, stream);
    if (e != hipSuccess) fprintf(stderr, "kernel_launch: cooperative launch failed: %s (grid %d)\n", hipGetErrorString(e), grid);
#endif
}
```

```cpp
#include <hip/hip_runtime.h>
#include <hip/hip_cooperative_groups.h>
#include <cstdio>
#include <cstdint>
namespace cg = cooperative_groups;
#define PG8_ALIGN true
#define PG8_SP2 true
#ifndef DUP_MASK
#define DUP_MASK 0x000
#endif
#ifndef EXTRA_SYNCS
#define EXTRA_SYNCS 0
#endif
#ifndef GEMM_SIMPLE
#define GEMM_SIMPLE 0
#endif
#if GEMM_SIMPLE
#define GEMM_CALL(E_, S_) pg8::gemm_simple<E_, S_>
#else
#define GEMM_CALL(E_, S_) pg8::gemm_phase<E_, S_, PG8_ALIGN, PG8_SP2>
#endif
#ifndef MK_PER_PHASE
#define MK_PER_PHASE 0
#endif
namespace pg8 {
#define PG8_LAS __attribute__((address_space(3)))
typedef unsigned short bf16_t;
typedef short bf16x8 __attribute__((ext_vector_type(8)));
typedef float f32x4 __attribute__((ext_vector_type(4)));
typedef unsigned u32x4 __attribute__((ext_vector_type(4)));
constexpr int BM = 256, BK = 64, HALF = 128, HTB = HALF * BK * 2  , STAGE_BYTES = 8 * HTB, NXCD = 8, WGM = 8;

__host__ __device__ __forceinline__ int lds_byte(int r, int c) { const int st = (r >> 4) * 2 + (c >> 5), rr = r & 15, cc = c & 31, ob = rr * 64 + cc * 2; return st * 1024 + (ob ^ (((ob >> 9) & 1) << 5)); }
__host__ __device__ __forceinline__ void stage_rc(int b, int& R, int& C) { const int st = b / 1024, sb = b % 1024, swz = sb ^ (((sb >> 9) & 1) << 5); R = (st >> 1) * 16 + swz / 64; C = (st & 1) * 32 + (swz % 64) / 2; }
__host__ __device__ __forceinline__ int perm32(int rho) { const int n = rho >> 4, i = rho & 15; return 8 * (i >> 2) + 4 * n + (i & 3); }

struct Unit { int pm, pn, z; };
struct Gemm { int K, lda, ldb; };

struct StaticOrder {
    int nM, nN, nwg, G, c; const char* A; const char* B; size_t tsA, tsB;
    __host__ __device__ void init(int M, int N, int G_, int c_, const void* A_, int lda, const void* B_, int ldb) { nM = M / BM; nN = N / BM; nwg = nM * nN; G = G_; c = c_; A = (const char*)A_; B = (const char*)B_; tsA = (size_t)BM * lda * 2; tsB = (size_t)BM * ldb * 2; }
    __device__ __forceinline__ const char* pa(const Unit& u) const { return A + (size_t)u.pm * tsA; }
    __device__ __forceinline__ const char* pb(const Unit& u) const { return B + (size_t)u.pn * tsB; }
    __host__ __device__ bool next(int i, Unit& u) const {
        const long L = (long)i * G + c; if (L >= nwg) return false;
        int wgid = (int)L; { const int q = nwg / NXCD, r = nwg % NXCD, xcd = wgid % NXCD, off = wgid / NXCD; wgid = (xcd < r ? xcd * (q + 1) : r * (q + 1) + (xcd - r) * q) + off; }
        const int nig = WGM * nN, gid = wgid / nig, fm = gid * WGM, gsz = (nM - fm) < WGM ? (nM - fm) : WGM;
        u.pm = fm + ((wgid % nig) % gsz); u.pn = (wgid % nig) / gsz; u.z = 0; return true;
    }
    __device__ __forceinline__ void a_ready(const Unit&) const {}
    __device__ __forceinline__ void done(const Unit&) const {}
};

__device__ __forceinline__ unsigned cvt_pk_bf16(float lo, float hi) { unsigned r; asm volatile("s_nop 1\n\tv_cvt_pk_bf16_f32 %0, %1, %2" : "=v"(r) : "v"(lo), "v"(hi)); return r; }
template <class Epi, class Sched, bool ALIGN_EPI = false, bool SP2 = false>
__device__ __forceinline__ void gemm_phase(PG8_LAS unsigned char* lds, const Gemm g, const Sched& S, const Epi& E) {
    const int tid = threadIdx.x, wid = __builtin_amdgcn_readfirstlane(tid >> 6), lane = tid & 63, wr = wid >> 2, wc = wid & 3, fr = lane & 15, fq = lane >> 4;
    const int K = g.K, nt = K / BK;
    unsigned voffA[2], voffB[2];
#pragma unroll
    for (int i = 0; i < 2; ++i) { int R, C; stage_rc(tid * 16 + i * 8192, R, C); const int Rb = Epi::PERM ? ((R & ~31) + perm32(R & 31)) : R;
        voffA[i] = (unsigned)(R * g.lda + C) * 2u; voffB[i] = (unsigned)(Rb * g.ldb + C) * 2u; }
    const size_t kstep = (size_t)(BK * 2);
    const size_t hstepA = (size_t)HALF * g.lda * 2, hstepB = (size_t)HALF * g.ldb * 2;
    const unsigned ldsw = (unsigned)wid * 1024u;
    const int aoff = lds_byte(wr * 64 + fr, fq * 8), boff = lds_byte(wc * 32 + fr, fq * 8);
#define PG8_SA(b, h) (((b) * 2 + (h)) * HTB)
#define PG8_SB(b, h) ((4 + (b) * 2 + (h)) * HTB)
#define PG8_STAGE(bufoff, gbase, voff) do { _Pragma("unroll") for (int _i = 0; _i < 2; ++_i) \
        __builtin_amdgcn_global_load_lds((const unsigned*)((const char*)(gbase) + (voff)[_i]), (PG8_LAS unsigned*)(lds + (bufoff) + ldsw + _i * 8192), 16, 0, 0); } while (0)
#define PG8_LDA(dst, b, h) do { _Pragma("unroll") for (int m = 0; m < 4; ++m) _Pragma("unroll") for (int k = 0; k < 2; ++k) dst[m][k] = *(const PG8_LAS bf16x8*)(lds + PG8_SA(b, h) + aoff + m * 2048 + k * 1024); } while (0)
#define PG8_LDB(dst, b, h) do { _Pragma("unroll") for (int n = 0; n < 2; ++n) _Pragma("unroll") for (int k = 0; k < 2; ++k) dst[n][k] = *(const PG8_LAS bf16x8*)(lds + PG8_SB(b, h) + boff + n * 2048 + k * 1024); } while (0)
#define PG8_MMA(ai, bj, At, Bt) do { __builtin_amdgcn_s_setprio(1); _Pragma("unroll") for (int m = 0; m < 4; ++m) _Pragma("unroll") for (int n = 0; n < 2; ++n) _Pragma("unroll") for (int k = 0; k < 2; ++k) \
        acc[ai][bj][m][n] = __builtin_amdgcn_mfma_f32_16x16x32_bf16(Bt[n][k], At[m][k], acc[ai][bj][m][n], 0, 0, 0); __builtin_amdgcn_s_setprio(0); } while (0)
#define PG8_WAIT_V(n) asm volatile("s_waitcnt vmcnt(" #n ")" ::: "memory")
#define PG8_WAIT_L(n) asm volatile("s_waitcnt lgkmcnt(" #n ")" ::: "memory")
#define PG8_BAR __builtin_amdgcn_s_barrier()
#define PG8_SCHED __builtin_amdgcn_sched_barrier(0)
    Unit cur, nxt; int ui = 0;
    if (!S.next(0, cur)) return;
    f32x4 acc[2][2][4][2];
#pragma unroll
    for (int a = 0; a < 2; ++a)
#pragma unroll
        for (int b = 0; b < 2; ++b)
#pragma unroll
            for (int m = 0; m < 4; ++m)
#pragma unroll
                for (int n = 0; n < 2; ++n) acc[a][b][m][n] = (f32x4){0.f, 0.f, 0.f, 0.f};
    bf16x8 At[4][2], B0[2][2], B1[2][2];
    const char* cA = S.pa(cur); const char* cB = S.pb(cur);
    S.a_ready(cur);
    if constexpr (SP2) {
        PG8_STAGE(PG8_SB(0, 0), cB, voffB); PG8_STAGE(PG8_SB(0, 1), cB + hstepB, voffB); PG8_STAGE(PG8_SA(0, 0), cA, voffA); PG8_STAGE(PG8_SA(0, 1), cA + hstepA, voffA);
        if (wr == 1) PG8_BAR;
        PG8_WAIT_V(2); PG8_BAR;
        PG8_STAGE(PG8_SB(1, 0), cB + kstep, voffB); PG8_STAGE(PG8_SA(1, 0), cA + kstep, voffA); PG8_STAGE(PG8_SB(1, 1), cB + hstepB + kstep, voffB);
        PG8_WAIT_V(6); PG8_BAR;
    } else {
        PG8_STAGE(PG8_SB(0, 0), cB, voffB); PG8_STAGE(PG8_SA(0, 0), cA, voffA); PG8_STAGE(PG8_SB(0, 1), cB + hstepB, voffB); PG8_STAGE(PG8_SA(0, 1), cA + hstepA, voffA);
        if (wr == 1) PG8_BAR;
        PG8_WAIT_V(4); PG8_BAR;
        PG8_STAGE(PG8_SB(1, 0), cB + kstep, voffB); PG8_STAGE(PG8_SA(1, 0), cA + kstep, voffA); PG8_STAGE(PG8_SB(1, 1), cB + hstepB + kstep, voffB);
        PG8_WAIT_V(6); PG8_BAR;
    }
    for (;;) {
        const bool has_next = S.next(ui + 1, nxt);
        const char* nA = has_next ? S.pa(nxt) : cA; const char* nB = has_next ? S.pb(nxt) : cB;
#pragma unroll 1
        for (int t = 0; t < nt; t += 2) {
            const bool last = (t == nt - 2);
            const char* a1 = cA + (size_t)(t + 1) * kstep;
            const char* a2 = last ? nA : cA + (size_t)(t + 2) * kstep; const char* b2 = last ? nB : cB + (size_t)(t + 2) * kstep;
            const char* a3 = a2 + kstep; const char* b3 = b2 + kstep;
            if (last && has_next) S.a_ready(nxt);
            if constexpr (SP2) {
            PG8_LDB(B0, 0, 0); PG8_LDB(B1, 0, 1); PG8_SCHED; PG8_LDA(At, 0, 0); PG8_STAGE(PG8_SA(1, 1), a1 + hstepA, voffA);
            PG8_WAIT_V(8); PG8_WAIT_L(0); PG8_BAR; PG8_MMA(0, 0, At, B0); if constexpr (!Epi::HALF_N) PG8_MMA(0, 1, At, B1); PG8_BAR; PG8_SCHED;
            PG8_LDA(At, 0, 1); PG8_STAGE(PG8_SB(0, 0), b2, voffB); PG8_STAGE(PG8_SB(0, 1), b2 + hstepB, voffB); PG8_STAGE(PG8_SA(0, 0), a2, voffA);
            PG8_WAIT_V(8); PG8_WAIT_L(0); PG8_BAR; PG8_MMA(1, 0, At, B0); if constexpr (!Epi::HALF_N) PG8_MMA(1, 1, At, B1); PG8_BAR; PG8_SCHED;
            PG8_LDB(B0, 1, 0); PG8_LDB(B1, 1, 1); PG8_SCHED; PG8_LDA(At, 1, 0); PG8_STAGE(PG8_SA(0, 1), a2 + hstepA, voffA);
            PG8_WAIT_V(8); PG8_WAIT_L(0); PG8_BAR; PG8_MMA(0, 0, At, B0); if constexpr (!Epi::HALF_N) PG8_MMA(0, 1, At, B1); PG8_BAR; PG8_SCHED;
            PG8_LDA(At, 1, 1); PG8_STAGE(PG8_SB(1, 0), b3, voffB); PG8_STAGE(PG8_SB(1, 1), b3 + hstepB, voffB); PG8_STAGE(PG8_SA(1, 0), a3, voffA);
            PG8_WAIT_V(8); PG8_WAIT_L(0); PG8_BAR; PG8_MMA(1, 0, At, B0); if constexpr (!Epi::HALF_N) PG8_MMA(1, 1, At, B1); PG8_BAR; PG8_SCHED;
            } else {
            PG8_LDB(B0, 0, 0); PG8_SCHED; PG8_LDA(At, 0, 0); PG8_STAGE(PG8_SA(1, 1), a1 + hstepA, voffA);
            PG8_WAIT_L(8); PG8_BAR; PG8_WAIT_L(0); PG8_MMA(0, 0, At, B0); PG8_BAR; PG8_SCHED;
            PG8_LDB(B1, 0, 1); PG8_STAGE(PG8_SB(0, 0), b2, voffB);
            PG8_BAR; PG8_WAIT_L(0); PG8_MMA(0, 1, At, B1); PG8_BAR;
            PG8_LDA(At, 0, 1); PG8_STAGE(PG8_SA(0, 0), a2, voffA);
            PG8_BAR; PG8_WAIT_L(0); PG8_MMA(1, 0, At, B0); PG8_BAR; PG8_SCHED;
            PG8_STAGE(PG8_SB(0, 1), b2 + hstepB, voffB);
            PG8_WAIT_V(6); PG8_BAR; PG8_MMA(1, 1, At, B1); PG8_BAR;
            PG8_LDB(B0, 1, 0); PG8_SCHED; PG8_LDA(At, 1, 0); PG8_STAGE(PG8_SA(0, 1), a2 + hstepA, voffA);
            PG8_WAIT_L(8); PG8_BAR; PG8_WAIT_L(0); PG8_MMA(0, 0, At, B0); PG8_BAR; PG8_SCHED;
            PG8_LDB(B1, 1, 1); PG8_STAGE(PG8_SB(1, 0), b3, voffB);
            PG8_BAR; PG8_WAIT_L(0); PG8_MMA(0, 1, At, B1); PG8_BAR;
            PG8_LDA(At, 1, 1); PG8_STAGE(PG8_SA(1, 0), a3, voffA);
            PG8_BAR; PG8_WAIT_L(0); PG8_MMA(1, 0, At, B0); PG8_BAR; PG8_SCHED;
            PG8_STAGE(PG8_SB(1, 1), b3 + hstepB, voffB);
            PG8_WAIT_V(6); PG8_BAR; PG8_MMA(1, 1, At, B1); PG8_BAR;
            }
        }
        if constexpr (ALIGN_EPI) { if (wr == 0) PG8_BAR; }
        if constexpr (!Epi::AFTER_DRAIN) { E(acc, cur, wr, wc, fr, fq); S.done(cur); }
        if (!has_next) break;
#pragma unroll
        for (int a = 0; a < 2; ++a)
#pragma unroll
            for (int b = 0; b < 2; ++b)
#pragma unroll
                for (int m = 0; m < 4; ++m)
#pragma unroll
                    for (int n = 0; n < 2; ++n) acc[a][b][m][n] = (f32x4){0.f, 0.f, 0.f, 0.f};
        cur = nxt; cA = nA; cB = nB; ++ui;
        if constexpr (ALIGN_EPI) { if (wr == 1) PG8_BAR; }
    }
    PG8_WAIT_V(0);
    if constexpr (!ALIGN_EPI) { if (wr == 0) PG8_BAR; }
    PG8_BAR;
    if constexpr (Epi::AFTER_DRAIN) { E.fused(acc, cur, wr, wc, fr, fq, lds, wid, lane); S.done(cur); }
#undef PG8_SA
#undef PG8_SB
#undef PG8_STAGE
#undef PG8_LDA
#undef PG8_LDB
#undef PG8_MMA
#undef PG8_WAIT_V
#undef PG8_WAIT_L
#undef PG8_BAR
#undef PG8_SCHED
}

template <class Epi, class Sched>
__device__ __forceinline__ void gemm_simple(PG8_LAS unsigned char* lds, const Gemm g, const Sched& S, const Epi& E) {
    const int tid = threadIdx.x, wid = __builtin_amdgcn_readfirstlane(tid >> 6), lane = tid & 63, wr = wid >> 2, wc = wid & 3, fr = lane & 15, fq = lane >> 4;
    const int nt = g.K / BK;
    unsigned voffA[2], voffB[2];
#pragma unroll
    for (int i = 0; i < 2; ++i) { int R, C; stage_rc(tid * 16 + i * 8192, R, C); const int Rb = Epi::PERM ? ((R & ~31) + perm32(R & 31)) : R;
        voffA[i] = (unsigned)(R * g.lda + C) * 2u; voffB[i] = (unsigned)(Rb * g.ldb + C) * 2u; }
    const size_t kstep = (size_t)(BK * 2), hstepA = (size_t)HALF * g.lda * 2, hstepB = (size_t)HALF * g.ldb * 2;
    const unsigned ldst = (unsigned)tid * 16u;
    const int aoff = lds_byte(wr * 64 + fr, fq * 8), boff = lds_byte(wc * 32 + fr, fq * 8);
#define SG_SA(b, h) (((b) * 2 + (h)) * HTB)
#define SG_SB(b, h) ((4 + (b) * 2 + (h)) * HTB)
#define SG_LDB(dst, b, h) do { _Pragma("unroll") for (int n = 0; n < 2; ++n) _Pragma("unroll") for (int k = 0; k < 2; ++k) dst[n][k] = *(const PG8_LAS bf16x8*)(lds + SG_SB(b, h) + boff + n * 2048 + k * 1024); } while (0)
#define SG_AFRAG(b, st, k) (*(const PG8_LAS bf16x8*)(lds + SG_SA(b, (st) >> 2) + aoff + ((st) & 3) * 2048 + (k) * 1024))
#define SG_AHALF(b, ai) do { bf16x8 c0 = SG_AFRAG(b, (ai) * 4, 0), c1 = SG_AFRAG(b, (ai) * 4, 1); \
        _Pragma("unroll") for (int m = 0; m < 4; ++m) { bf16x8 n0 = c0, n1 = c1; \
            if (m < 3) { n0 = SG_AFRAG(b, (ai) * 4 + m + 1, 0); n1 = SG_AFRAG(b, (ai) * 4 + m + 1, 1); } \
            __builtin_amdgcn_sched_barrier(0); \
            _Pragma("unroll") for (int n = 0; n < 2; ++n) { \
                acc[ai][0][m][n] = __builtin_amdgcn_mfma_f32_16x16x32_bf16(B0[n][0], c0, acc[ai][0][m][n], 0, 0, 0); acc[ai][0][m][n] = __builtin_amdgcn_mfma_f32_16x16x32_bf16(B0[n][1], c1, acc[ai][0][m][n], 0, 0, 0); \
                acc[ai][1][m][n] = __builtin_amdgcn_mfma_f32_16x16x32_bf16(B1[n][0], c0, acc[ai][1][m][n], 0, 0, 0); acc[ai][1][m][n] = __builtin_amdgcn_mfma_f32_16x16x32_bf16(B1[n][1], c1, acc[ai][1][m][n], 0, 0, 0); } \
            __builtin_amdgcn_sched_barrier(0); c0 = n0; c1 = n1; } } while (0)
#define SG_LOADA(t) do { _Pragma("unroll") for (int h = 0; h < 2; ++h) _Pragma("unroll") for (int i = 0; i < 2; ++i) rr[h][i] = *(const u32x4*)(cA + h * hstepA + (size_t)(t) * kstep + voffA[i]); } while (0)
#define SG_LOADB(t) do { _Pragma("unroll") for (int h = 0; h < 2; ++h) _Pragma("unroll") for (int i = 0; i < 2; ++i) rr[h][i] = *(const u32x4*)(cB + h * hstepB + (size_t)(t) * kstep + voffB[i]); } while (0)
#define SG_STOREA(b) do { _Pragma("unroll") for (int h = 0; h < 2; ++h) _Pragma("unroll") for (int i = 0; i < 2; ++i) *(PG8_LAS u32x4*)(lds + SG_SA(b, h) + i * 8192 + ldst) = rr[h][i]; } while (0)
#define SG_STOREB(b) do { _Pragma("unroll") for (int h = 0; h < 2; ++h) _Pragma("unroll") for (int i = 0; i < 2; ++i) *(PG8_LAS u32x4*)(lds + SG_SB(b, h) + i * 8192 + ldst) = rr[h][i]; } while (0)
#define SG_KTILE(b, tn, more) do { bf16x8 B0[2][2], B1[2][2]; if (more) SG_LOADA(tn); SG_LDB(B0, b, 0); SG_LDB(B1, b, 1); SG_AHALF(b, 0); \
        if (more) { SG_STOREA((b) ^ 1); SG_LOADB(tn); } SG_AHALF(b, 1); if (more) SG_STOREB((b) ^ 1); __syncthreads(); } while (0)
    Unit cur;
    for (int ui = 0; S.next(ui, cur); ++ui) {
        f32x4 acc[2][2][4][2];
#pragma unroll
        for (int a = 0; a < 2; ++a)
#pragma unroll
            for (int b = 0; b < 2; ++b)
#pragma unroll
                for (int m = 0; m < 4; ++m)
#pragma unroll
                    for (int n = 0; n < 2; ++n) acc[a][b][m][n] = (f32x4){0.f, 0.f, 0.f, 0.f};
        const char* cA = S.pa(cur); const char* cB = S.pb(cur);
        u32x4 rr[2][2];
        __syncthreads();
        SG_LOADA(0); SG_STOREA(0); SG_LOADB(0); SG_STOREB(0);
        __syncthreads();
#pragma unroll 1
        for (int t = 0; t < nt; t += 2) {
            SG_KTILE(0, t + 1, true);
            const bool more = (t + 2 < nt);
            SG_KTILE(1, t + 2, more);
        }
        E(acc, cur, wr, wc, fr, fq);
    }
#undef SG_SA
#undef SG_SB
#undef SG_LDB
#undef SG_AFRAG
#undef SG_AHALF
#undef SG_LOADA
#undef SG_LOADB
#undef SG_STOREA
#undef SG_STOREB
#undef SG_KTILE
}
}

constexpr int BATCH = 4, SEQ = 4096, D = 1024, M = BATCH * SEQ;
constexpr int CW = 512, CK = 31, SW = 512, NG = 32, SP = 64, FH = 2816, INC = 3584, NMOD6 = 6 * D;
constexpr int LC = 16, NCH = M / LC, CPB = SEQ / LC, KA2 = 384;
constexpr float EPS = 1e-6f;
constexpr int NWAVES = 8, NTHR = 512;
constexpr int NPHASE = 8;

constexpr size_t MiB = 1u << 20;
constexpr size_t WS_CTL = 0, CTL_ZERO_BYTES = 1 * MiB;
constexpr size_t WS_BAR = 512 * 1024, WS_PCNT = 512 * 1024 + 16384, WS_GCNT = 512 * 1024 + 32768, BAR_BYTES = 32768 + 256;
constexpr size_t WS_MOD = 0, WS_RSS1 = 30 * MiB, WS_RSS2 = 31 * MiB;
constexpr size_t WS_WIN = 1 * MiB, WS_WCP = 8 * MiB, WS_WGLU = 9 * MiB, WS_WOUT = 11 * MiB, WS_WFI = 13 * MiB, WS_WFO = 24 * MiB;
constexpr size_t WS_SHW = 29 * MiB + 512 * 1024;
constexpr size_t WS_W1 = 30 * MiB, WS_B2 = 34 * MiB;
constexpr size_t WS_H1 = 40 * MiB;
constexpr size_t WS_UCONV = 72 * MiB, WS_A2S = 88 * MiB, WS_SGC = 112 * MiB, WS_SGS = 144 * MiB, WS_ACONV = 176 * MiB, WS_ASSM = 192 * MiB, WS_S = 208 * MiB, WS_MERGED = 224 * MiB;
constexpr size_t WS_X1B = 72 * MiB;
constexpr size_t WS_HID = 136 * MiB;
constexpr size_t WS_END = 256 * MiB;
static_assert(WS_HID + (size_t)M * FH * 2 <= WS_MERGED && WS_WFO + (size_t)D * FH * 2 <= WS_SHW && WS_B2 + (size_t)NG * 256 * KA2 * 2 <= WS_H1, "ws map");

constexpr int RING_BYTES = 131072, LDS_BYTES = 147456;

#define GAS __attribute__((address_space(1)))
#define LAS __attribute__((address_space(3)))
typedef unsigned short bf16;
typedef unsigned v4u __attribute__((ext_vector_type(4)));
typedef unsigned v2u __attribute__((ext_vector_type(2)));
typedef float f32x4 __attribute__((ext_vector_type(4)));
typedef float f32x2 __attribute__((ext_vector_type(2)));
using pg8::cvt_pk_bf16;
__device__ __forceinline__ float bf_lo(unsigned w) { return __uint_as_float(w << 16); }
__device__ __forceinline__ float bf_hi(unsigned w) { return __uint_as_float(w & 0xffff0000u); }
__device__ __forceinline__ float sigm(float x) { return __builtin_amdgcn_rcpf(1.0f + __expf(-x)); }
__device__ __forceinline__ float silu_f(float x) { return x * sigm(x); }
__device__ __forceinline__ float gelu_tanh(float x) { return x * sigm(1.5957691216057308f * (x + 0.044715f * x * x * x)); }
__device__ __forceinline__ float wave_sum(float v) {
#pragma unroll
    for (int o = 1; o < 64; o <<= 1) v += __shfl_xor(v, o);
    return v;
}
__device__ __forceinline__ v4u pack8(const f32x4 a, const f32x4 b) { v4u w; w.x = cvt_pk_bf16(a[0], a[1]); w.y = cvt_pk_bf16(a[2], a[3]); w.z = cvt_pk_bf16(b[0], b[1]); w.w = cvt_pk_bf16(b[2], b[3]); return w; }
__device__ __forceinline__ void unpack8(const v4u w, f32x4& a, f32x4& b) { a = (f32x4){bf_lo(w.x), bf_hi(w.x), bf_lo(w.y), bf_hi(w.y)}; b = (f32x4){bf_lo(w.z), bf_hi(w.z), bf_lo(w.w), bf_hi(w.w)}; }

struct BatchOrder {
    int nM, nwg, G, c; const char* A; const char* B; size_t zsA, tsA, zsB;
    __device__ __forceinline__ bool next(int i, pg8::Unit& u) const { const int L = i * G + c; if (L >= nwg) return false; u.z = L / nM; u.pm = L % nM; u.pn = 0; return true; }
    __device__ __forceinline__ const char* pa(const pg8::Unit& u) const { return A + (size_t)u.z * zsA + (size_t)u.pm * tsA; }
    __device__ __forceinline__ const char* pb(const pg8::Unit& u) const { return B + (size_t)u.z * zsB; }
    __device__ __forceinline__ void a_ready(const pg8::Unit&) const {}
    __device__ __forceinline__ void done(const pg8::Unit&) const {}
};

#define EPI_HEAD static constexpr bool PERM = true, AFTER_DRAIN = false, HALF_N = false
typedef f32x4 AccT[2][2][4][2];

struct EpiIn {
    EPI_HEAD; bf16* uconv; bf16* a2s; bf16* sgc; bf16* sgs;
    __device__ __forceinline__ void operator()(const AccT& acc, const pg8::Unit& u, int wr, int wc, int fr, int fq) const {
        const int row0 = u.pm * 256 + wr * 64 + fr;
        if (u.pn < 4) {
            const int col = u.pn * 128 + wc * 32 + 8 * fq;
#pragma unroll
            for (int ai = 0; ai < 2; ++ai)
#pragma unroll
                for (int m = 0; m < 4; ++m) { const int row = row0 + ai * 128 + m * 16; f32x4 o0, o1;
#pragma unroll
                    for (int e = 0; e < 4; ++e) { o0[e] = acc[ai][0][m][0][e] * sigm(acc[ai][1][m][0][e]); o1[e] = acc[ai][0][m][1][e] * sigm(acc[ai][1][m][1][e]); }
                    *(v4u*)(uconv + (size_t)row * CW + col) = pack8(o0, o1); }
        } else if (u.pn < 6) {
#pragma unroll
            for (int bj = 0; bj < 2; ++bj) { const int cc = (u.pn - 4) * 256 + bj * 128 + wc * 32 + 8 * fq, g = cc >> 4, h0 = cc & 15;
#pragma unroll
                for (int ai = 0; ai < 2; ++ai)
#pragma unroll
                    for (int m = 0; m < 4; ++m) { const int row = row0 + ai * 128 + m * 16;
                        *(v4u*)(a2s + ((size_t)(g * NCH + (row >> 4)) * KA2 + (row & 15) * 16 + h0)) = pack8(acc[ai][bj][m][0], acc[ai][bj][m][1]); } }
        } else {
#pragma unroll
            for (int bj = 0; bj < 2; ++bj) { const int gc = (u.pn - 6) * 256 + bj * 128 + wc * 32 + 8 * fq; bf16* dst = gc < D ? sgc + gc : sgs + (gc - D);
#pragma unroll
                for (int ai = 0; ai < 2; ++ai)
#pragma unroll
                    for (int m = 0; m < 4; ++m) { const int row = row0 + ai * 128 + m * 16; f32x4 o0, o1;
#pragma unroll
                        for (int e = 0; e < 4; ++e) { o0[e] = sigm(acc[ai][bj][m][0][e]); o1[e] = sigm(acc[ai][bj][m][1][e]); }
                        *(v4u*)(dst + (size_t)row * D) = pack8(o0, o1); } }
        }
    }
};
struct EpiState {
    EPI_HEAD; float* S;
    __device__ __forceinline__ void operator()(const AccT& acc, const pg8::Unit& u, int wr, int wc, int fr, int fq) const {
        const int col = wc * 32 + 8 * fq;
#pragma unroll
        for (int ai = 0; ai < 2; ++ai)
#pragma unroll
            for (int m = 0; m < 4; ++m) { const int rr = u.pm * 256 + ai * 128 + wr * 64 + m * 16 + fr; float* p = S + ((size_t)(u.z * NCH + rr)) * 128 + col;
                *(f32x4*)p = acc[ai][0][m][0]; *(f32x4*)(p + 4) = acc[ai][0][m][1]; }
    }
};
struct EpiStateLds {
    static constexpr bool PERM = true, AFTER_DRAIN = true, HALF_N = true;
    __device__ __forceinline__ void fused(const AccT& acc, const pg8::Unit& u, int wr, int wc, int fr, int fq, LAS unsigned char* lds, int wid, int lane) const {
        const int col = wc * 32 + 8 * fq;
#pragma unroll
        for (int ai = 0; ai < 2; ++ai)
#pragma unroll
            for (int m = 0; m < 4; ++m) { LAS float* p = (LAS float*)lds + (ai * 128 + wr * 64 + m * 16 + fr) * 128 + col;
                *(LAS f32x4*)p = acc[ai][0][m][0]; *(LAS f32x4*)(p + 4) = acc[ai][0][m][1]; }
    }
};
struct EpiSsmOut {
    EPI_HEAD; const bf16* a2s; const float* dvec; bf16* assm;
    __device__ __forceinline__ void operator()(const AccT& acc, const pg8::Unit& u, int wr, int wc, int fr, int fq) const {
        const int g = u.z; asm volatile("" : "+v"(fq), "+v"(fr));
#pragma unroll
        for (int bj = 0; bj < 2; ++bj) { const int c = bj * 128 + wc * 32 + 8 * fq, t = c >> 4, h0 = c & 15;
            const f32x4 d0 = *(const f32x4*)(dvec + g * 16 + h0), d1 = *(const f32x4*)(dvec + g * 16 + h0 + 4);
            v4u uu[2][4];
#pragma unroll
            for (int ai = 0; ai < 2; ++ai)
#pragma unroll
                for (int m = 0; m < 4; ++m) uu[ai][m] = *(const v4u*)(a2s + ((size_t)(g * NCH + u.pm * 256 + ai * 128 + wr * 64 + m * 16 + fr) * KA2 + c));
#pragma unroll
            for (int ai = 0; ai < 2; ++ai)
#pragma unroll
                for (int m = 0; m < 4; ++m) { const int rr = u.pm * 256 + ai * 128 + wr * 64 + m * 16 + fr;
                    f32x4 u0, u1; unpack8(uu[ai][m], u0, u1);
                    f32x4 y0 = acc[ai][bj][m][0] + d0 * u0, y1 = acc[ai][bj][m][1] + d1 * u1;
#pragma unroll
                    for (int e = 0; e < 4; ++e) { y0[e] = gelu_tanh(y0[e]); y1[e] = gelu_tanh(y1[e]); }
                    *(v4u*)(assm + ((size_t)(rr * LC + t) * SW + g * 16 + h0)) = pack8(y0, y1); }
            asm volatile("" ::: "memory"); }
    }
};
struct EpiConvProj {
    EPI_HEAD; const bf16* sgc; bf16* mg;
    __device__ __forceinline__ void operator()(const AccT& acc, const pg8::Unit& u, int wr, int wc, int fr, int fq) const {
#pragma unroll
        for (int bj = 0; bj < 2; ++bj) { const int col = u.pn * 256 + bj * 128 + wc * 32 + 8 * fq;
            v4u gg[2][4];
#pragma unroll
            for (int ai = 0; ai < 2; ++ai)
#pragma unroll
                for (int m = 0; m < 4; ++m) gg[ai][m] = *(const v4u*)(sgc + (size_t)(u.pm * 256 + ai * 128 + wr * 64 + m * 16 + fr) * D + col);
#pragma unroll
            for (int ai = 0; ai < 2; ++ai)
#pragma unroll
                for (int m = 0; m < 4; ++m) { const size_t off = (size_t)(u.pm * 256 + ai * 128 + wr * 64 + m * 16 + fr) * D + col;
                    f32x4 g0, g1; unpack8(gg[ai][m], g0, g1);
                    *(v4u*)(mg + off) = pack8(g0 * acc[ai][bj][m][0], g1 * acc[ai][bj][m][1]); }
            asm volatile("" ::: "memory"); }
    }
};
struct EpiSsmGlu {
    EPI_HEAD; const bf16* sgs; bf16* mg;
    __device__ __forceinline__ void operator()(const AccT& acc, const pg8::Unit& u, int wr, int wc, int fr, int fq) const {
        const int col = u.pn * 128 + wc * 32 + 8 * fq;
#pragma unroll
        for (int ai = 0; ai < 2; ++ai) {
            v4u gg[4], pp[4];
#pragma unroll
            for (int m = 0; m < 4; ++m) { const size_t off = (size_t)(u.pm * 256 + ai * 128 + wr * 64 + m * 16 + fr) * D + col; gg[m] = *(const v4u*)(sgs + off); pp[m] = *(const v4u*)(mg + off); }
#pragma unroll
            for (int m = 0; m < 4; ++m) { const size_t off = (size_t)(u.pm * 256 + ai * 128 + wr * 64 + m * 16 + fr) * D + col;
                f32x4 g0, g1, p0, p1; unpack8(gg[m], g0, g1); unpack8(pp[m], p0, p1);
#pragma unroll
                for (int e = 0; e < 4; ++e) { p0[e] += g0[e] * acc[ai][0][m][0][e] * sigm(acc[ai][1][m][0][e]); p1[e] += g1[e] * acc[ai][0][m][1][e] * sigm(acc[ai][1][m][1][e]); }
                *(v4u*)(mg + off) = pack8(p0, p1); }
            asm volatile("" ::: "memory"); }
    }
};
struct EpiOut {
    EPI_HEAD; const float* x; const float* mod; const float* n2g; bf16* x1; bf16* a2; float* rss;
    __device__ __forceinline__ void operator()(const AccT& acc, const pg8::Unit& u, int wr, int wc, int fr, int fq) const {
        const float* mb = mod + (u.pm >> 4) * NMOD6;
        float ss[2][4];
#pragma unroll
        for (int ai = 0; ai < 2; ++ai)
#pragma unroll
            for (int m = 0; m < 4; ++m) ss[ai][m] = 0.f;
#pragma unroll
        for (int bj = 0; bj < 2; ++bj) { const int col = u.pn * 256 + bj * 128 + wc * 32 + 8 * fq;
            const f32x4 gv0 = *(const f32x4*)(mb + 2 * D + col), gv1 = *(const f32x4*)(mb + 2 * D + col + 4);
            const f32x4 cs0 = *(const f32x4*)(n2g + col) * (*(const f32x4*)(mb + 4 * D + col) + 1.0f), cs1 = *(const f32x4*)(n2g + col + 4) * (*(const f32x4*)(mb + 4 * D + col + 4) + 1.0f);
#pragma unroll
            for (int ai = 0; ai < 2; ++ai) {
                f32x4 xx[4][2];
#pragma unroll
                for (int m = 0; m < 4; ++m) { const size_t off = (size_t)(u.pm * 256 + ai * 128 + wr * 64 + m * 16 + fr) * D + col;
                    xx[m][0] = __builtin_nontemporal_load((const f32x4*)(x + off)); xx[m][1] = __builtin_nontemporal_load((const f32x4*)(x + off + 4)); }
#pragma unroll
                for (int m = 0; m < 4; ++m) { const size_t off = (size_t)(u.pm * 256 + ai * 128 + wr * 64 + m * 16 + fr) * D + col;
                    const f32x4 v0 = xx[m][0] + gv0 * acc[ai][bj][m][0], v1 = xx[m][1] + gv1 * acc[ai][bj][m][1];
                    *(v4u*)(a2 + off) = pack8(v0 * cs0, v1 * cs1);
                    ss[ai][m] += (v0[0] * v0[0] + v0[1] * v0[1]) + (v0[2] * v0[2] + v0[3] * v0[3]) + (v1[0] * v1[0] + v1[1] * v1[1]) + (v1[2] * v1[2] + v1[3] * v1[3]); }
                asm volatile("" ::: "memory"); } }
#pragma unroll
        for (int ai = 0; ai < 2; ++ai)
#pragma unroll
            for (int m = 0; m < 4; ++m) { float t = ss[ai][m]; t += __shfl_xor(t, 16); t += __shfl_xor(t, 32);
                if (fq == 0) rss[(u.pm * 256 + ai * 128 + wr * 64 + m * 16 + fr) * 16 + u.pn * 4 + wc] = t; }
    }
};
struct EpiFfnIn {
    EPI_HEAD; const float* rss; const float* shw; bf16* hid;
    __device__ __forceinline__ void operator()(const AccT& acc, const pg8::Unit& u, int wr, int wc, int fr, int fq) const {
        const float* sb = shw + (u.pm >> 4) * (2 * FH) + u.pn * 256 + wc * 32 + 8 * fq;
        const f32x4 sg0 = *(const f32x4*)sb, sg1 = *(const f32x4*)(sb + 4), su0 = *(const f32x4*)(sb + 128), su1 = *(const f32x4*)(sb + 132);
        f32x4 qq[2][4];
#pragma unroll
        for (int ai = 0; ai < 2; ++ai)
#pragma unroll
            for (int m = 0; m < 4; ++m) qq[ai][m] = *(const f32x4*)(rss + (u.pm * 256 + ai * 128 + wr * 64 + m * 16 + fr) * 16 + 4 * fq);
#pragma unroll
        for (int ai = 0; ai < 2; ++ai)
#pragma unroll
            for (int m = 0; m < 4; ++m) { const int row = u.pm * 256 + ai * 128 + wr * 64 + m * 16 + fr;
                float t = (qq[ai][m][0] + qq[ai][m][1]) + (qq[ai][m][2] + qq[ai][m][3]); t += __shfl_xor(t, 16); t += __shfl_xor(t, 32);
                const float inv = rsqrtf(t * (1.0f / D) + EPS);
                const f32x4 g0 = acc[ai][0][m][0] * inv + sg0, g1 = acc[ai][0][m][1] * inv + sg1, u0 = acc[ai][1][m][0] * inv + su0, u1 = acc[ai][1][m][1] * inv + su1; f32x4 o0, o1;
#pragma unroll
                for (int e = 0; e < 4; ++e) { o0[e] = silu_f(g0[e]) * u0[e]; o1[e] = silu_f(g1[e]) * u1[e]; }
                *(v4u*)(hid + (size_t)row * FH + u.pn * 128 + wc * 32 + 8 * fq) = pack8(o0, o1); }
    }
};
struct EpiFfnOut {
    EPI_HEAD; const float* mod; const float* fg; const float* n2g; const bf16* x1; float* xo; float* rss; unsigned* cnt;
    __device__ __forceinline__ void operator()(AccT& acc, const pg8::Unit& u, int wr, int wc, int fr, int fq) const {
        const float* mb = mod + (u.pm >> 4) * NMOD6;
        {
            f32x4 gv[2][2], rc[2][2];
#pragma unroll
            for (int bj = 0; bj < 2; ++bj)
#pragma unroll
                for (int n = 0; n < 2; ++n) { const int col = u.pn * 256 + bj * 128 + wc * 32 + 8 * fq + 4 * n; gv[bj][n] = *(const f32x4*)(mb + 5 * D + col);
                    const f32x4 cs = *(const f32x4*)(n2g + col) * (*(const f32x4*)(mb + 4 * D + col) + 1.0f); rc[bj][n] = (f32x4){1.0f / cs[0], 1.0f / cs[1], 1.0f / cs[2], 1.0f / cs[3]}; }
#pragma unroll
            for (int ai = 0; ai < 2; ++ai)
#pragma unroll
                for (int m = 0; m < 4; ++m) { const int row = u.pm * 256 + ai * 128 + wr * 64 + m * 16 + fr; float ss = 0.f;
#pragma unroll
                    for (int bj = 0; bj < 2; ++bj) { const size_t off = (size_t)row * D + u.pn * 256 + bj * 128 + wc * 32 + 8 * fq;
                        f32x4 r0, r1; unpack8(*(const v4u*)(x1 + off), r0, r1);
                        const f32x4 v0 = r0 * rc[bj][0] + gv[bj][0] * acc[ai][bj][m][0], v1 = r1 * rc[bj][1] + gv[bj][1] * acc[ai][bj][m][1];
                        acc[ai][bj][m][0] = v0; acc[ai][bj][m][1] = v1;
                        ss += (v0[0] * v0[0] + v0[1] * v0[1]) + (v0[2] * v0[2] + v0[3] * v0[3]) + (v1[0] * v1[0] + v1[1] * v1[1]) + (v1[2] * v1[2] + v1[3] * v1[3]); }
                    ss += __shfl_xor(ss, 16); ss += __shfl_xor(ss, 32);
                    if (fq == 0) __hip_atomic_store(rss + row * 16 + u.pn * 4 + wc, ss, __ATOMIC_RELAXED, __HIP_MEMORY_SCOPE_AGENT); }
        }
        asm volatile("s_waitcnt vmcnt(0)" ::: "memory");
        unsigned* cw = cnt + 64 * u.pm;
        if (fr == 0 && fq == 0) __hip_atomic_fetch_add(cw, 1u, __ATOMIC_RELAXED, __HIP_MEMORY_SCOPE_AGENT);
        { unsigned sp = 0; while ((unsigned)__builtin_amdgcn_readfirstlane(__hip_atomic_load(cw, __ATOMIC_RELAXED, __HIP_MEMORY_SCOPE_AGENT)) < 32u) { __builtin_amdgcn_s_sleep(2); if (++sp > (1u << 22)) break; } }
        __builtin_amdgcn_fence(__ATOMIC_ACQUIRE, "agent");
        asm volatile("s_waitcnt vmcnt(0)" ::: "memory");
        f32x4 fv[2][2];
#pragma unroll
        for (int bj = 0; bj < 2; ++bj)
#pragma unroll
            for (int n = 0; n < 2; ++n) fv[bj][n] = *(const f32x4*)(fg + u.pn * 256 + bj * 128 + wc * 32 + 8 * fq + 4 * n);
#pragma unroll
        for (int ai = 0; ai < 2; ++ai)
#pragma unroll
            for (int m = 0; m < 4; ++m) { const int row = u.pm * 256 + ai * 128 + wr * 64 + m * 16 + fr;
                const unsigned long long* pp = (const unsigned long long*)(rss + row * 16 + 4 * fq);
                const unsigned long long w0 = __hip_atomic_load(pp, __ATOMIC_RELAXED, __HIP_MEMORY_SCOPE_AGENT), w1 = __hip_atomic_load(pp + 1, __ATOMIC_RELAXED, __HIP_MEMORY_SCOPE_AGENT);
                float t = (__uint_as_float((unsigned)w0) + __uint_as_float((unsigned)(w0 >> 32))) + (__uint_as_float((unsigned)w1) + __uint_as_float((unsigned)(w1 >> 32)));
                t += __shfl_xor(t, 16); t += __shfl_xor(t, 32);
                const float inv = rsqrtf(t * (1.0f / D) + EPS);
#pragma unroll
                for (int bj = 0; bj < 2; ++bj) { const size_t off = (size_t)row * D + u.pn * 256 + bj * 128 + wc * 32 + 8 * fq;
                    __builtin_nontemporal_store(acc[ai][bj][m][0] * inv * fv[bj][0], (f32x4*)(xo + off)); __builtin_nontemporal_store(acc[ai][bj][m][1] * inv * fv[bj][1], (f32x4*)(xo + off + 4)); } }
    }
};

struct TripleOrder {
    pg8::StaticOrder base; const char* A1; const char* B1; size_t tsA, tsB;
    __device__ __forceinline__ bool next(int i, pg8::Unit& u) const { pg8::Unit t; if (!base.next(i / 3, t)) return false; const int sub = i % 3; u.pm = t.pm;
        if (sub == 0) { u.pn = t.pn; u.z = 0; } else { u.pn = 2 * t.pn + (sub - 1); u.z = 1; } return true; }
    __device__ __forceinline__ const char* pa(const pg8::Unit& u) const { return u.z ? A1 + (size_t)u.pm * tsA : base.pa(u); }
    __device__ __forceinline__ const char* pb(const pg8::Unit& u) const { return u.z ? B1 + (size_t)u.pn * tsB : base.pb(u); }
    __device__ __forceinline__ void a_ready(const pg8::Unit&) const {}
    __device__ __forceinline__ void done(const pg8::Unit&) const {}
};
struct EpiMix {
    EPI_HEAD; const bf16* sgc; const bf16* sgs; bf16* mg;
    __device__ __forceinline__ void operator()(const AccT& acc, const pg8::Unit& u, int wr, int wc, int fr, int fq) const {
        if (u.z == 0) { const EpiConvProj e{sgc, mg}; e(acc, u, wr, wc, fr, fq); } else { const EpiSsmGlu e{sgs, mg}; e(acc, u, wr, wc, fr, fq); }
    }
};

__device__ __forceinline__ int ileave(int n0, int half) { return n0 < half ? 256 * (n0 >> 7) + (n0 & 127) : 256 * ((n0 - half) >> 7) + 128 + ((n0 - half) & 127); }
__device__ __forceinline__ void tr_fetch(const float* W, int N, int item, int lane, float (&tv)[32]) {
    const int nblk = N / 32, kb = item / nblk, nb = item % nblk, k0 = 64 * kb, n0 = 32 * nb;
#pragma unroll
    for (int i = 0; i < 32; ++i) tv[i] = __builtin_nontemporal_load(W + (size_t)(k0 + 2 * i + (lane >> 5)) * N + n0 + (lane & 31));
}
__device__ __forceinline__ void tr_emit(const float (&tv)[32], int K, int N, bf16* WT, int mode, LAS float* scr, int item, int lane) {
    const int nblk = N / 32, kb = item / nblk, nb = item % nblk, k0 = 64 * kb, n0 = 32 * nb;
    int r0 = n0;
    if (mode == 1) r0 = n0 < 1024 ? ileave(n0, 512) : n0;
    else if (mode == 2) r0 = ileave(n0, 1024);
    else if (mode == 3) r0 = ileave(n0, FH);
#pragma unroll
    for (int i = 0; i < 32; ++i) scr[(2 * i + (lane >> 5)) * 33 + (lane & 31)] = tv[i];
    asm volatile("s_waitcnt lgkmcnt(0)" ::: "memory");
    const int c = lane & 7;
#pragma unroll
    for (int j = 0; j < 4; ++j) { const int n = (lane >> 3) + 8 * j; const LAS float* s = scr + (8 * c) * 33 + n;
        v4u o; o.x = cvt_pk_bf16(s[0 * 33], s[1 * 33]); o.y = cvt_pk_bf16(s[2 * 33], s[3 * 33]); o.z = cvt_pk_bf16(s[4 * 33], s[5 * 33]); o.w = cvt_pk_bf16(s[6 * 33], s[7 * 33]);
        *(v4u*)(WT + (size_t)(r0 + n) * K + k0 + 8 * c) = o; }
    asm volatile("s_waitcnt lgkmcnt(0)" ::: "memory");
}
__device__ __forceinline__ void transpose_item(const float* W, int K, int N, bf16* WT, int mode, LAS float* scr, int item, int lane) {
    const int nblk = N / 32, kb = item / nblk, nb = item % nblk, k0 = 64 * kb, n0 = 32 * nb;
    int r0 = n0;
    if (mode == 1) r0 = n0 < 1024 ? ileave(n0, 512) : n0;
    else if (mode == 2) r0 = ileave(n0, 1024);
    else if (mode == 3) r0 = ileave(n0, FH);
    float tv[32];
#pragma unroll
    for (int i = 0; i < 32; ++i) tv[i] = __builtin_nontemporal_load(W + (size_t)(k0 + 2 * i + (lane >> 5)) * N + n0 + (lane & 31));
#pragma unroll
    for (int i = 0; i < 32; ++i) scr[(2 * i + (lane >> 5)) * 33 + (lane & 31)] = tv[i];
    asm volatile("s_waitcnt lgkmcnt(0)" ::: "memory");
    const int c = lane & 7;
#pragma unroll
    for (int j = 0; j < 4; ++j) { const int n = (lane >> 3) + 8 * j; const LAS float* s = scr + (8 * c) * 33 + n;
        v4u o; o.x = cvt_pk_bf16(s[0 * 33], s[1 * 33]); o.y = cvt_pk_bf16(s[2 * 33], s[3 * 33]); o.z = cvt_pk_bf16(s[4 * 33], s[5 * 33]); o.w = cvt_pk_bf16(s[6 * 33], s[7 * 33]);
        *(v4u*)(WT + (size_t)(r0 + n) * K + k0 + 8 * c) = o; }
    asm volatile("s_waitcnt lgkmcnt(0)" ::: "memory");
}
__device__ __forceinline__ void sincos_d(double x, double& s, double& c) {
    const double k = rint(x * 0.63661977236758134308);
    double r = fma(-k, 1.57079632679489655800e+00, x); r = fma(-k, 6.12323399573676603587e-17, r);
    const int q = ((int)k) & 3; const double r2 = r * r;
    double sp = -1.0 / 1307674368000.0; sp = fma(sp, r2, 1.0 / 6227020800.0); sp = fma(sp, r2, -1.0 / 39916800.0); sp = fma(sp, r2, 1.0 / 362880.0); sp = fma(sp, r2, -1.0 / 5040.0); sp = fma(sp, r2, 1.0 / 120.0); sp = fma(sp, r2, -1.0 / 6.0); sp = fma(sp * r2, r, r);
    double cp = 1.0 / 20922789888000.0; cp = fma(cp, r2, -1.0 / 87178291200.0); cp = fma(cp, r2, 1.0 / 479001600.0); cp = fma(cp, r2, -1.0 / 3628800.0); cp = fma(cp, r2, 1.0 / 40320.0); cp = fma(cp, r2, -1.0 / 720.0); cp = fma(cp, r2, 1.0 / 24.0); cp = fma(cp, r2, -0.5); cp = fma(cp, r2, 1.0);
    s = (q == 0) ? sp : (q == 1) ? cp : (q == 2) ? -sp : -cp;
    c = (q == 0) ? cp : (q == 1) ? -sp : (q == 2) ? -cp : sp;
}
__device__ __forceinline__ void ssm_abar(const float* a_re, const float* a_im, const float* log_dt, int g, int p, double& er, double& ei, double& ar, double& ai) {
    const double dt = (double)expf(log_dt[g]); ar = (double)a_re[g * SP + p]; ai = (double)a_im[g * SP + p];
    const double x = dt * ar;
    double mag = 1.0 / 362880.0; mag = fma(mag, x, 1.0 / 40320.0); mag = fma(mag, x, 1.0 / 5040.0); mag = fma(mag, x, 1.0 / 720.0); mag = fma(mag, x, 1.0 / 120.0); mag = fma(mag, x, 1.0 / 24.0); mag = fma(mag, x, 1.0 / 6.0); mag = fma(mag, x, 0.5); mag = fma(mag, x, 1.0); mag = fma(mag, x, 1.0);
    double s, c; sincos_d(dt * ai, s, c); er = mag * c; ei = mag * s;
}

#define XB_TMO      128
#define XB_XCNT(j)  (256  + 64 * (j))
#define XB_XSUB(j)  (1280 + 64 * (j))
#define XB_XGEN(j)  (2304 + 64 * (j))
#define XB_TOP      3328
#define XB_TOPGEN   3392
#define XCD_BAR_WORDS 3456
#define XB_SPIN_CAP (1u << 18)

__device__ __forceinline__ unsigned xb_ld(unsigned* p)              { return __hip_atomic_load(p, __ATOMIC_RELAXED, __HIP_MEMORY_SCOPE_AGENT); }
__device__ __forceinline__ unsigned xb_add(unsigned* p, unsigned v) { return __hip_atomic_fetch_add(p, v, __ATOMIC_RELAXED, __HIP_MEMORY_SCOPE_AGENT); }
__device__ __forceinline__ unsigned xb_xcc_id() { return (unsigned)__builtin_amdgcn_s_getreg((3 << 11) | 20) & 0xFu; }
#define XB_SPIN(cond, bar) do { unsigned _sp = 0; while (cond) { __builtin_amdgcn_s_sleep(1); \
    if ((++_sp & 255u) == 0u) { if (xb_ld(&(bar)[XB_TMO])) break; if (_sp > XB_SPIN_CAP) { atomicAdd(&(bar)[XB_TMO], 1u); break; } } } } while (0)

struct XcdBarrier {
    unsigned* bar; unsigned x;
    volatile LAS unsigned* st;
};

__device__ __forceinline__ XcdBarrier xcd_barrier_post(unsigned* bar, volatile LAS unsigned* st) {
    XcdBarrier b; b.bar = bar; b.x = xb_xcc_id(); b.st = st;
    if (threadIdx.x == 0) (void)xb_add(&bar[XB_XCNT(b.x)], 1u);
    return b;
}
__device__ __forceinline__ void xcd_barrier_complete(unsigned* bar, unsigned x, unsigned& nloc, unsigned& nx) {
    const unsigned G = gridDim.x * gridDim.y * gridDim.z;
    unsigned sum, cnt, mine, sp = 0u;
    for (;;) {
        sum = 0u; cnt = 0u; mine = 0u;
#pragma unroll
        for (unsigned j = 0; j < 16; ++j) { const unsigned c = xb_ld(&bar[XB_XCNT(j)]); sum += c; cnt += (c > 0u) ? 1u : 0u; mine = (j == x) ? c : mine; }
        if (sum == G) break;
        __builtin_amdgcn_s_sleep(1);
        if ((++sp & 255u) == 0u) { if (xb_ld(&bar[XB_TMO])) break; if (sp > XB_SPIN_CAP) { atomicAdd(&bar[XB_TMO], 1u); break; } }
    }
    nloc = mine > 0u ? mine : 1u; nx = cnt > 0u ? cnt : 1u;
}

__device__ __forceinline__ void xcd_barrier(const XcdBarrier& b) {
    asm volatile("s_waitcnt vmcnt(0)" ::: "memory");
    __syncthreads();
    if (threadIdx.x == 0) {
        unsigned* bar = b.bar;
        __builtin_amdgcn_s_waitcnt(0);
        unsigned nloc = b.st[0], nx = b.st[1];
        if (nloc == 0u) { xcd_barrier_complete(bar, b.x, nloc, nx); b.st[0] = nloc; b.st[1] = nx; }
        const unsigned old = xb_add(&bar[XB_XSUB(b.x)], 1u);
        const unsigned gen = old / nloc;
        if (old + 1u == (gen + 1u) * nloc) {
            __builtin_amdgcn_fence(__ATOMIC_RELEASE, "agent");
            asm volatile("s_waitcnt vmcnt(0)" ::: "memory");
            const unsigned og = xb_add(&bar[XB_TOP], 1u);
            const unsigned tg = og / nx;
            if (og + 1u == (tg + 1u) * nx) xb_add(&bar[XB_TOPGEN], 1u);
            else XB_SPIN(xb_ld(&bar[XB_TOPGEN]) == tg, bar);
            __builtin_amdgcn_fence(__ATOMIC_ACQUIRE, "agent");
            xb_add(&bar[XB_XGEN(b.x)], 1u);
            asm volatile("s_waitcnt vmcnt(0)" ::: "memory");
        } else {
            XB_SPIN(xb_ld(&bar[XB_TOPGEN]) == gen, bar);
            __builtin_amdgcn_fence(__ATOMIC_ACQUIRE, "agent");
            asm volatile("s_waitcnt vmcnt(0)" ::: "memory");
        }
    }
    __syncthreads();
}

struct Args { const float* in[25]; float* out; unsigned char* ws; int ph_lo, ph_hi; };
static_assert(sizeof(Args) == 25 * 8 + 8 + 8 + 8, "Args has no padding");

__global__ void __launch_bounds__(NTHR, 2) fwd_megakernel(Args args) {
    extern __shared__ __attribute__((aligned(16))) unsigned char lds_raw[];
    LAS unsigned char* lds = (LAS unsigned char*)lds_raw;
    const int tid = threadIdx.x, lane = tid & 63, wave = __builtin_amdgcn_readfirstlane(tid >> 6);
    const int G = gridDim.x, bid = blockIdx.x;
    const int gw = bid * NWAVES + wave, NGW = G * NWAVES;
    unsigned char* ws = args.ws;
    const float* x = args.in[0]; const float* cvec = args.in[1]; const float* w_ada = args.in[2]; const float* b_ada = args.in[3]; const float* n1g = args.in[4];
    const float* w_in = args.in[5]; const float* conv_w = args.in[6]; const float* conv_b = args.in[7]; const float* cln_g = args.in[8]; const float* cln_b = args.in[9];
    const float* conv_proj = args.in[10]; const float* a_re = args.in[11]; const float* a_im = args.in[12]; const float* b_re = args.in[13]; const float* b_im = args.in[14];
    const float* c_re = args.in[15]; const float* c_im = args.in[16]; const float* ssm_d = args.in[17]; const float* log_dt = args.in[18]; const float* ssm_glu = args.in[19];
    const float* w_out = args.in[20]; const float* n2g = args.in[21]; const float* w_ffn_in = args.in[22]; const float* w_ffn_out = args.in[23]; const float* final_g = args.in[24];
    float* out = args.out;
    float* MOD = (float*)(ws + WS_MOD); float* RSS1 = (float*)(ws + WS_RSS1); float* RSS2 = (float*)(ws + WS_RSS2); float* SHW = (float*)(ws + WS_SHW);
    bf16* WIN = (bf16*)(ws + WS_WIN); bf16* WCP = (bf16*)(ws + WS_WCP); bf16* WGLU = (bf16*)(ws + WS_WGLU); bf16* WOUT = (bf16*)(ws + WS_WOUT); bf16* WFI = (bf16*)(ws + WS_WFI); bf16* WFO = (bf16*)(ws + WS_WFO);
    bf16* W1T = (bf16*)(ws + WS_W1); bf16* B2T = (bf16*)(ws + WS_B2); bf16* H1 = (bf16*)(ws + WS_H1);
    bf16* UCONV = (bf16*)(ws + WS_UCONV); bf16* A2S = (bf16*)(ws + WS_A2S); bf16* SGC = (bf16*)(ws + WS_SGC); bf16* SGS = (bf16*)(ws + WS_SGS);
    bf16* ACONV = (bf16*)(ws + WS_ACONV); bf16* ASSM = (bf16*)(ws + WS_ASSM); float* SST = (float*)(ws + WS_S); bf16* MG = (bf16*)(ws + WS_MERGED); bf16* HID = (bf16*)(ws + WS_HID); bf16* X1B = (bf16*)(ws + WS_X1B);
    cg::grid_group grid = cg::this_grid();
    const int lo = args.ph_lo, hi = args.ph_hi;
    volatile LAS unsigned* bst = (volatile LAS unsigned*)(lds + RING_BYTES + 1024);
    if (tid < 2) bst[tid] = 0u;
    __syncthreads();
    XcdBarrier xbar = xcd_barrier_post((unsigned*)(ws + WS_BAR), bst);
    if (lo == 0x7fffffff) grid.sync();
#ifndef PHMASK
#define PHMASK 0xFF
#endif
#define IN(k) ((((PHMASK) >> (k)) & 1) && lo <= (k) && (k) < hi)
#define GRID_SYNC() do { xcd_barrier(xbar); } while (0)
#define SEAM(k) do { if (IN(k) && IN((k) + 1)) GRID_SYNC(); } while (0)
#define REPS(k) _Pragma("unroll 1") for (int rep_ = 0; rep_ < ((((DUP_MASK) >> (k)) & 1) ? 2 : 1); ++rep_)

    if (IN(0)) REPS(0) { if (rep_) GRID_SYNC();
        {
            LAS float* scr = (LAS float*)(lds + wave * 16384);
            constexpr int I_IN = (D / 64) * (INC / 32), I_CP = (CW / 64) * (D / 32), I_GLU = (SW / 64) * (2 * D / 32), I_OUT = (D / 64) * (D / 32), I_FI = (D / 64) * (2 * FH / 32), I_FO = (FH / 64) * (D / 32);
            constexpr int NITEMS = I_IN + I_FI;
            const int ngv = NMOD6 / 64;
            const int tw0 = (G >= 2 * ngv) ? (bid - ngv) * NWAVES + wave : gw, tnw = (G >= 2 * ngv) ? (G - ngv) * NWAVES : NGW;
            {
                float cur[32], nxt[32];
                int it = (tw0 >= 0 ? tw0 : NITEMS);
                if (it < NITEMS) { if (it < I_FI) tr_fetch(w_ffn_in, 2 * FH, it, lane, cur); else tr_fetch(w_in, INC, it - I_FI, lane, cur); }
                while (it < NITEMS) {
                    const int itn = it + tnw;
                    if (itn < NITEMS) { if (itn < I_FI) tr_fetch(w_ffn_in, 2 * FH, itn, lane, nxt); else tr_fetch(w_in, INC, itn - I_FI, lane, nxt); }
                    if (it < I_FI) tr_emit(cur, D, 2 * FH, WFI, 3, scr, it, lane); else tr_emit(cur, D, INC, WIN, 1, scr, it - I_FI, lane);
#pragma unroll
                    for (int i = 0; i < 32; ++i) cur[i] = nxt[i];
                    it = itn;
                }
            }
        }
        {
            __syncthreads();
            LAS float* red = (LAS float*)lds;
            LAS float* sc = (LAS float*)(lds + 8192);
            if (bid < NMOD6 / 64) { for (int e = tid; e < BATCH * D; e += NTHR) sc[e] = silu_f(cvec[e]); }
            __syncthreads();
            for (int it = bid; it < NMOD6 / 64; it += G) {
                const int col = it * 64 + lane; float a0 = 0.f, a1 = 0.f, a2 = 0.f, a3 = 0.f;
#pragma unroll 1
                for (int k0 = wave * 128; k0 < wave * 128 + 128; k0 += 32) { float wv[32];
#pragma unroll
                    for (int j = 0; j < 32; ++j) wv[j] = __builtin_nontemporal_load(w_ada + (size_t)(k0 + j) * NMOD6 + col);
#pragma unroll
                    for (int j = 0; j < 32; ++j) { a0 += wv[j] * sc[k0 + j]; a1 += wv[j] * sc[D + k0 + j]; a2 += wv[j] * sc[2 * D + k0 + j]; a3 += wv[j] * sc[3 * D + k0 + j]; } }
                red[(wave * 4 + 0) * 64 + lane] = a0; red[(wave * 4 + 1) * 64 + lane] = a1; red[(wave * 4 + 2) * 64 + lane] = a2; red[(wave * 4 + 3) * 64 + lane] = a3;
                __syncthreads();
                if (tid < 256) { const int b = tid >> 6, c = tid & 63; float t = b_ada[it * 64 + c];
#pragma unroll
                    for (int w = 0; w < 8; ++w) t += red[(w * 4 + b) * 64 + c];
                    __hip_atomic_store(MOD + b * NMOD6 + it * 64 + c, t, __ATOMIC_RELAXED, __HIP_MEMORY_SCOPE_AGENT); }
                asm volatile("s_waitcnt vmcnt(0)" ::: "memory");
                __syncthreads();
                if (tid == 0) __hip_atomic_fetch_add((unsigned*)(ws + WS_GCNT), 1u, __ATOMIC_RELAXED, __HIP_MEMORY_SCOPE_AGENT);
            }
        }
        {
            LAS f32x2* PW = (LAS f32x2*)(lds);
            LAS f32x2* QQ = (LAS f32x2*)(lds + 8704);
            LAS f32x2* BB = (LAS f32x2*)(lds + 9216);
            LAS f32x2* CC = (LAS f32x2*)(lds + 17408);
            LAS float* KT = (LAS float*)(lds + 25600);
            for (int it = bid; it < NG * 8; it += G) {
                const int g = it >> 3, rb = it & 7;
                __syncthreads();
                if (tid < 64) {
                    double er, ei, ar, ai; ssm_abar(a_re, a_im, log_dt, g, tid, er, ei, ar, ai);
                    const double nr = er - 1.0, ni = ei, den = ar * ar + ai * ai;
                    QQ[tid] = (f32x2){(float)((nr * ar + ni * ai) / den), (float)((ni * ar - nr * ai) / den)};
                    double pr = 1.0, pi = 0.0;
                    for (int j = 0; j <= 16; ++j) { PW[j * 64 + tid] = (f32x2){(float)pr, (float)pi}; const double t = pr * er - pi * ei; pi = pr * ei + pi * er; pr = t; }
                }
                for (int e = tid; e < 1024; e += NTHR) CC[e] = (f32x2){c_re[g * 1024 + e], c_im[g * 1024 + e]};
                __syncthreads();
                for (int e = tid; e < 1024; e += NTHR) { const f32x2 q = QQ[e >> 4]; const float br = b_re[g * 1024 + e], bi = b_im[g * 1024 + e]; BB[e] = (f32x2){q.x * br - q.y * bi, q.x * bi + q.y * br}; }
                __syncthreads();
                if (rb < 4) {
                    const int nl = 4 * rb + 4, pair = tid & 255, ho = pair >> 4, hi = pair & 15;
                    for (int j = tid >> 8; j < nl; j += 2) {
                        float s = 0.f;
                        for (int p = 0; p < 64; ++p) { const f32x2 c = CC[ho * 64 + p], w = PW[j * 64 + p], b = BB[p * 16 + hi];
                            const float cr = c.x * w.x - c.y * w.y, ci = c.x * w.y + c.y * w.x; s += cr * b.x - ci * b.y; }
                        KT[j * 256 + pair] = s;
                    }
                    __syncthreads();
                    for (int r = wave * 8; r < wave * 8 + 8; ++r) { const int n = 64 * rb + r, t = n >> 4, ho = n & 15;
#pragma unroll
                        for (int i = 0; i < 3; ++i) { const int kp = lane + 64 * i; float v[2];
#pragma unroll
                            for (int h = 0; h < 2; ++h) { const int k = 2 * kp + h;
                                if (k < 256) { const int s = k >> 4, hi = k & 15; v[h] = (s <= t) ? KT[(t - s) * 256 + ho * 16 + hi] : 0.f; }
                                else { const int p = (k - 256) & 63; const f32x2 c = CC[ho * 64 + p], w = PW[(t + 1) * 64 + p]; v[h] = (k < 320) ? (c.x * w.x - c.y * w.y) : -(c.x * w.y + c.y * w.x); } }
                            *(unsigned*)(B2T + ((size_t)(g * 256 + n) * KA2 + 2 * kp)) = cvt_pk_bf16(v[0], v[1]); } }
                } else {
                    for (int r = wave * 8; r < wave * 8 + 8; ++r) { const int n = 64 * (rb - 4) + r, p = n & 63;
#pragma unroll
                        for (int i = 0; i < 2; ++i) { const int kp = lane + 64 * i; float v[2];
#pragma unroll
                            for (int h = 0; h < 2; ++h) { const int k = 2 * kp + h, s = k >> 4, hi = k & 15; const f32x2 w = PW[(15 - s) * 64 + p], b = BB[p * 16 + hi];
                                v[h] = (n < 64) ? (w.x * b.x - w.y * b.y) : (n < 128) ? (w.x * b.y + w.y * b.x) : 0.f; }
                            *(unsigned*)(W1T + ((size_t)(g * 256 + n) * 256 + 2 * kp)) = cvt_pk_bf16(v[0], v[1]); } }
                }
            }
            __syncthreads();
        }
    }
    if (IN(0) && IN(1)) {
        if (tid == 0) { unsigned sp = 0; while (__hip_atomic_load((unsigned*)(ws + WS_GCNT), __ATOMIC_RELAXED, __HIP_MEMORY_SCOPE_AGENT) < (unsigned)(NMOD6 / 64)) { __builtin_amdgcn_s_sleep(2); if (++sp > (1u << 22)) break; }
            __builtin_amdgcn_fence(__ATOMIC_ACQUIRE, "agent"); asm volatile("s_waitcnt vmcnt(0)" ::: "memory"); }
        __syncthreads();
    }
    for (int xs_ = 0; xs_ < EXTRA_SYNCS; ++xs_) GRID_SYNC();

    if (IN(1)) REPS(1) { if (rep_) GRID_SYNC();
        for (int rb = gw * 8; rb < M; rb += NGW * 8) {
            const float* mb = MOD + (rb >> 12) * NMOD6;
            f32x4 v[8][4]; float inv[8];
#pragma unroll
            for (int q = 0; q < 8; ++q) { const f32x4* xr = (const f32x4*)(x + (size_t)(rb + q) * D) + lane;
#pragma unroll
                for (int j = 0; j < 4; ++j) v[q][j] = __builtin_nontemporal_load(xr + 64 * j); }
#pragma unroll
            for (int q = 0; q < 8; ++q) { float s = 0.f;
#pragma unroll
                for (int j = 0; j < 4; ++j) s += (v[q][j][0] * v[q][j][0] + v[q][j][1] * v[q][j][1]) + (v[q][j][2] * v[q][j][2] + v[q][j][3] * v[q][j][3]);
                inv[q] = rsqrtf(wave_sum(s) * (1.0f / D) + EPS); }
#pragma unroll
            for (int j = 0; j < 4; ++j) { const int col = lane * 4 + 256 * j;
                const f32x4 gsc = (*(const f32x4*)(n1g + col)) * (*(const f32x4*)(mb + D + col) + 1.0f), sh = *(const f32x4*)(mb + col);
#pragma unroll
                for (int q = 0; q < 8; ++q) { const f32x4 h = v[q][j] * inv[q] * gsc + sh;
                    v2u o; o.x = cvt_pk_bf16(h[0], h[1]); o.y = cvt_pk_bf16(h[2], h[3]); *(v2u*)(H1 + (size_t)(rb + q) * D + col) = o; } }
        }
    }
    SEAM(1);

    if (IN(2)) REPS(2) { if (rep_) GRID_SYNC();
        pg8::Gemm g{D, D, D}; pg8::StaticOrder S; S.init(M, INC, G, bid, H1, D, WIN, D);
        EpiIn E{UCONV, A2S, SGC, SGS};
        GEMM_CALL(EpiIn, pg8::StaticOrder)(lds, g, S, E);
        {
            constexpr int NU = (M / 256) * (INC / 256), I_CP = (CW / 64) * (D / 32), I_GLU = (SW / 64) * (2 * D / 32), I_OUT = (D / 64) * (D / 32);
            int first = NU % G, nhelp = G - first; if (first == 0) nhelp = G;
            if (bid >= first) {
                LAS float* scr = (LAS float*)(lds + wave * 16384);
                const int hw0 = (bid - first) * NWAVES + wave, hnw = nhelp * NWAVES;
                for (int it = hw0; it < I_GLU + I_OUT + I_CP; it += hnw) {
                    if (it < I_GLU) transpose_item(ssm_glu, SW, 2 * D, WGLU, 2, scr, it, lane);
                    else if (it < I_GLU + I_OUT) transpose_item(w_out, D, D, WOUT, 0, scr, it - I_GLU, lane);
                    else transpose_item(conv_proj, CW, D, WCP, 0, scr, it - I_GLU - I_OUT, lane);
                }
                for (int v = hw0; v < 2 * FH; v += hnw) {
                    const v4u w0 = *(const v4u*)(WFI + (size_t)v * D + lane * 8), w1 = *(const v4u*)(WFI + (size_t)v * D + 512 + lane * 8);
                    f32x4 a0, a1, b0, b1; unpack8(w0, a0, a1); unpack8(w1, b0, b1);
        #pragma unroll
                    for (int b = 0; b < BATCH; ++b) { const float* sh = MOD + b * NMOD6 + 3 * D;
                        const f32x4 s0 = *(const f32x4*)(sh + lane * 8), s1 = *(const f32x4*)(sh + lane * 8 + 4), s2 = *(const f32x4*)(sh + 512 + lane * 8), s3 = *(const f32x4*)(sh + 512 + lane * 8 + 4);
                        const f32x4 pr = a0 * s0 + a1 * s1 + b0 * s2 + b1 * s3; const float t = wave_sum((pr[0] + pr[1]) + (pr[2] + pr[3]));
                        if (lane == 0) SHW[b * (2 * FH) + v] = t; }
                }
            }
        }
    }
    SEAM(2);

    if (IN(3)) REPS(3) { if (rep_) GRID_SYNC();
        {
            const int cp = tid & 255, th = tid >> 8;
            LAS float* OUTT = (LAS float*)(lds + 65536);
            const bool bal = (G == 256);
            const int nmine = bal ? (bid < NG * 4 ? 0 : 4) : (M / 32 - bid + G - 1) / G;
            f32x2 w[CK];
#pragma unroll
            for (int j = 0; j < CK; ++j) w[j] = *(const f32x2*)(conv_w + j * CW + 2 * cp);
            const f32x2 bias = *(const f32x2*)(conv_b + 2 * cp);
#define CONV_ITEM(ii_) (bal ? (bid - NG * 4) * 4 + (ii_) : bid + (ii_) * G)
#define CONV_FETCH(dst, it_) do { const int t0_ = (it_) * 32, pos0_ = t0_ & (SEQ - 1); _Pragma("unroll") for (int k_ = 0; k_ < 8; ++k_) { const int e_ = tid + k_ * NTHR, r_ = e_ >> 6, ch_ = e_ & 63; v4u v_ = {0u, 0u, 0u, 0u}; \
                if (e_ < 62 * 64 && pos0_ - 30 + r_ >= 0) v_ = *(const v4u*)(UCONV + (size_t)(t0_ - 30 + r_) * CW + ch_ * 8); dst[k_] = v_; } } while (0)
            v4u pre[8];
            if (nmine > 0) CONV_FETCH(pre, CONV_ITEM(0));
            for (int ii = 0; ii < nmine; ++ii) {
                const int item = CONV_ITEM(ii);
                const int t0 = item * 32;
                __syncthreads();
#pragma unroll
                for (int k = 0; k < 8; ++k) { const int e = tid + k * NTHR; if (e < 62 * 64) *(LAS v4u*)(lds + (e >> 6) * 1024 + (e & 63) * 16) = pre[k]; }
                if (ii + 1 < nmine) CONV_FETCH(pre, CONV_ITEM(ii + 1));
                f32x2 acc[16];
#pragma unroll
                for (int q = 0; q < 16; ++q) acc[q] = bias;
                __syncthreads();
#pragma unroll
                for (int i = 0; i < 46; ++i) { const unsigned uv = *(const LAS unsigned*)(lds + (th * 16 + i) * 1024 + cp * 4); const f32x2 vv = {bf_lo(uv), bf_hi(uv)};
#pragma unroll
                    for (int q = 0; q < 16; ++q) { const int j = i - q; if (j >= 0 && j < CK) acc[q] += vv * w[j]; } }
#pragma unroll
                for (int q = 0; q < 16; ++q) *(LAS f32x2*)(OUTT + (th * 16 + q) * 512 + 2 * cp) = acc[q];
                __syncthreads();
#pragma unroll
                for (int q = 0; q < 4; ++q) { const int tt = wave * 4 + q; const LAS float* rowp = OUTT + tt * 512;
                    f32x4 a = *(const LAS f32x4*)(rowp + lane * 4), b = *(const LAS f32x4*)(rowp + 256 + lane * 4);
                    const float mu = wave_sum((a[0] + a[1]) + (a[2] + a[3]) + (b[0] + b[1]) + (b[2] + b[3])) * (1.0f / CW);
                    a -= mu; b -= mu;
                    const float var = wave_sum((a[0] * a[0] + a[1] * a[1]) + (a[2] * a[2] + a[3] * a[3]) + (b[0] * b[0] + b[1] * b[1]) + (b[2] * b[2] + b[3] * b[3])) * (1.0f / CW);
                    const float rstd = rsqrtf(var + EPS);
                    a = a * rstd * (*(const f32x4*)(cln_g + lane * 4)) + *(const f32x4*)(cln_b + lane * 4);
                    b = b * rstd * (*(const f32x4*)(cln_g + 256 + lane * 4)) + *(const f32x4*)(cln_b + 256 + lane * 4);
                    v2u o0, o1; o0.x = cvt_pk_bf16(silu_f(a[0]), silu_f(a[1])); o0.y = cvt_pk_bf16(silu_f(a[2]), silu_f(a[3])); o1.x = cvt_pk_bf16(silu_f(b[0]), silu_f(b[1])); o1.y = cvt_pk_bf16(silu_f(b[2]), silu_f(b[3]));
                    bf16* dst = ACONV + (size_t)(t0 + tt) * CW; *(v2u*)(dst + lane * 4) = o0; *(v2u*)(dst + 256 + lane * 4) = o1; }
            }
            __syncthreads();
        }
        if (bid < NG * 4) {
            const int L = bid, g = L >> 2, b = L & 3;
            {
                pg8::Gemm gg{256, KA2, 256}; BatchOrder S{4, NG * 4, 1 << 20, L, (const char*)A2S, (const char*)W1T, (size_t)NCH * KA2 * 2, (size_t)256 * KA2 * 2, (size_t)256 * 256 * 2};
                EpiStateLds E{};
                GEMM_CALL(EpiStateLds, BatchOrder)(lds, gg, S, E);
            }
            __syncthreads();
            {
                double er, ei, ar, ai; ssm_abar(a_re, a_im, log_dt, g, lane, er, ei, ar, ai);
#pragma unroll
                for (int j = 0; j < 4; ++j) { const double t = er * er - ei * ei; ei = 2.0 * er * ei; er = t; }
                const float alr = (float)er, ali = (float)ei;
#pragma unroll
                for (int j = 0; j < 5; ++j) { const double t = er * er - ei * ei; ei = 2.0 * er * ei; er = t; }
                const float a32r = (float)er, a32i = (float)ei;
                const LAS float* sl = (const LAS float*)lds + wave * 32 * 128; LAS f32x2* EE = (LAS f32x2*)(lds + RING_BYTES + 2048);
                float xr = 0.f, xi = 0.f;
#pragma unroll 8
                for (int c = 0; c < 32; ++c) { const float sr = sl[c * 128 + lane], si = sl[c * 128 + 64 + lane]; const float nr = alr * xr - ali * xi + sr, ni = alr * xi + ali * xr + si; xr = nr; xi = ni; }
                EE[wave * 64 + lane] = (f32x2){xr, xi};
                __syncthreads();
                xr = 0.f; xi = 0.f;
                for (int v = 0; v < wave; ++v) { const f32x2 e = EE[v * 64 + lane]; const float nr = a32r * xr - a32i * xi + e.x, ni = a32r * xi + a32i * xr + e.y; xr = nr; xi = ni; }
                bf16* dst = A2S + (size_t)(g * NCH + b * CPB + wave * 32) * KA2 + 256 + lane;
#pragma unroll 8
                for (int c = 0; c < 32; ++c) {
                    const unsigned pk = cvt_pk_bf16(xr, xi); dst[(size_t)c * KA2] = (bf16)(pk & 0xffffu); dst[(size_t)c * KA2 + 64] = (bf16)(pk >> 16);
                    const float sr = sl[c * 128 + lane], si = sl[c * 128 + 64 + lane];
                    const float nr = alr * xr - ali * xi + sr, ni = alr * xi + ali * xr + si; xr = nr; xi = ni;
                }
            }
            asm volatile("s_waitcnt vmcnt(0)" ::: "memory");
            __syncthreads(); __builtin_amdgcn_fence(__ATOMIC_ACQUIRE, "agent");
            {
                pg8::Gemm gg{KA2, KA2, KA2}; BatchOrder S{4, NG * 4, 1 << 20, L, (const char*)A2S, (const char*)B2T, (size_t)NCH * KA2 * 2, (size_t)256 * KA2 * 2, (size_t)256 * KA2 * 2};
                EpiSsmOut E{A2S, ssm_d, ASSM};
                GEMM_CALL(EpiSsmOut, BatchOrder)(lds, gg, S, E);
            }
        }
    }
    SEAM(3);

    if (IN(4)) REPS(4) { if (rep_) GRID_SYNC();
        pg8::Gemm g{SW, SW, SW}; TripleOrder S; S.base.init(M, D, G, bid, ACONV, CW, WCP, CW); S.A1 = (const char*)ASSM; S.B1 = (const char*)WGLU; S.tsA = (size_t)256 * SW * 2; S.tsB = (size_t)256 * SW * 2;
        EpiMix E{SGC, SGS, MG};
        GEMM_CALL(EpiMix, TripleOrder)(lds, g, S, E);
    }
    SEAM(4);

    if (IN(5)) REPS(5) { if (rep_) GRID_SYNC();
        pg8::Gemm g{D, D, D}; pg8::StaticOrder S; S.init(M, D, G, bid, MG, D, WOUT, D);
        EpiOut E{x, MOD, n2g, X1B, H1, RSS1};
        GEMM_CALL(EpiOut, pg8::StaticOrder)(lds, g, S, E);
    }
    SEAM(5);

    if (IN(6)) REPS(6) { if (rep_) GRID_SYNC();
        pg8::Gemm g{D, D, D}; pg8::StaticOrder S; S.init(M, 2 * FH, G, bid, H1, D, WFI, D);
        EpiFfnIn E{RSS1, SHW, HID};
        GEMM_CALL(EpiFfnIn, pg8::StaticOrder)(lds, g, S, E);
        {
            constexpr int NU = (M / 256) * (2 * FH / 256), I_FO = (FH / 64) * (D / 32);
            int first = NU % G, nhelp = G - first; if (first == 0) nhelp = G;
            if (bid >= first) {
                LAS float* scr = (LAS float*)(lds + wave * 16384);
                for (int it = (bid - first) * NWAVES + wave; it < I_FO; it += nhelp * NWAVES) transpose_item(w_ffn_out, FH, D, WFO, 0, scr, it, lane);
            }
        }
    }
    SEAM(6);

    if (IN(7)) REPS(7) { if (rep_) GRID_SYNC();
        pg8::Gemm g{FH, FH, FH}; pg8::StaticOrder S; S.init(M, D, G, bid, HID, FH, WFO, FH);
        EpiFfnOut E{MOD, final_g, n2g, H1, out, RSS2, (unsigned*)(ws + WS_PCNT)};
        GEMM_CALL(EpiFfnOut, pg8::StaticOrder)(lds, g, S, E);
    }

#undef IN
#undef SEAM
}

extern "C" void kernel_launch(void* const* d_in, const int* in_sizes, int n_in, void* d_out, int out_size, void* d_ws, size_t ws_size, hipStream_t stream) {
    static int grid = 0;
    if (grid == 0) {
        if (n_in != 25 || out_size != M * D || ws_size < WS_END) { fprintf(stderr, "kernel_launch: unexpected shapes (n_in %d out %d ws %zu)\n", n_in, out_size, ws_size); grid = -1; return; }
        int dev = 0, cus = 0, per_cu = 0;
        (void)hipGetDevice(&dev); (void)hipDeviceGetAttribute(&cus, hipDeviceAttributeMultiprocessorCount, dev);
        if (hipFuncSetAttribute((const void*)fwd_megakernel, hipFuncAttributeMaxDynamicSharedMemorySize, LDS_BYTES) != hipSuccess) { fprintf(stderr, "kernel_launch: hipFuncSetAttribute failed\n"); grid = -1; return; }
        if (hipOccupancyMaxActiveBlocksPerMultiprocessor(&per_cu, (const void*)fwd_megakernel, NTHR, LDS_BYTES) != hipSuccess || per_cu < 1) { fprintf(stderr, "kernel_launch: occupancy query failed (%d)\n", per_cu); (void)hipGetLastError(); per_cu = 1; }
        grid = cus * (per_cu > 1 ? 1 : per_cu);
        if (grid <= 0) grid = 256;
    }
    if (grid < 0) return;
    (void)hipMemsetAsync((char*)d_ws + WS_BAR, 0, BAR_BYTES, stream);
    Args a{};
    for (int i = 0; i < 25; ++i) a.in[i] = (const float*)d_in[i];
    a.out = (float*)d_out; a.ws = (unsigned char*)d_ws;
#if MK_PER_PHASE
    for (int ph = 0; ph < NPHASE; ++ph) { a.ph_lo = ph; a.ph_hi = ph + 1; hipLaunchKernelGGL(fwd_megakernel, dim3(grid), dim3(NTHR), LDS_BYTES, stream, a); }
#else
    a.ph_lo = 0; a.ph_hi = NPHASE;
    void* kargs[] = {&a};
    hipError_t e = hipLaunchCooperativeKernel((const void*)fwd_megakernel, dim3(grid), dim3(NTHR), kargs, LDS_BYTES, stream);
    if (e != hipSuccess) fprintf(stderr, "kernel_launch: cooperative launch failed: %s (grid %d)\n", hipGetErrorString(e), grid);
#endif
}
```

```cpp
#include <hip/hip_runtime.h>
#include <hip/hip_cooperative_groups.h>
#include <cstdio>
#include <cstdint>
namespace cg = cooperative_groups;
#define PG8_ALIGN true
#define PG8_SP2 true
#ifndef DUP_MASK
#define DUP_MASK 0x000
#endif
#ifndef EXTRA_SYNCS
#define EXTRA_SYNCS 0
#endif
#ifndef GEMM_SIMPLE
#define GEMM_SIMPLE 0
#endif
#if GEMM_SIMPLE
#define GEMM_CALL(E_, S_) pg8::gemm_simple<E_, S_>
#else
#define GEMM_CALL(E_, S_) pg8::gemm_phase<E_, S_, PG8_ALIGN, PG8_SP2>
#endif
#ifndef MK_PER_PHASE
#define MK_PER_PHASE 0
#endif
namespace pg8 {
#define PG8_LAS __attribute__((address_space(3)))
typedef unsigned short bf16_t;
typedef short bf16x8 __attribute__((ext_vector_type(8)));
typedef float f32x4 __attribute__((ext_vector_type(4)));
typedef unsigned u32x4 __attribute__((ext_vector_type(4)));
constexpr int BM = 256, BK = 64, HALF = 128, HTB = HALF * BK * 2  , STAGE_BYTES = 8 * HTB, NXCD = 8, WGM = 8;

__host__ __device__ __forceinline__ int lds_byte(int r, int c) { const int st = (r >> 4) * 2 + (c >> 5), rr = r & 15, cc = c & 31, ob = rr * 64 + cc * 2; return st * 1024 + (ob ^ (((ob >> 9) & 1) << 5)); }
__host__ __device__ __forceinline__ void stage_rc(int b, int& R, int& C) { const int st = b / 1024, sb = b % 1024, swz = sb ^ (((sb >> 9) & 1) << 5); R = (st >> 1) * 16 + swz / 64; C = (st & 1) * 32 + (swz % 64) / 2; }
__host__ __device__ __forceinline__ int perm32(int rho) { const int n = rho >> 4, i = rho & 15; return 8 * (i >> 2) + 4 * n + (i & 3); }

struct Unit { int pm, pn, z; };
struct Gemm { int K, lda, ldb; };

struct StaticOrder {
    int nM, nN, nwg, G, c; const char* A; const char* B; size_t tsA, tsB;
    __host__ __device__ void init(int M, int N, int G_, int c_, const void* A_, int lda, const void* B_, int ldb) { nM = M / BM; nN = N / BM; nwg = nM * nN; G = G_; c = c_; A = (const char*)A_; B = (const char*)B_; tsA = (size_t)BM * lda * 2; tsB = (size_t)BM * ldb * 2; }
    __device__ __forceinline__ const char* pa(const Unit& u) const { return A + (size_t)u.pm * tsA; }
    __device__ __forceinline__ const char* pb(const Unit& u) const { return B + (size_t)u.pn * tsB; }
    __host__ __device__ bool next(int i, Unit& u) const {
        const long L = (long)i * G + c; if (L >= nwg) return false;
        int wgid = (int)L; { const int q = nwg / NXCD, r = nwg % NXCD, xcd = wgid % NXCD, off = wgid / NXCD; wgid = (xcd < r ? xcd * (q + 1) : r * (q + 1) + (xcd - r) * q) + off; }
        const int nig = WGM * nN, gid = wgid / nig, fm = gid * WGM, gsz = (nM - fm) < WGM ? (nM - fm) : WGM;
        u.pm = fm + ((wgid % nig) % gsz); u.pn = (wgid % nig) / gsz; u.z = 0; return true;
    }
    __device__ __forceinline__ void a_ready(const Unit&) const {}
    __device__ __forceinline__ void done(const Unit&) const {}
};

__device__ __forceinline__ unsigned cvt_pk_bf16(float lo, float hi) { unsigned r; asm volatile("s_nop 1\n\tv_cvt_pk_bf16_f32 %0, %1, %2" : "=v"(r) : "v"(lo), "v"(hi)); return r; }
template <class Epi, class Sched, bool ALIGN_EPI = false, bool SP2 = false>
__device__ __forceinline__ void gemm_phase(PG8_LAS unsigned char* lds, const Gemm g, const Sched& S, const Epi& E) {
    const int tid = threadIdx.x, wid = __builtin_amdgcn_readfirstlane(tid >> 6), lane = tid & 63, wr = wid >> 2, wc = wid & 3, fr = lane & 15, fq = lane >> 4;
    const int K = g.K, nt = K / BK;
    unsigned voffA[2], voffB[2];
#pragma unroll
    for (int i = 0; i < 2; ++i) { int R, C; stage_rc(tid * 16 + i * 8192, R, C); const int Rb = Epi::PERM ? ((R & ~31) + perm32(R & 31)) : R;
        voffA[i] = (unsigned)(R * g.lda + C) * 2u; voffB[i] = (unsigned)(Rb * g.ldb + C) * 2u; }
    const size_t kstep = (size_t)(BK * 2);
    const size_t hstepA = (size_t)HALF * g.lda * 2, hstepB = (size_t)HALF * g.ldb * 2;
    const unsigned ldsw = (unsigned)wid * 1024u;
    const int aoff = lds_byte(wr * 64 + fr, fq * 8), boff = lds_byte(wc * 32 + fr, fq * 8);
#define PG8_SA(b, h) (((b) * 2 + (h)) * HTB)
#define PG8_SB(b, h) ((4 + (b) * 2 + (h)) * HTB)
#define PG8_STAGE(bufoff, gbase, voff) do { _Pragma("unroll") for (int _i = 0; _i < 2; ++_i) \
        __builtin_amdgcn_global_load_lds((const unsigned*)((const char*)(gbase) + (voff)[_i]), (PG8_LAS unsigned*)(lds + (bufoff) + ldsw + _i * 8192), 16, 0, 0); } while (0)
#define PG8_LDA(dst, b, h) do { _Pragma("unroll") for (int m = 0; m < 4; ++m) _Pragma("unroll") for (int k = 0; k < 2; ++k) dst[m][k] = *(const PG8_LAS bf16x8*)(lds + PG8_SA(b, h) + aoff + m * 2048 + k * 1024); } while (0)
#define PG8_LDB(dst, b, h) do { _Pragma("unroll") for (int n = 0; n < 2; ++n) _Pragma("unroll") for (int k = 0; k < 2; ++k) dst[n][k] = *(const PG8_LAS bf16x8*)(lds + PG8_SB(b, h) + boff + n * 2048 + k * 1024); } while (0)
#define PG8_MMA(ai, bj, At, Bt) do { __builtin_amdgcn_s_setprio(1); _Pragma("unroll") for (int m = 0; m < 4; ++m) _Pragma("unroll") for (int n = 0; n < 2; ++n) _Pragma("unroll") for (int k = 0; k < 2; ++k) \
        acc[ai][bj][m][n] = __builtin_amdgcn_mfma_f32_16x16x32_bf16(Bt[n][k], At[m][k], acc[ai][bj][m][n], 0, 0, 0); __builtin_amdgcn_s_setprio(0); } while (0)
#define PG8_WAIT_V(n) asm volatile("s_waitcnt vmcnt(" #n ")" ::: "memory")
#define PG8_WAIT_L(n) asm volatile("s_waitcnt lgkmcnt(" #n ")" ::: "memory")
#define PG8_BAR __builtin_amdgcn_s_barrier()
#define PG8_SCHED __builtin_amdgcn_sched_barrier(0)
    Unit cur, nxt; int ui = 0;
    if (!S.next(0, cur)) return;
    f32x4 acc[2][2][4][2];
#pragma unroll
    for (int a = 0; a < 2; ++a)
#pragma unroll
        for (int b = 0; b < 2; ++b)
#pragma unroll
            for (int m = 0; m < 4; ++m)
#pragma unroll
                for (int n = 0; n < 2; ++n) acc[a][b][m][n] = (f32x4){0.f, 0.f, 0.f, 0.f};
    bf16x8 At[4][2], B0[2][2], B1[2][2];
    const char* cA = S.pa(cur); const char* cB = S.pb(cur);
    S.a_ready(cur);
    if constexpr (SP2) {
        PG8_STAGE(PG8_SB(0, 0), cB, voffB); PG8_STAGE(PG8_SB(0, 1), cB + hstepB, voffB); PG8_STAGE(PG8_SA(0, 0), cA, voffA); PG8_STAGE(PG8_SA(0, 1), cA + hstepA, voffA);
        if (wr == 1) PG8_BAR;
        PG8_WAIT_V(2); PG8_BAR;
        PG8_STAGE(PG8_SB(1, 0), cB + kstep, voffB); PG8_STAGE(PG8_SA(1, 0), cA + kstep, voffA); PG8_STAGE(PG8_SB(1, 1), cB + hstepB + kstep, voffB);
        PG8_WAIT_V(6); PG8_BAR;
    } else {
        PG8_STAGE(PG8_SB(0, 0), cB, voffB); PG8_STAGE(PG8_SA(0, 0), cA, voffA); PG8_STAGE(PG8_SB(0, 1), cB + hstepB, voffB); PG8_STAGE(PG8_SA(0, 1), cA + hstepA, voffA);
        if (wr == 1) PG8_BAR;
        PG8_WAIT_V(4); PG8_BAR;
        PG8_STAGE(PG8_SB(1, 0), cB + kstep, voffB); PG8_STAGE(PG8_SA(1, 0), cA + kstep, voffA); PG8_STAGE(PG8_SB(1, 1), cB + hstepB + kstep, voffB);
        PG8_WAIT_V(6); PG8_BAR;
    }
    for (;;) {
        const bool has_next = S.next(ui + 1, nxt);
        const char* nA = has_next ? S.pa(nxt) : cA; const char* nB = has_next ? S.pb(nxt) : cB;
#pragma unroll 1
        for (int t = 0; t < nt; t += 2) {
            const bool last = (t == nt - 2);
            const char* a1 = cA + (size_t)(t + 1) * kstep;
            const char* a2 = last ? nA : cA + (size_t)(t + 2) * kstep; const char* b2 = last ? nB : cB + (size_t)(t + 2) * kstep;
            const char* a3 = a2 + kstep; const char* b3 = b2 + kstep;
            if (last && has_next) S.a_ready(nxt);
            if constexpr (SP2) {
            PG8_LDB(B0, 0, 0); PG8_LDB(B1, 0, 1); PG8_SCHED; PG8_LDA(At, 0, 0); PG8_STAGE(PG8_SA(1, 1), a1 + hstepA, voffA);
            PG8_WAIT_V(8); PG8_WAIT_L(0); PG8_BAR; PG8_MMA(0, 0, At, B0); if constexpr (!Epi::HALF_N) PG8_MMA(0, 1, At, B1); PG8_BAR; PG8_SCHED;
            PG8_LDA(At, 0, 1); PG8_STAGE(PG8_SB(0, 0), b2, voffB); PG8_STAGE(PG8_SB(0, 1), b2 + hstepB, voffB); PG8_STAGE(PG8_SA(0, 0), a2, voffA);
            PG8_WAIT_V(8); PG8_WAIT_L(0); PG8_BAR; PG8_MMA(1, 0, At, B0); if constexpr (!Epi::HALF_N) PG8_MMA(1, 1, At, B1); PG8_BAR; PG8_SCHED;
            PG8_LDB(B0, 1, 0); PG8_LDB(B1, 1, 1); PG8_SCHED; PG8_LDA(At, 1, 0); PG8_STAGE(PG8_SA(0, 1), a2 + hstepA, voffA);
            PG8_WAIT_V(8); PG8_WAIT_L(0); PG8_BAR; PG8_MMA(0, 0, At, B0); if constexpr (!Epi::HALF_N) PG8_MMA(0, 1, At, B1); PG8_BAR; PG8_SCHED;
            PG8_LDA(At, 1, 1); PG8_STAGE(PG8_SB(1, 0), b3, voffB); PG8_STAGE(PG8_SB(1, 1), b3 + hstepB, voffB); PG8_STAGE(PG8_SA(1, 0), a3, voffA);
            PG8_WAIT_V(8); PG8_WAIT_L(0); PG8_BAR; PG8_MMA(1, 0, At, B0); if constexpr (!Epi::HALF_N) PG8_MMA(1, 1, At, B1); PG8_BAR; PG8_SCHED;
            } else {
            PG8_LDB(B0, 0, 0); PG8_SCHED; PG8_LDA(At, 0, 0); PG8_STAGE(PG8_SA(1, 1), a1 + hstepA, voffA);
            PG8_WAIT_L(8); PG8_BAR; PG8_WAIT_L(0); PG8_MMA(0, 0, At, B0); PG8_BAR; PG8_SCHED;
            PG8_LDB(B1, 0, 1); PG8_STAGE(PG8_SB(0, 0), b2, voffB);
            PG8_BAR; PG8_WAIT_L(0); PG8_MMA(0, 1, At, B1); PG8_BAR;
            PG8_LDA(At, 0, 1); PG8_STAGE(PG8_SA(0, 0), a2, voffA);
            PG8_BAR; PG8_WAIT_L(0); PG8_MMA(1, 0, At, B0); PG8_BAR; PG8_SCHED;
            PG8_STAGE(PG8_SB(0, 1), b2 + hstepB, voffB);
            PG8_WAIT_V(6); PG8_BAR; PG8_MMA(1, 1, At, B1); PG8_BAR;
            PG8_LDB(B0, 1, 0); PG8_SCHED; PG8_LDA(At, 1, 0); PG8_STAGE(PG8_SA(0, 1), a2 + hstepA, voffA);
            PG8_WAIT_L(8); PG8_BAR; PG8_WAIT_L(0); PG8_MMA(0, 0, At, B0); PG8_BAR; PG8_SCHED;
            PG8_LDB(B1, 1, 1); PG8_STAGE(PG8_SB(1, 0), b3, voffB);
            PG8_BAR; PG8_WAIT_L(0); PG8_MMA(0, 1, At, B1); PG8_BAR;
            PG8_LDA(At, 1, 1); PG8_STAGE(PG8_SA(1, 0), a3, voffA);
            PG8_BAR; PG8_WAIT_L(0); PG8_MMA(1, 0, At, B0); PG8_BAR; PG8_SCHED;
            PG8_STAGE(PG8_SB(1, 1), b3 + hstepB, voffB);
            PG8_WAIT_V(6); PG8_BAR; PG8_MMA(1, 1, At, B1); PG8_BAR;
            }
        }
        if constexpr (ALIGN_EPI) { if (wr == 0) PG8_BAR; }
        if constexpr (!Epi::AFTER_DRAIN) { E(acc, cur, wr, wc, fr, fq); S.done(cur); }
        if (!has_next) break;
#pragma unroll
        for (int a = 0; a < 2; ++a)
#pragma unroll
            for (int b = 0; b < 2; ++b)
#pragma unroll
                for (int m = 0; m < 4; ++m)
#pragma unroll
                    for (int n = 0; n < 2; ++n) acc[a][b][m][n] = (f32x4){0.f, 0.f, 0.f, 0.f};
        cur = nxt; cA = nA; cB = nB; ++ui;
        if constexpr (ALIGN_EPI) { if (wr == 1) PG8_BAR; }
    }
    PG8_WAIT_V(0);
    if constexpr (!ALIGN_EPI) { if (wr == 0) PG8_BAR; }
    PG8_BAR;
    if constexpr (Epi::AFTER_DRAIN) { E.fused(acc, cur, wr, wc, fr, fq, lds, wid, lane); S.done(cur); }
#undef PG8_SA
#undef PG8_SB
#undef PG8_STAGE
#undef PG8_LDA
#undef PG8_LDB
#undef PG8_MMA
#undef PG8_WAIT_V
#undef PG8_WAIT_L
#undef PG8_BAR
#undef PG8_SCHED
}

template <class Epi, class Sched>
__device__ __forceinline__ void gemm_simple(PG8_LAS unsigned char* lds, const Gemm g, const Sched& S, const Epi& E) {
    const int tid = threadIdx.x, wid = __builtin_amdgcn_readfirstlane(tid >> 6), lane = tid & 63, wr = wid >> 2, wc = wid & 3, fr = lane & 15, fq = lane >> 4;
    const int nt = g.K / BK;
    unsigned voffA[2], voffB[2];
#pragma unroll
    for (int i = 0; i < 2; ++i) { int R, C; stage_rc(tid * 16 + i * 8192, R, C); const int Rb = Epi::PERM ? ((R & ~31) + perm32(R & 31)) : R;
        voffA[i] = (unsigned)(R * g.lda + C) * 2u; voffB[i] = (unsigned)(Rb * g.ldb + C) * 2u; }
    const size_t kstep = (size_t)(BK * 2), hstepA = (size_t)HALF * g.lda * 2, hstepB = (size_t)HALF * g.ldb * 2;
    const unsigned ldst = (unsigned)tid * 16u;
    const int aoff = lds_byte(wr * 64 + fr, fq * 8), boff = lds_byte(wc * 32 + fr, fq * 8);
#define SG_SA(b, h) (((b) * 2 + (h)) * HTB)
#define SG_SB(b, h) ((4 + (b) * 2 + (h)) * HTB)
#define SG_LDB(dst, b, h) do { _Pragma("unroll") for (int n = 0; n < 2; ++n) _Pragma("unroll") for (int k = 0; k < 2; ++k) dst[n][k] = *(const PG8_LAS bf16x8*)(lds + SG_SB(b, h) + boff + n * 2048 + k * 1024); } while (0)
#define SG_AFRAG(b, st, k) (*(const PG8_LAS bf16x8*)(lds + SG_SA(b, (st) >> 2) + aoff + ((st) & 3) * 2048 + (k) * 1024))
#define SG_AHALF(b, ai) do { bf16x8 c0 = SG_AFRAG(b, (ai) * 4, 0), c1 = SG_AFRAG(b, (ai) * 4, 1); \
        _Pragma("unroll") for (int m = 0; m < 4; ++m) { bf16x8 n0 = c0, n1 = c1; \
            if (m < 3) { n0 = SG_AFRAG(b, (ai) * 4 + m + 1, 0); n1 = SG_AFRAG(b, (ai) * 4 + m + 1, 1); } \
            __builtin_amdgcn_sched_barrier(0); \
            _Pragma("unroll") for (int n = 0; n < 2; ++n) { \
                acc[ai][0][m][n] = __builtin_amdgcn_mfma_f32_16x16x32_bf16(B0[n][0], c0, acc[ai][0][m][n], 0, 0, 0); acc[ai][0][m][n] = __builtin_amdgcn_mfma_f32_16x16x32_bf16(B0[n][1], c1, acc[ai][0][m][n], 0, 0, 0); \
                acc[ai][1][m][n] = __builtin_amdgcn_mfma_f32_16x16x32_bf16(B1[n][0], c0, acc[ai][1][m][n], 0, 0, 0); acc[ai][1][m][n] = __builtin_amdgcn_mfma_f32_16x16x32_bf16(B1[n][1], c1, acc[ai][1][m][n], 0, 0, 0); } \
            __builtin_amdgcn_sched_barrier(0); c0 = n0; c1 = n1; } } while (0)
#define SG_LOADA(t) do { _Pragma("unroll") for (int h = 0; h < 2; ++h) _Pragma("unroll") for (int i = 0; i < 2; ++i) rr[h][i] = *(const u32x4*)(cA + h * hstepA + (size_t)(t) * kstep + voffA[i]); } while (0)
#define SG_LOADB(t) do { _Pragma("unroll") for (int h = 0; h < 2; ++h) _Pragma("unroll") for (int i = 0; i < 2; ++i) rr[h][i] = *(const u32x4*)(cB + h * hstepB + (size_t)(t) * kstep + voffB[i]); } while (0)
#define SG_STOREA(b) do { _Pragma("unroll") for (int h = 0; h < 2; ++h) _Pragma("unroll") for (int i = 0; i < 2; ++i) *(PG8_LAS u32x4*)(lds + SG_SA(b, h) + i * 8192 + ldst) = rr[h][i]; } while (0)
#define SG_STOREB(b) do { _Pragma("unroll") for (int h = 0; h < 2; ++h) _Pragma("unroll") for (int i = 0; i < 2; ++i) *(PG8_LAS u32x4*)(lds + SG_SB(b, h) + i * 8192 + ldst) = rr[h][i]; } while (0)
#define SG_KTILE(b, tn, more) do { bf16x8 B0[2][2], B1[2][2]; if (more) SG_LOADA(tn); SG_LDB(B0, b, 0); SG_LDB(B1, b, 1); SG_AHALF(b, 0); \
        if (more) { SG_STOREA((b) ^ 1); SG_LOADB(tn); } SG_AHALF(b, 1); if (more) SG_STOREB((b) ^ 1); __syncthreads(); } while (0)
    Unit cur;
    for (int ui = 0; S.next(ui, cur); ++ui) {
        f32x4 acc[2][2][4][2];
#pragma unroll
        for (int a = 0; a < 2; ++a)
#pragma unroll
            for (int b = 0; b < 2; ++b)
#pragma unroll
                for (int m = 0; m < 4; ++m)
#pragma unroll
                    for (int n = 0; n < 2; ++n) acc[a][b][m][n] = (f32x4){0.f, 0.f, 0.f, 0.f};
        const char* cA = S.pa(cur); const char* cB = S.pb(cur);
        u32x4 rr[2][2];
        __syncthreads();
        SG_LOADA(0); SG_STOREA(0); SG_LOADB(0); SG_STOREB(0);
        __syncthreads();
#pragma unroll 1
        for (int t = 0; t < nt; t += 2) {
            SG_KTILE(0, t + 1, true);
            const bool more = (t + 2 < nt);
            SG_KTILE(1, t + 2, more);
        }
        E(acc, cur, wr, wc, fr, fq);
    }
#undef SG_SA
#undef SG_SB
#undef SG_LDB
#undef SG_AFRAG
#undef SG_AHALF
#undef SG_LOADA
#undef SG_LOADB
#undef SG_STOREA
#undef SG_STOREB
#undef SG_KTILE
}
}

constexpr int BATCH = 4, SEQ = 4096, D = 1024, M = BATCH * SEQ;
constexpr int CW = 512, CK = 31, SW = 512, NG = 32, SP = 64, FH = 2816, INC = 3584, NMOD6 = 6 * D;
constexpr int LC = 16, NCH = M / LC, CPB = SEQ / LC, KA2 = 384;
constexpr float EPS = 1e-6f;
constexpr int NWAVES = 8, NTHR = 512;
constexpr int NPHASE = 8;

constexpr size_t MiB = 1u << 20;
constexpr size_t WS_CTL = 0, CTL_ZERO_BYTES = 1 * MiB;
constexpr size_t WS_BAR = 512 * 1024, WS_PCNT = 512 * 1024 + 16384, WS_GCNT = 512 * 1024 + 32768, BAR_BYTES = 32768 + 256;
constexpr size_t WS_MOD = 0, WS_RSS1 = 30 * MiB, WS_RSS2 = 31 * MiB;
constexpr size_t WS_WIN = 1 * MiB, WS_WCP = 8 * MiB, WS_WGLU = 9 * MiB, WS_WOUT = 11 * MiB, WS_WFI = 13 * MiB, WS_WFO = 24 * MiB;
constexpr size_t WS_SHW = 29 * MiB + 512 * 1024;
constexpr size_t WS_W1 = 30 * MiB, WS_B2 = 34 * MiB;
constexpr size_t WS_H1 = 40 * MiB;
constexpr size_t WS_UCONV = 72 * MiB, WS_A2S = 88 * MiB, WS_SGC = 112 * MiB, WS_SGS = 144 * MiB, WS_ACONV = 176 * MiB, WS_ASSM = 192 * MiB, WS_S = 208 * MiB, WS_MERGED = 224 * MiB;
constexpr size_t WS_X1B = 72 * MiB;
constexpr size_t WS_HID = 136 * MiB;
constexpr size_t WS_END = 256 * MiB;
static_assert(WS_HID + (size_t)M * FH * 2 <= WS_MERGED && WS_WFO + (size_t)D * FH * 2 <= WS_SHW && WS_B2 + (size_t)NG * 256 * KA2 * 2 <= WS_H1, "ws map");

constexpr int RING_BYTES = 131072, LDS_BYTES = 147456;

#define GAS __attribute__((address_space(1)))
#define LAS __attribute__((address_space(3)))
typedef unsigned short bf16;
typedef unsigned v4u __attribute__((ext_vector_type(4)));
typedef unsigned v2u __attribute__((ext_vector_type(2)));
typedef float f32x4 __attribute__((ext_vector_type(4)));
typedef float f32x2 __attribute__((ext_vector_type(2)));
using pg8::cvt_pk_bf16;
__device__ __forceinline__ float bf_lo(unsigned w) { return __uint_as_float(w << 16); }
__device__ __forceinline__ float bf_hi(unsigned w) { return __uint_as_float(w & 0xffff0000u); }
__device__ __forceinline__ float sigm(float x) { return __builtin_amdgcn_rcpf(1.0f + __expf(-x)); }
__device__ __forceinline__ float silu_f(float x) { return x * sigm(x); }
__device__ __forceinline__ float gelu_tanh(float x) { return x * sigm(1.5957691216057308f * (x + 0.044715f * x * x * x)); }
__device__ __forceinline__ float wave_sum(float v) {
#pragma unroll
    for (int o = 1; o < 64; o <<= 1) v += __shfl_xor(v, o);
    return v;
}
__device__ __forceinline__ v4u pack8(const f32x4 a, const f32x4 b) { v4u w; w.x = cvt_pk_bf16(a[0], a[1]); w.y = cvt_pk_bf16(a[2], a[3]); w.z = cvt_pk_bf16(b[0], b[1]); w.w = cvt_pk_bf16(b[2], b[3]); return w; }
__device__ __forceinline__ void unpack8(const v4u w, f32x4& a, f32x4& b) { a = (f32x4){bf_lo(w.x), bf_hi(w.x), bf_lo(w.y), bf_hi(w.y)}; b = (f32x4){bf_lo(w.z), bf_hi(w.z), bf_lo(w.w), bf_hi(w.w)}; }

struct BatchOrder {
    int nM, nwg, G, c; const char* A; const char* B; size_t zsA, tsA, zsB;
    __device__ __forceinline__ bool next(int i, pg8::Unit& u) const { const int L = i * G + c; if (L >= nwg) return false; u.z = L / nM; u.pm = L % nM; u.pn = 0; return true; }
    __device__ __forceinline__ const char* pa(const pg8::Unit& u) const { return A + (size_t)u.z * zsA + (size_t)u.pm * tsA; }
    __device__ __forceinline__ const char* pb(const pg8::Unit& u) const { return B + (size_t)u.z * zsB; }
    __device__ __forceinline__ void a_ready(const pg8::Unit&) const {}
    __device__ __forceinline__ void done(const pg8::Unit&) const {}
};

#define EPI_HEAD static constexpr bool PERM = true, AFTER_DRAIN = false, HALF_N = false
typedef f32x4 AccT[2][2][4][2];

struct EpiIn {
    EPI_HEAD; bf16* uconv; bf16* a2s; bf16* sgc; bf16* sgs;
    __device__ __forceinline__ void operator()(const AccT& acc, const pg8::Unit& u, int wr, int wc, int fr, int fq) const {
        const int row0 = u.pm * 256 + wr * 64 + fr;
        if (u.pn < 4) {
            const int col = u.pn * 128 + wc * 32 + 8 * fq;
#pragma unroll
            for (int ai = 0; ai < 2; ++ai)
#pragma unroll
                for (int m = 0; m < 4; ++m) { const int row = row0 + ai * 128 + m * 16; f32x4 o0, o1;
#pragma unroll
                    for (int e = 0; e < 4; ++e) { o0[e] = acc[ai][0][m][0][e] * sigm(acc[ai][1][m][0][e]); o1[e] = acc[ai][0][m][1][e] * sigm(acc[ai][1][m][1][e]); }
                    *(v4u*)(uconv + (size_t)row * CW + col) = pack8(o0, o1); }
        } else if (u.pn < 6) {
#pragma unroll
            for (int bj = 0; bj < 2; ++bj) { const int cc = (u.pn - 4) * 256 + bj * 128 + wc * 32 + 8 * fq, g = cc >> 4, h0 = cc & 15;
#pragma unroll
                for (int ai = 0; ai < 2; ++ai)
#pragma unroll
                    for (int m = 0; m < 4; ++m) { const int row = row0 + ai * 128 + m * 16;
                        *(v4u*)(a2s + ((size_t)(g * NCH + (row >> 4)) * KA2 + (row & 15) * 16 + h0)) = pack8(acc[ai][bj][m][0], acc[ai][bj][m][1]); } }
        } else {
#pragma unroll
            for (int bj = 0; bj < 2; ++bj) { const int gc = (u.pn - 6) * 256 + bj * 128 + wc * 32 + 8 * fq; bf16* dst = gc < D ? sgc + gc : sgs + (gc - D);
#pragma unroll
                for (int ai = 0; ai < 2; ++ai)
#pragma unroll
                    for (int m = 0; m < 4; ++m) { const int row = row0 + ai * 128 + m * 16; f32x4 o0, o1;
#pragma unroll
                        for (int e = 0; e < 4; ++e) { o0[e] = sigm(acc[ai][bj][m][0][e]); o1[e] = sigm(acc[ai][bj][m][1][e]); }
                        *(v4u*)(dst + (size_t)row * D) = pack8(o0, o1); } }
        }
    }
};
struct EpiState {
    EPI_HEAD; float* S;
    __device__ __forceinline__ void operator()(const AccT& acc, const pg8::Unit& u, int wr, int wc, int fr, int fq) const {
        const int col = wc * 32 + 8 * fq;
#pragma unroll
        for (int ai = 0; ai < 2; ++ai)
#pragma unroll
            for (int m = 0; m < 4; ++m) { const int rr = u.pm * 256 + ai * 128 + wr * 64 + m * 16 + fr; float* p = S + ((size_t)(u.z * NCH + rr)) * 128 + col;
                *(f32x4*)p = acc[ai][0][m][0]; *(f32x4*)(p + 4) = acc[ai][0][m][1]; }
    }
};
struct EpiStateLds {
    static constexpr bool PERM = true, AFTER_DRAIN = true, HALF_N = true;
    __device__ __forceinline__ void fused(const AccT& acc, const pg8::Unit& u, int wr, int wc, int fr, int fq, LAS unsigned char* lds, int wid, int lane) const {
        const int col = wc * 32 + 8 * fq;
#pragma unroll
        for (int ai = 0; ai < 2; ++ai)
#pragma unroll
            for (int m = 0; m < 4; ++m) { LAS float* p = (LAS float*)lds + (ai * 128 + wr * 64 + m * 16 + fr) * 128 + col;
                *(LAS f32x4*)p = acc[ai][0][m][0]; *(LAS f32x4*)(p + 4) = acc[ai][0][m][1]; }
    }
};
struct EpiSsmOut {
    EPI_HEAD; const bf16* a2s; const float* dvec; bf16* assm;
    __device__ __forceinline__ void operator()(const AccT& acc, const pg8::Unit& u, int wr, int wc, int fr, int fq) const {
        const int g = u.z; asm volatile("" : "+v"(fq), "+v"(fr));
#pragma unroll
        for (int bj = 0; bj < 2; ++bj) { const int c = bj * 128 + wc * 32 + 8 * fq, t = c >> 4, h0 = c & 15;
            const f32x4 d0 = *(const f32x4*)(dvec + g * 16 + h0), d1 = *(const f32x4*)(dvec + g * 16 + h0 + 4);
            v4u uu[2][4];
#pragma unroll
            for (int ai = 0; ai < 2; ++ai)
#pragma unroll
                for (int m = 0; m < 4; ++m) uu[ai][m] = *(const v4u*)(a2s + ((size_t)(g * NCH + u.pm * 256 + ai * 128 + wr * 64 + m * 16 + fr) * KA2 + c));
#pragma unroll
            for (int ai = 0; ai < 2; ++ai)
#pragma unroll
                for (int m = 0; m < 4; ++m) { const int rr = u.pm * 256 + ai * 128 + wr * 64 + m * 16 + fr;
                    f32x4 u0, u1; unpack8(uu[ai][m], u0, u1);
                    f32x4 y0 = acc[ai][bj][m][0] + d0 * u0, y1 = acc[ai][bj][m][1] + d1 * u1;
#pragma unroll
                    for (int e = 0; e < 4; ++e) { y0[e] = gelu_tanh(y0[e]); y1[e] = gelu_tanh(y1[e]); }
                    *(v4u*)(assm + ((size_t)(rr * LC + t) * SW + g * 16 + h0)) = pack8(y0, y1); }
            asm volatile("" ::: "memory"); }
    }
};
struct EpiConvProj {
    EPI_HEAD; const bf16* sgc; bf16* mg;
    __device__ __forceinline__ void operator()(const AccT& acc, const pg8::Unit& u, int wr, int wc, int fr, int fq) const {
#pragma unroll
        for (int bj = 0; bj < 2; ++bj) { const int col = u.pn * 256 + bj * 128 + wc * 32 + 8 * fq;
            v4u gg[2][4];
#pragma unroll
            for (int ai = 0; ai < 2; ++ai)
#pragma unroll
                for (int m = 0; m < 4; ++m) gg[ai][m] = *(const v4u*)(sgc + (size_t)(u.pm * 256 + ai * 128 + wr * 64 + m * 16 + fr) * D + col);
#pragma unroll
            for (int ai = 0; ai < 2; ++ai)
#pragma unroll
                for (int m = 0; m < 4; ++m) { const size_t off = (size_t)(u.pm * 256 + ai * 128 + wr * 64 + m * 16 + fr) * D + col;
                    f32x4 g0, g1; unpack8(gg[ai][m], g0, g1);
                    *(v4u*)(mg + off) = pack8(g0 * acc[ai][bj][m][0], g1 * acc[ai][bj][m][1]); }
            asm volatile("" ::: "memory"); }
    }
};
struct EpiSsmGlu {
    EPI_HEAD; const bf16* sgs; bf16* mg;
    __device__ __forceinline__ void operator()(const AccT& acc, const pg8::Unit& u, int wr, int wc, int fr, int fq) const {
        const int col = u.pn * 128 + wc * 32 + 8 * fq;
#pragma unroll
        for (int ai = 0; ai < 2; ++ai) {
            v4u gg[4], pp[4];
#pragma unroll
            for (int m = 0; m < 4; ++m) { const size_t off = (size_t)(u.pm * 256 + ai * 128 + wr * 64 + m * 16 + fr) * D + col; gg[m] = *(const v4u*)(sgs + off); pp[m] = *(const v4u*)(mg + off); }
#pragma unroll
            for (int m = 0; m < 4; ++m) { const size_t off = (size_t)(u.pm * 256 + ai * 128 + wr * 64 + m * 16 + fr) * D + col;
                f32x4 g0, g1, p0, p1; unpack8(gg[m], g0, g1); unpack8(pp[m], p0, p1);
#pragma unroll
                for (int e = 0; e < 4; ++e) { p0[e] += g0[e] * acc[ai][0][m][0][e] * sigm(acc[ai][1][m][0][e]); p1[e] += g1[e] * acc[ai][0][m][1][e] * sigm(acc[ai][1][m][1][e]); }
                *(v4u*)(mg + off) = pack8(p0, p1); }
            asm volatile("" ::: "memory"); }
    }
};
struct EpiOut {
    EPI_HEAD; const float* x; const float* mod; const float* n2g; bf16* x1; bf16* a2; float* rss;
    __device__ __forceinline__ void operator()(const AccT& acc, const pg8::Unit& u, int wr, int wc, int fr, int fq) const {
        const float* mb = mod + (u.pm >> 4) * NMOD6;
        float ss[2][4];
#pragma unroll
        for (int ai = 0; ai < 2; ++ai)
#pragma unroll
            for (int m = 0; m < 4; ++m) ss[ai][m] = 0.f;
#pragma unroll
        for (int bj = 0; bj < 2; ++bj) { const int col = u.pn * 256 + bj * 128 + wc * 32 + 8 * fq;
            const f32x4 gv0 = *(const f32x4*)(mb + 2 * D + col), gv1 = *(const f32x4*)(mb + 2 * D + col + 4);
            const f32x4 cs0 = *(const f32x4*)(n2g + col) * (*(const f32x4*)(mb + 4 * D + col) + 1.0f), cs1 = *(const f32x4*)(n2g + col + 4) * (*(const f32x4*)(mb + 4 * D + col + 4) + 1.0f);
#pragma unroll
            for (int ai = 0; ai < 2; ++ai) {
                f32x4 xx[4][2];
#pragma unroll
                for (int m = 0; m < 4; ++m) { const size_t off = (size_t)(u.pm * 256 + ai * 128 + wr * 64 + m * 16 + fr) * D + col;
                    xx[m][0] = __builtin_nontemporal_load((const f32x4*)(x + off)); xx[m][1] = __builtin_nontemporal_load((const f32x4*)(x + off + 4)); }
#pragma unroll
                for (int m = 0; m < 4; ++m) { const size_t off = (size_t)(u.pm * 256 + ai * 128 + wr * 64 + m * 16 + fr) * D + col;
                    const f32x4 v0 = xx[m][0] + gv0 * acc[ai][bj][m][0], v1 = xx[m][1] + gv1 * acc[ai][bj][m][1];
                    *(v4u*)(a2 + off) = pack8(v0 * cs0, v1 * cs1);
                    ss[ai][m] += (v0[0] * v0[0] + v0[1] * v0[1]) + (v0[2] * v0[2] + v0[3] * v0[3]) + (v1[0] * v1[0] + v1[1] * v1[1]) + (v1[2] * v1[2] + v1[3] * v1[3]); }
                asm volatile("" ::: "memory"); } }
#pragma unroll
        for (int ai = 0; ai < 2; ++ai)
#pragma unroll
            for (int m = 0; m < 4; ++m) { float t = ss[ai][m]; t += __shfl_xor(t, 16); t += __shfl_xor(t, 32);
                if (fq == 0) rss[(u.pm * 256 + ai * 128 + wr * 64 + m * 16 + fr) * 16 + u.pn * 4 + wc] = t; }
    }
};
struct EpiFfnIn {
    EPI_HEAD; const float* rss; const float* shw; bf16* hid;
    __device__ __forceinline__ void operator()(const AccT& acc, const pg8::Unit& u, int wr, int wc, int fr, int fq) const {
        const float* sb = shw + (u.pm >> 4) * (2 * FH) + u.pn * 256 + wc * 32 + 8 * fq;
        const f32x4 sg0 = *(const f32x4*)sb, sg1 = *(const f32x4*)(sb + 4), su0 = *(const f32x4*)(sb + 128), su1 = *(const f32x4*)(sb + 132);
        f32x4 qq[2][4];
#pragma unroll
        for (int ai = 0; ai < 2; ++ai)
#pragma unroll
            for (int m = 0; m < 4; ++m) qq[ai][m] = *(const f32x4*)(rss + (u.pm * 256 + ai * 128 + wr * 64 + m * 16 + fr) * 16 + 4 * fq);
#pragma unroll
        for (int ai = 0; ai < 2; ++ai)
#pragma unroll
            for (int m = 0; m < 4; ++m) { const int row = u.pm * 256 + ai * 128 + wr * 64 + m * 16 + fr;
                float t = (qq[ai][m][0] + qq[ai][m][1]) + (qq[ai][m][2] + qq[ai][m][3]); t += __shfl_xor(t, 16); t += __shfl_xor(t, 32);
                const float inv = rsqrtf(t * (1.0f / D) + EPS);
                const f32x4 g0 = acc[ai][0][m][0] * inv + sg0, g1 = acc[ai][0][m][1] * inv + sg1, u0 = acc[ai][1][m][0] * inv + su0, u1 = acc[ai][1][m][1] * inv + su1; f32x4 o0, o1;
#pragma unroll
                for (int e = 0; e < 4; ++e) { o0[e] = silu_f(g0[e]) * u0[e]; o1[e] = silu_f(g1[e]) * u1[e]; }
                *(v4u*)(hid + (size_t)row * FH + u.pn * 128 + wc * 32 + 8 * fq) = pack8(o0, o1); }
    }
};
struct EpiFfnOut {
    EPI_HEAD; const float* mod; const float* fg; const float* n2g; const bf16* x1; float* xo; float* rss; unsigned* cnt;
    __device__ __forceinline__ void operator()(AccT& acc, const pg8::Unit& u, int wr, int wc, int fr, int fq) const {
        const float* mb = mod + (u.pm >> 4) * NMOD6;
        {
            f32x4 gv[2][2], rc[2][2];
#pragma unroll
            for (int bj = 0; bj < 2; ++bj)
#pragma unroll
                for (int n = 0; n < 2; ++n) { const int col = u.pn * 256 + bj * 128 + wc * 32 + 8 * fq + 4 * n; gv[bj][n] = *(const f32x4*)(mb + 5 * D + col);
                    const f32x4 cs = *(const f32x4*)(n2g + col) * (*(const f32x4*)(mb + 4 * D + col) + 1.0f); rc[bj][n] = (f32x4){1.0f / cs[0], 1.0f / cs[1], 1.0f / cs[2], 1.0f / cs[3]}; }
#pragma unroll
            for (int ai = 0; ai < 2; ++ai)
#pragma unroll
                for (int m = 0; m < 4; ++m) { const int row = u.pm * 256 + ai * 128 + wr * 64 + m * 16 + fr; float ss = 0.f;
#pragma unroll
                    for (int bj = 0; bj < 2; ++bj) { const size_t off = (size_t)row * D + u.pn * 256 + bj * 128 + wc * 32 + 8 * fq;
                        f32x4 r0, r1; unpack8(*(const v4u*)(x1 + off), r0, r1);
                        const f32x4 v0 = r0 * rc[bj][0] + gv[bj][0] * acc[ai][bj][m][0], v1 = r1 * rc[bj][1] + gv[bj][1] * acc[ai][bj][m][1];
                        acc[ai][bj][m][0] = v0; acc[ai][bj][m][1] = v1;
                        ss += (v0[0] * v0[0] + v0[1] * v0[1]) + (v0[2] * v0[2] + v0[3] * v0[3]) + (v1[0] * v1[0] + v1[1] * v1[1]) + (v1[2] * v1[2] + v1[3] * v1[3]); }
                    ss += __shfl_xor(ss, 16); ss += __shfl_xor(ss, 32);
                    if (fq == 0) __hip_atomic_store(rss + row * 16 + u.pn * 4 + wc, ss, __ATOMIC_RELAXED, __HIP_MEMORY_SCOPE_AGENT); }
        }
        asm volatile("s_waitcnt vmcnt(0)" ::: "memory");
        unsigned* cw = cnt + 64 * u.pm;
        if (fr == 0 && fq == 0) __hip_atomic_fetch_add(cw, 1u, __ATOMIC_RELAXED, __HIP_MEMORY_SCOPE_AGENT);
        { unsigned sp = 0; while ((unsigned)__builtin_amdgcn_readfirstlane(__hip_atomic_load(cw, __ATOMIC_RELAXED, __HIP_MEMORY_SCOPE_AGENT)) < 32u) { __builtin_amdgcn_s_sleep(2); if (++sp > (1u << 22)) break; } }
        __builtin_amdgcn_fence(__ATOMIC_ACQUIRE, "agent");
        asm volatile("s_waitcnt vmcnt(0)" ::: "memory");
        f32x4 fv[2][2];
#pragma unroll
        for (int bj = 0; bj < 2; ++bj)
#pragma unroll
            for (int n = 0; n < 2; ++n) fv[bj][n] = *(const f32x4*)(fg + u.pn * 256 + bj * 128 + wc * 32 + 8 * fq + 4 * n);
#pragma unroll
        for (int ai = 0; ai < 2; ++ai)
#pragma unroll
            for (int m = 0; m < 4; ++m) { const int row = u.pm * 256 + ai * 128 + wr * 64 + m * 16 + fr;
                const unsigned long long* pp = (const unsigned long long*)(rss + row * 16 + 4 * fq);
                const unsigned long long w0 = __hip_atomic_load(pp, __ATOMIC_RELAXED, __HIP_MEMORY_SCOPE_AGENT), w1 = __hip_atomic_load(pp + 1, __ATOMIC_RELAXED, __HIP_MEMORY_SCOPE_AGENT);
                float t = (__uint_as_float((unsigned)w0) + __uint_as_float((unsigned)(w0 >> 32))) + (__uint_as_float((unsigned)w1) + __uint_as_float((unsigned)(w1 >> 32)));
                t += __shfl_xor(t, 16); t += __shfl_xor(t, 32);
                const float inv = rsqrtf(t * (1.0f / D) + EPS);
#pragma unroll
                for (int bj = 0; bj < 2; ++bj) { const size_t off = (size_t)row * D + u.pn * 256 + bj * 128 + wc * 32 + 8 * fq;
                    __builtin_nontemporal_store(acc[ai][bj][m][0] * inv * fv[bj][0], (f32x4*)(xo + off)); __builtin_nontemporal_store(acc[ai][bj][m][1] * inv * fv[bj][1], (f32x4*)(xo + off + 4)); } }
    }
};

struct TripleOrder {
    pg8::StaticOrder base; const char* A1; const char* B1; size_t tsA, tsB;
    __device__ __forceinline__ bool next(int i, pg8::Unit& u) const { pg8::Unit t; if (!base.next(i / 3, t)) return false; const int sub = i % 3; u.pm = t.pm;
        if (sub == 0) { u.pn = t.pn; u.z = 0; } else { u.pn = 2 * t.pn + (sub - 1); u.z = 1; } return true; }
    __device__ __forceinline__ const char* pa(const pg8::Unit& u) const { return u.z ? A1 + (size_t)u.pm * tsA : base.pa(u); }
    __device__ __forceinline__ const char* pb(const pg8::Unit& u) const { return u.z ? B1 + (size_t)u.pn * tsB : base.pb(u); }
    __device__ __forceinline__ void a_ready(const pg8::Unit&) const {}
    __device__ __forceinline__ void done(const pg8::Unit&) const {}
};
struct EpiMix {
    EPI_HEAD; const bf16* sgc; const bf16* sgs; bf16* mg;
    __device__ __forceinline__ void operator()(const AccT& acc, const pg8::Unit& u, int wr, int wc, int fr, int fq) const {
        if (u.z == 0) { const EpiConvProj e{sgc, mg}; e(acc, u, wr, wc, fr, fq); } else { const EpiSsmGlu e{sgs, mg}; e(acc, u, wr, wc, fr, fq); }
    }
};

__device__ __forceinline__ int ileave(int n0, int half) { return n0 < half ? 256 * (n0 >> 7) + (n0 & 127) : 256 * ((n0 - half) >> 7) + 128 + ((n0 - half) & 127); }
__device__ __forceinline__ void tr_fetch(const float* W, int N, int item, int lane, float (&tv)[32]) {
    const int nblk = N / 32, kb = item / nblk, nb = item % nblk, k0 = 64 * kb, n0 = 32 * nb;
#pragma unroll
    for (int i = 0; i < 32; ++i) tv[i] = __builtin_nontemporal_load(W + (size_t)(k0 + 2 * i + (lane >> 5)) * N + n0 + (lane & 31));
}
__device__ __forceinline__ void tr_emit(const float (&tv)[32], int K, int N, bf16* WT, int mode, LAS float* scr, int item, int lane) {
    const int nblk = N / 32, kb = item / nblk, nb = item % nblk, k0 = 64 * kb, n0 = 32 * nb;
    int r0 = n0;
    if (mode == 1) r0 = n0 < 1024 ? ileave(n0, 512) : n0;
    else if (mode == 2) r0 = ileave(n0, 1024);
    else if (mode == 3) r0 = ileave(n0, FH);
#pragma unroll
    for (int i = 0; i < 32; ++i) scr[(2 * i + (lane >> 5)) * 33 + (lane & 31)] = tv[i];
    asm volatile("s_waitcnt lgkmcnt(0)" ::: "memory");
    const int c = lane & 7;
#pragma unroll
    for (int j = 0; j < 4; ++j) { const int n = (lane >> 3) + 8 * j; const LAS float* s = scr + (8 * c) * 33 + n;
        v4u o; o.x = cvt_pk_bf16(s[0 * 33], s[1 * 33]); o.y = cvt_pk_bf16(s[2 * 33], s[3 * 33]); o.z = cvt_pk_bf16(s[4 * 33], s[5 * 33]); o.w = cvt_pk_bf16(s[6 * 33], s[7 * 33]);
        *(v4u*)(WT + (size_t)(r0 + n) * K + k0 + 8 * c) = o; }
    asm volatile("s_waitcnt lgkmcnt(0)" ::: "memory");
}
__device__ __forceinline__ void transpose_item(const float* W, int K, int N, bf16* WT, int mode, LAS float* scr, int item, int lane) {
    const int nblk = N / 32, kb = item / nblk, nb = item % nblk, k0 = 64 * kb, n0 = 32 * nb;
    int r0 = n0;
    if (mode == 1) r0 = n0 < 1024 ? ileave(n0, 512) : n0;
    else if (mode == 2) r0 = ileave(n0, 1024);
    else if (mode == 3) r0 = ileave(n0, FH);
    float tv[32];
#pragma unroll
    for (int i = 0; i < 32; ++i) tv[i] = __builtin_nontemporal_load(W + (size_t)(k0 + 2 * i + (lane >> 5)) * N + n0 + (lane & 31));
#pragma unroll
    for (int i = 0; i < 32; ++i) scr[(2 * i + (lane >> 5)) * 33 + (lane & 31)] = tv[i];
    asm volatile("s_waitcnt lgkmcnt(0)" ::: "memory");
    const int c = lane & 7;
#pragma unroll
    for (int j = 0; j < 4; ++j) { const int n = (lane >> 3) + 8 * j; const LAS float* s = scr + (8 * c) * 33 + n;
        v4u o; o.x = cvt_pk_bf16(s[0 * 33], s[1 * 33]); o.y = cvt_pk_bf16(s[2 * 33], s[3 * 33]); o.z = cvt_pk_bf16(s[4 * 33], s[5 * 33]); o.w = cvt_pk_bf16(s[6 * 33], s[7 * 33]);
        *(v4u*)(WT + (size_t)(r0 + n) * K + k0 + 8 * c) = o; }
    asm volatile("s_waitcnt lgkmcnt(0)" ::: "memory");
}
__device__ __forceinline__ void sincos_d(double x, double& s, double& c) {
    const double k = rint(x * 0.63661977236758134308);
    double r = fma(-k, 1.57079632679489655800e+00, x); r = fma(-k, 6.12323399573676603587e-17, r);
    const int q = ((int)k) & 3; const double r2 = r * r;
    double sp = -1.0 / 1307674368000.0; sp = fma(sp, r2, 1.0 / 6227020800.0); sp = fma(sp, r2, -1.0 / 39916800.0); sp = fma(sp, r2, 1.0 / 362880.0); sp = fma(sp, r2, -1.0 / 5040.0); sp = fma(sp, r2, 1.0 / 120.0); sp = fma(sp, r2, -1.0 / 6.0); sp = fma(sp * r2, r, r);
    double cp = 1.0 / 20922789888000.0; cp = fma(cp, r2, -1.0 / 87178291200.0); cp = fma(cp, r2, 1.0 / 479001600.0); cp = fma(cp, r2, -1.0 / 3628800.0); cp = fma(cp, r2, 1.0 / 40320.0); cp = fma(cp, r2, -1.0 / 720.0); cp = fma(cp, r2, 1.0 / 24.0); cp = fma(cp, r2, -0.5); cp = fma(cp, r2, 1.0);
    s = (q == 0) ? sp : (q == 1) ? cp : (q == 2) ? -sp : -cp;
    c = (q == 0) ? cp : (q == 1) ? -sp : (q == 2) ? -cp : sp;
}
__device__ __forceinline__ void ssm_abar(const float* a_re, const float* a_im, const float* log_dt, int g, int p, double& er, double& ei, double& ar, double& ai) {
    const double dt = (double)expf(log_dt[g]); ar = (double)a_re[g * SP + p]; ai = (double)a_im[g * SP + p];
    const double x = dt * ar;
    double mag = 1.0 / 362880.0; mag = fma(mag, x, 1.0 / 40320.0); mag = fma(mag, x, 1.0 / 5040.0); mag = fma(mag, x, 1.0 / 720.0); mag = fma(mag, x, 1.0 / 120.0); mag = fma(mag, x, 1.0 / 24.0); mag = fma(mag, x, 1.0 / 6.0); mag = fma(mag, x, 0.5); mag = fma(mag, x, 1.0); mag = fma(mag, x, 1.0);
    double s, c; sincos_d(dt * ai, s, c); er = mag * c; ei = mag * s;
}

#define XB_TMO      128
#define XB_XCNT(j)  (256  + 64 * (j))
#define XB_XSUB(j)  (1280 + 64 * (j))
#define XB_XGEN(j)  (2304 + 64 * (j))
#define XB_TOP      3328
#define XB_TOPGEN   3392
#define XCD_BAR_WORDS 3456
#define XB_SPIN_CAP (1u << 18)

__device__ __forceinline__ unsigned xb_ld(unsigned* p)              { return __hip_atomic_load(p, __ATOMIC_RELAXED, __HIP_MEMORY_SCOPE_AGENT); }
__device__ __forceinline__ unsigned xb_add(unsigned* p, unsigned v) { return __hip_atomic_fetch_add(p, v, __ATOMIC_RELAXED, __HIP_MEMORY_SCOPE_AGENT); }
__device__ __forceinline__ unsigned xb_xcc_id() { return (unsigned)__builtin_amdgcn_s_getreg((3 << 11) | 20) & 0xFu; }
#define XB_SPIN(cond, bar) do { unsigned _sp = 0; while (cond) { __builtin_amdgcn_s_sleep(1); \
    if ((++_sp & 255u) == 0u) { if (xb_ld(&(bar)[XB_TMO])) break; if (_sp > XB_SPIN_CAP) { atomicAdd(&(bar)[XB_TMO], 1u); break; } } } } while (0)

struct XcdBarrier {
    unsigned* bar; unsigned x;
    volatile LAS unsigned* st;
};

__device__ __forceinline__ XcdBarrier xcd_barrier_post(unsigned* bar, volatile LAS unsigned* st) {
    XcdBarrier b; b.bar = bar; b.x = xb_xcc_id(); b.st = st;
    if (threadIdx.x == 0) (void)xb_add(&bar[XB_XCNT(b.x)], 1u);
    return b;
}
__device__ __forceinline__ void xcd_barrier_complete(unsigned* bar, unsigned x, unsigned& nloc, unsigned& nx) {
    const unsigned G = gridDim.x * gridDim.y * gridDim.z;
    unsigned sum, cnt, mine, sp = 0u;
    for (;;) {
        sum = 0u; cnt = 0u; mine = 0u;
#pragma unroll
        for (unsigned j = 0; j < 16; ++j) { const unsigned c = xb_ld(&bar[XB_XCNT(j)]); sum += c; cnt += (c > 0u) ? 1u : 0u; mine = (j == x) ? c : mine; }
        if (sum == G) break;
        __builtin_amdgcn_s_sleep(1);
        if ((++sp & 255u) == 0u) { if (xb_ld(&bar[XB_TMO])) break; if (sp > XB_SPIN_CAP) { atomicAdd(&bar[XB_TMO], 1u); break; } }
    }
    nloc = mine > 0u ? mine : 1u; nx = cnt > 0u ? cnt : 1u;
}

__device__ __forceinline__ void xcd_barrier(const XcdBarrier& b) {
    asm volatile("s_waitcnt vmcnt(0)" ::: "memory");
    __syncthreads();
    if (threadIdx.x == 0) {
        unsigned* bar = b.bar;
        __builtin_amdgcn_s_waitcnt(0);
        unsigned nloc = b.st[0], nx = b.st[1];
        if (nloc == 0u) { xcd_barrier_complete(bar, b.x, nloc, nx); b.st[0] = nloc; b.st[1] = nx; }
        const unsigned old = xb_add(&bar[XB_XSUB(b.x)], 1u);
        const unsigned gen = old / nloc;
        if (old + 1u == (gen + 1u) * nloc) {
            __builtin_amdgcn_fence(__ATOMIC_RELEASE, "agent");
            asm volatile("s_waitcnt vmcnt(0)" ::: "memory");
            const unsigned og = xb_add(&bar[XB_TOP], 1u);
            const unsigned tg = og / nx;
            if (og + 1u == (tg + 1u) * nx) xb_add(&bar[XB_TOPGEN], 1u);
            else XB_SPIN(xb_ld(&bar[XB_TOPGEN]) == tg, bar);
            __builtin_amdgcn_fence(__ATOMIC_ACQUIRE, "agent");
            xb_add(&bar[XB_XGEN(b.x)], 1u);
            asm volatile("s_waitcnt vmcnt(0)" ::: "memory");
        } else {
            XB_SPIN(xb_ld(&bar[XB_TOPGEN]) == gen, bar);
            __builtin_amdgcn_fence(__ATOMIC_ACQUIRE, "agent");
            asm volatile("s_waitcnt vmcnt(0)" ::: "memory");
        }
    }
    __syncthreads();
}

struct Args { const float* in[25]; float* out; unsigned char* ws; int ph_lo, ph_hi; };
static_assert(sizeof(Args) == 25 * 8 + 8 + 8 + 8, "Args has no padding");

__global__ void __launch_bounds__(NTHR, 2) fwd_megakernel(Args args) {
    extern __shared__ __attribute__((aligned(16))) unsigned char lds_raw[];
    LAS unsigned char* lds = (LAS unsigned char*)lds_raw;
    const int tid = threadIdx.x, lane = tid & 63, wave = __builtin_amdgcn_readfirstlane(tid >> 6);
    const int G = gridDim.x, bid = blockIdx.x;
    const int gw = bid * NWAVES + wave, NGW = G * NWAVES;
    unsigned char* ws = args.ws;
    const float* x = args.in[0]; const float* cvec = args.in[1]; const float* w_ada = args.in[2]; const float* b_ada = args.in[3]; const float* n1g = args.in[4];
    const float* w_in = args.in[5]; const float* conv_w = args.in[6]; const float* conv_b = args.in[7]; const float* cln_g = args.in[8]; const float* cln_b = args.in[9];
    const float* conv_proj = args.in[10]; const float* a_re = args.in[11]; const float* a_im = args.in[12]; const float* b_re = args.in[13]; const float* b_im = args.in[14];
    const float* c_re = args.in[15]; const float* c_im = args.in[16]; const float* ssm_d = args.in[17]; const float* log_dt = args.in[18]; const float* ssm_glu = args.in[19];
    const float* w_out = args.in[20]; const float* n2g = args.in[21]; const float* w_ffn_in = args.in[22]; const float* w_ffn_out = args.in[23]; const float* final_g = args.in[24];
    float* out = args.out;
    float* MOD = (float*)(ws + WS_MOD); float* RSS1 = (float*)(ws + WS_RSS1); float* RSS2 = (float*)(ws + WS_RSS2); float* SHW = (float*)(ws + WS_SHW);
    bf16* WIN = (bf16*)(ws + WS_WIN); bf16* WCP = (bf16*)(ws + WS_WCP); bf16* WGLU = (bf16*)(ws + WS_WGLU); bf16* WOUT = (bf16*)(ws + WS_WOUT); bf16* WFI = (bf16*)(ws + WS_WFI); bf16* WFO = (bf16*)(ws + WS_WFO);
    bf16* W1T = (bf16*)(ws + WS_W1); bf16* B2T = (bf16*)(ws + WS_B2); bf16* H1 = (bf16*)(ws + WS_H1);
    bf16* UCONV = (bf16*)(ws + WS_UCONV); bf16* A2S = (bf16*)(ws + WS_A2S); bf16* SGC = (bf16*)(ws + WS_SGC); bf16* SGS = (bf16*)(ws + WS_SGS);
    bf16* ACONV = (bf16*)(ws + WS_ACONV); bf16* ASSM = (bf16*)(ws + WS_ASSM); float* SST = (float*)(ws + WS_S); bf16* MG = (bf16*)(ws + WS_MERGED); bf16* HID = (bf16*)(ws + WS_HID); bf16* X1B = (bf16*)(ws + WS_X1B);
    cg::grid_group grid = cg::this_grid();
    const int lo = args.ph_lo, hi = args.ph_hi;
    volatile LAS unsigned* bst = (volatile LAS unsigned*)(lds + RING_BYTES + 1024);
    if (tid < 2) bst[tid] = 0u;
    __syncthreads();
    XcdBarrier xbar = xcd_barrier_post((unsigned*)(ws + WS_BAR), bst);
    if (lo == 0x7fffffff) grid.sync();
#ifndef PHMASK
#define PHMASK 0xFF
#endif
#define IN(k) ((((PHMASK) >> (k)) & 1) && lo <= (k) && (k) < hi)
#define GRID_SYNC() do { xcd_barrier(xbar); } while (0)
#define SEAM(k) do { if (IN(k) && IN((k) + 1)) GRID_SYNC(); } while (0)
#define REPS(k) _Pragma("unroll 1") for (int rep_ = 0; rep_ < ((((DUP_MASK) >> (k)) & 1) ? 2 : 1); ++rep_)

    if (IN(0)) REPS(0) { if (rep_) GRID_SYNC();
        {
            LAS float* scr = (LAS float*)(lds + wave * 16384);
            constexpr int I_IN = (D / 64) * (INC / 32), I_CP = (CW / 64) * (D / 32), I_GLU = (SW / 64) * (2 * D / 32), I_OUT = (D / 64) * (D / 32), I_FI = (D / 64) * (2 * FH / 32), I_FO = (FH / 64) * (D / 32);
            constexpr int NITEMS = I_IN + I_FI;
            const int ngv = NMOD6 / 64;
            const int tw0 = (G >= 2 * ngv) ? (bid - ngv) * NWAVES + wave : gw, tnw = (G >= 2 * ngv) ? (G - ngv) * NWAVES : NGW;
            {
                float cur[32], nxt[32];
                int it = (tw0 >= 0 ? tw0 : NITEMS);
                if (it < NITEMS) { if (it < I_FI) tr_fetch(w_ffn_in, 2 * FH, it, lane, cur); else tr_fetch(w_in, INC, it - I_FI, lane, cur); }
                while (it < NITEMS) {
                    const int itn = it + tnw;
                    if (itn < NITEMS) { if (itn < I_FI) tr_fetch(w_ffn_in, 2 * FH, itn, lane, nxt); else tr_fetch(w_in, INC, itn - I_FI, lane, nxt); }
                    if (it < I_FI) tr_emit(cur, D, 2 * FH, WFI, 3, scr, it, lane); else tr_emit(cur, D, INC, WIN, 1, scr, it - I_FI, lane);
#pragma unroll
                    for (int i = 0; i < 32; ++i) cur[i] = nxt[i];
                    it = itn;
                }
            }
        }
        {
            __syncthreads();
            LAS float* red = (LAS float*)lds;
            LAS float* sc = (LAS float*)(lds + 8192);
            if (bid < NMOD6 / 64) { for (int e = tid; e < BATCH * D; e += NTHR) sc[e] = silu_f(cvec[e]); }
            __syncthreads();
            for (int it = bid; it < NMOD6 / 64; it += G) {
                const int col = it * 64 + lane; float a0 = 0.f, a1 = 0.f, a2 = 0.f, a3 = 0.f;
#pragma unroll 1
                for (int k0 = wave * 128; k0 < wave * 128 + 128; k0 += 32) { float wv[32];
#pragma unroll
                    for (int j = 0; j < 32; ++j) wv[j] = __builtin_nontemporal_load(w_ada + (size_t)(k0 + j) * NMOD6 + col);
#pragma unroll
                    for (int j = 0; j < 32; ++j) { a0 += wv[j] * sc[k0 + j]; a1 += wv[j] * sc[D + k0 + j]; a2 += wv[j] * sc[2 * D + k0 + j]; a3 += wv[j] * sc[3 * D + k0 + j]; } }
                red[(wave * 4 + 0) * 64 + lane] = a0; red[(wave * 4 + 1) * 64 + lane] = a1; red[(wave * 4 + 2) * 64 + lane] = a2; red[(wave * 4 + 3) * 64 + lane] = a3;
                __syncthreads();
                if (tid < 256) { const int b = tid >> 6, c = tid & 63; float t = b_ada[it * 64 + c];
#pragma unroll
                    for (int w = 0; w < 8; ++w) t += red[(w * 4 + b) * 64 + c];
                    __hip_atomic_store(MOD + b * NMOD6 + it * 64 + c, t, __ATOMIC_RELAXED, __HIP_MEMORY_SCOPE_AGENT); }
                asm volatile("s_waitcnt vmcnt(0)" ::: "memory");
                __syncthreads();
                if (tid == 0) __hip_atomic_fetch_add((unsigned*)(ws + WS_GCNT), 1u, __ATOMIC_RELAXED, __HIP_MEMORY_SCOPE_AGENT);
            }
        }
        {
            LAS f32x2* PW = (LAS f32x2*)(lds);
            LAS f32x2* QQ = (LAS f32x2*)(lds + 8704);
            LAS f32x2* BB = (LAS f32x2*)(lds + 9216);
            LAS f32x2* CC = (LAS f32x2*)(lds + 17408);
            LAS float* KT = (LAS float*)(lds + 25600);
            for (int it = bid; it < NG * 8; it += G) {
                const int g = it >> 3, rb = it & 7;
                __syncthreads();
                if (tid < 64) {
                    double er, ei, ar, ai; ssm_abar(a_re, a_im, log_dt, g, tid, er, ei, ar, ai);
                    const double nr = er - 1.0, ni = ei, den = ar * ar + ai * ai;
                    QQ[tid] = (f32x2){(float)((nr * ar + ni * ai) / den), (float)((ni * ar - nr * ai) / den)};
                    double pr = 1.0, pi = 0.0;
                    for (int j = 0; j <= 16; ++j) { PW[j * 64 + tid] = (f32x2){(float)pr, (float)pi}; const double t = pr * er - pi * ei; pi = pr * ei + pi * er; pr = t; }
                }
                for (int e = tid; e < 1024; e += NTHR) CC[e] = (f32x2){c_re[g * 1024 + e], c_im[g * 1024 + e]};
                __syncthreads();
                for (int e = tid; e < 1024; e += NTHR) { const f32x2 q = QQ[e >> 4]; const float br = b_re[g * 1024 + e], bi = b_im[g * 1024 + e]; BB[e] = (f32x2){q.x * br - q.y * bi, q.x * bi + q.y * br}; }
                __syncthreads();
                if (rb < 4) {
                    const int nl = 4 * rb + 4, pair = tid & 255, ho = pair >> 4, hi = pair & 15;
                    for (int j = tid >> 8; j < nl; j += 2) {
                        float s = 0.f;
                        for (int p = 0; p < 64; ++p) { const f32x2 c = CC[ho * 64 + p], w = PW[j * 64 + p], b = BB[p * 16 + hi];
                            const float cr = c.x * w.x - c.y * w.y, ci = c.x * w.y + c.y * w.x; s += cr * b.x - ci * b.y; }
                        KT[j * 256 + pair] = s;
                    }
                    __syncthreads();
                    for (int r = wave * 8; r < wave * 8 + 8; ++r) { const int n = 64 * rb + r, t = n >> 4, ho = n & 15;
#pragma unroll
                        for (int i = 0; i < 3; ++i) { const int kp = lane + 64 * i; float v[2];
#pragma unroll
                            for (int h = 0; h < 2; ++h) { const int k = 2 * kp + h;
                                if (k < 256) { const int s = k >> 4, hi = k & 15; v[h] = (s <= t) ? KT[(t - s) * 256 + ho * 16 + hi] : 0.f; }
                                else { const int p = (k - 256) & 63; const f32x2 c = CC[ho * 64 + p], w = PW[(t + 1) * 64 + p]; v[h] = (k < 320) ? (c.x * w.x - c.y * w.y) : -(c.x * w.y + c.y * w.x); } }
                            *(unsigned*)(B2T + ((size_t)(g * 256 + n) * KA2 + 2 * kp)) = cvt_pk_bf16(v[0], v[1]); } }
                } else {
                    for (int r = wave * 8; r < wave * 8 + 8; ++r) { const int n = 64 * (rb - 4) + r, p = n & 63;
#pragma unroll
                        for (int i = 0; i < 2; ++i) { const int kp = lane + 64 * i; float v[2];
#pragma unroll
                            for (int h = 0; h < 2; ++h) { const int k = 2 * kp + h, s = k >> 4, hi = k & 15; const f32x2 w = PW[(15 - s) * 64 + p], b = BB[p * 16 + hi];
                                v[h] = (n < 64) ? (w.x * b.x - w.y * b.y) : (n < 128) ? (w.x * b.y + w.y * b.x) : 0.f; }
                            *(unsigned*)(W1T + ((size_t)(g * 256 + n) * 256 + 2 * kp)) = cvt_pk_bf16(v[0], v[1]); } }
                }
            }
            __syncthreads();
        }
    }
    if (IN(0) && IN(1)) {
        if (tid == 0) { unsigned sp = 0; while (__hip_atomic_load((unsigned*)(ws + WS_GCNT), __ATOMIC_RELAXED, __HIP_MEMORY_SCOPE_AGENT) < (unsigned)(NMOD6 / 64)) { __builtin_amdgcn_s_sleep(2); if (++sp > (1u << 22)) break; }
            __builtin_amdgcn_fence(__ATOMIC_ACQUIRE, "agent"); asm volatile("s_waitcnt vmcnt(0)" ::: "memory"); }
        __syncthreads();
    }
    for (int xs_ = 0; xs_ < EXTRA_SYNCS; ++xs_) GRID_SYNC();

    if (IN(1)) REPS(1) { if (rep_) GRID_SYNC();
        for (int rb = gw * 8; rb < M; rb += NGW * 8) {
            const float* mb = MOD + (rb >> 12) * NMOD6;
            f32x4 v[8][4]; float inv[8];
#pragma unroll
            for (int q = 0; q < 8; ++q) { const f32x4* xr = (const f32x4*)(x + (size_t)(rb + q) * D) + lane;
#pragma unroll
                for (int j = 0; j < 4; ++j) v[q][j] = __builtin_nontemporal_load(xr + 64 * j); }
#pragma unroll
            for (int q = 0; q < 8; ++q) { float s = 0.f;
#pragma unroll
                for (int j = 0; j < 4; ++j) s += (v[q][j][0] * v[q][j][0] + v[q][j][1] * v[q][j][1]) + (v[q][j][2] * v[q][j][2] + v[q][j][3] * v[q][j][3]);
                inv[q] = rsqrtf(wave_sum(s) * (1.0f / D) + EPS); }
#pragma unroll
            for (int j = 0; j < 4; ++j) { const int col = lane * 4 + 256 * j;
                const f32x4 gsc = (*(const f32x4*)(n1g + col)) * (*(const f32x4*)(mb + D + col) + 1.0f), sh = *(const f32x4*)(mb + col);
#pragma unroll
                for (int q = 0; q < 8; ++q) { const f32x4 h = v[q][j] * inv[q] * gsc + sh;
                    v2u o; o.x = cvt_pk_bf16(h[0], h[1]); o.y = cvt_pk_bf16(h[2], h[3]); *(v2u*)(H1 + (size_t)(rb + q) * D + col) = o; } }
        }
    }
    SEAM(1);

    if (IN(2)) REPS(2) { if (rep_) GRID_SYNC();
        pg8::Gemm g{D, D, D}; pg8::StaticOrder S; S.init(M, INC, G, bid, H1, D, WIN, D);
        EpiIn E{UCONV, A2S, SGC, SGS};
        GEMM_CALL(EpiIn, pg8::StaticOrder)(lds, g, S, E);
        {
            constexpr int NU = (M / 256) * (INC / 256), I_CP = (CW / 64) * (D / 32), I_GLU = (SW / 64) * (2 * D / 32), I_OUT = (D / 64) * (D / 32);
            int first = NU % G, nhelp = G - first; if (first == 0) nhelp = G;
            if (bid >= first) {
                LAS float* scr = (LAS float*)(lds + wave * 16384);
                const int hw0 = (bid - first) * NWAVES + wave, hnw = nhelp * NWAVES;
                for (int it = hw0; it < I_GLU + I_OUT + I_CP; it += hnw) {
                    if (it < I_GLU) transpose_item(ssm_glu, SW, 2 * D, WGLU, 2, scr, it, lane);
                    else if (it < I_GLU + I_OUT) transpose_item(w_out, D, D, WOUT, 0, scr, it - I_GLU, lane);
                    else transpose_item(conv_proj, CW, D, WCP, 0, scr, it - I_GLU - I_OUT, lane);
                }
                for (int v = hw0; v < 2 * FH; v += hnw) {
                    const v4u w0 = *(const v4u*)(WFI + (size_t)v * D + lane * 8), w1 = *(const v4u*)(WFI + (size_t)v * D + 512 + lane * 8);
                    f32x4 a0, a1, b0, b1; unpack8(w0, a0, a1); unpack8(w1, b0, b1);
        #pragma unroll
                    for (int b = 0; b < BATCH; ++b) { const float* sh = MOD + b * NMOD6 + 3 * D;
                        const f32x4 s0 = *(const f32x4*)(sh + lane * 8), s1 = *(const f32x4*)(sh + lane * 8 + 4), s2 = *(const f32x4*)(sh + 512 + lane * 8), s3 = *(const f32x4*)(sh + 512 + lane * 8 + 4);
                        const f32x4 pr = a0 * s0 + a1 * s1 + b0 * s2 + b1 * s3; const float t = wave_sum((pr[0] + pr[1]) + (pr[2] + pr[3]));
                        if (lane == 0) SHW[b * (2 * FH) + v] = t; }
                }
            }
        }
    }
    SEAM(2);

    if (IN(3)) REPS(3) { if (rep_) GRID_SYNC();
        {
            const int cp = tid & 255, th = tid >> 8;
            LAS float* OUTT = (LAS float*)(lds + 65536);
            const bool bal = (G == 256);
            const int nmine = bal ? (bid < NG * 4 ? 0 : 4) : (M / 32 - bid + G - 1) / G;
            f32x2 w[CK];
#pragma unroll
            for (int j = 0; j < CK; ++j) w[j] = *(const f32x2*)(conv_w + j * CW + 2 * cp);
            const f32x2 bias = *(const f32x2*)(conv_b + 2 * cp);
#define CONV_ITEM(ii_) (bal ? (bid - NG * 4) * 4 + (ii_) : bid + (ii_) * G)
#define CONV_FETCH(dst, it_) do { const int t0_ = (it_) * 32, pos0_ = t0_ & (SEQ - 1); _Pragma("unroll") for (int k_ = 0; k_ < 8; ++k_) { const int e_ = tid + k_ * NTHR, r_ = e_ >> 6, ch_ = e_ & 63; v4u v_ = {0u, 0u, 0u, 0u}; \
                if (e_ < 62 * 64 && pos0_ - 30 + r_ >= 0) v_ = *(const v4u*)(UCONV + (size_t)(t0_ - 30 + r_) * CW + ch_ * 8); dst[k_] = v_; } } while (0)
            v4u pre[8];
            if (nmine > 0) CONV_FETCH(pre, CONV_ITEM(0));
            for (int ii = 0; ii < nmine; ++ii) {
                const int item = CONV_ITEM(ii);
                const int t0 = item * 32;
                __syncthreads();
#pragma unroll
                for (int k = 0; k < 8; ++k) { const int e = tid + k * NTHR; if (e < 62 * 64) *(LAS v4u*)(lds + (e >> 6) * 1024 + (e & 63) * 16) = pre[k]; }
                if (ii + 1 < nmine) CONV_FETCH(pre, CONV_ITEM(ii + 1));
                f32x2 acc[16];
#pragma unroll
                for (int q = 0; q < 16; ++q) acc[q] = bias;
                __syncthreads();
#pragma unroll
                for (int i = 0; i < 46; ++i) { const unsigned uv = *(const LAS unsigned*)(lds + (th * 16 + i) * 1024 + cp * 4); const f32x2 vv = {bf_lo(uv), bf_hi(uv)};
#pragma unroll
                    for (int q = 0; q < 16; ++q) { const int j = i - q; if (j >= 0 && j < CK) acc[q] += vv * w[j]; } }
#pragma unroll
                for (int q = 0; q < 16; ++q) *(LAS f32x2*)(OUTT + (th * 16 + q) * 512 + 2 * cp) = acc[q];
                __syncthreads();
#pragma unroll
                for (int q = 0; q < 4; ++q) { const int tt = wave * 4 + q; const LAS float* rowp = OUTT + tt * 512;
                    f32x4 a = *(const LAS f32x4*)(rowp + lane * 4), b = *(const LAS f32x4*)(rowp + 256 + lane * 4);
                    const float mu = wave_sum((a[0] + a[1]) + (a[2] + a[3]) + (b[0] + b[1]) + (b[2] + b[3])) * (1.0f / CW);
                    a -= mu; b -= mu;
                    const float var = wave_sum((a[0] * a[0] + a[1] * a[1]) + (a[2] * a[2] + a[3] * a[3]) + (b[0] * b[0] + b[1] * b[1]) + (b[2] * b[2] + b[3] * b[3])) * (1.0f / CW);
                    const float rstd = rsqrtf(var + EPS);
                    a = a * rstd * (*(const f32x4*)(cln_g + lane * 4)) + *(const f32x4*)(cln_b + lane * 4);
                    b = b * rstd * (*(const f32x4*)(cln_g + 256 + lane * 4)) + *(const f32x4*)(cln_b + 256 + lane * 4);
                    v2u o0, o1; o0.x = cvt_pk_bf16(silu_f(a[0]), silu_f(a[1])); o0.y = cvt_pk_bf16(silu_f(a[2]), silu_f(a[3])); o1.x = cvt_pk_bf16(silu_f(b[0]), silu_f(b[1])); o1.y = cvt_pk_bf16(silu_f(b[2]), silu_f(b[3]));
                    bf16* dst = ACONV + (size_t)(t0 + tt) * CW; *(v2u*)(dst + lane * 4) = o0; *(v2u*)(dst + 256 + lane * 4) = o1; }
            }
            __syncthreads();
        }
        if (bid < NG * 4) {
            const int L = bid, g = L >> 2, b = L & 3;
            {
                pg8::Gemm gg{256, KA2, 256}; BatchOrder S{4, NG * 4, 1 << 20, L, (const char*)A2S, (const char*)W1T, (size_t)NCH * KA2 * 2, (size_t)256 * KA2 * 2, (size_t)256 * 256 * 2};
                EpiStateLds E{};
                GEMM_CALL(EpiStateLds, BatchOrder)(lds, gg, S, E);
            }
            __syncthreads();
            {
                double er, ei, ar, ai; ssm_abar(a_re, a_im, log_dt, g, lane, er, ei, ar, ai);
#pragma unroll
                for (int j = 0; j < 4; ++j) { const double t = er * er - ei * ei; ei = 2.0 * er * ei; er = t; }
                const float alr = (float)er, ali = (float)ei;
#pragma unroll
                for (int j = 0; j < 5; ++j) { const double t = er * er - ei * ei; ei = 2.0 * er * ei; er = t; }
                const float a32r = (float)er, a32i = (float)ei;
                const LAS float* sl = (const LAS float*)lds + wave * 32 * 128; LAS f32x2* EE = (LAS f32x2*)(lds + RING_BYTES + 2048);
                float xr = 0.f, xi = 0.f;
#pragma unroll 8
                for (int c = 0; c < 32; ++c) { const float sr = sl[c * 128 + lane], si = sl[c * 128 + 64 + lane]; const float nr = alr * xr - ali * xi + sr, ni = alr * xi + ali * xr + si; xr = nr; xi = ni; }
                EE[wave * 64 + lane] = (f32x2){xr, xi};
                __syncthreads();
                xr = 0.f; xi = 0.f;
                for (int v = 0; v < wave; ++v) { const f32x2 e = EE[v * 64 + lane]; const float nr = a32r * xr - a32i * xi + e.x, ni = a32r * xi + a32i * xr + e.y; xr = nr; xi = ni; }
                bf16* dst = A2S + (size_t)(g * NCH + b * CPB + wave * 32) * KA2 + 256 + lane;
#pragma unroll 8
                for (int c = 0; c < 32; ++c) {
                    const unsigned pk = cvt_pk_bf16(xr, xi); dst[(size_t)c * KA2] = (bf16)(pk & 0xffffu); dst[(size_t)c * KA2 + 64] = (bf16)(pk >> 16);
                    const float sr = sl[c * 128 + lane], si = sl[c * 128 + 64 + lane];
                    const float nr = alr * xr - ali * xi + sr, ni = alr * xi + ali * xr + si; xr = nr; xi = ni;
                }
            }
            asm volatile("s_waitcnt vmcnt(0)" ::: "memory");
            __syncthreads();
            {
                pg8::Gemm gg{KA2, KA2, KA2}; BatchOrder S{4, NG * 4, 1 << 20, L, (const char*)A2S, (const char*)B2T, (size_t)NCH * KA2 * 2, (size_t)256 * KA2 * 2, (size_t)256 * KA2 * 2};
                EpiSsmOut E{A2S, ssm_d, ASSM};
                GEMM_CALL(EpiSsmOut, BatchOrder)(lds, gg, S, E);
            }
        }
    }
    SEAM(3);

    if (IN(4)) REPS(4) { if (rep_) GRID_SYNC();
        pg8::Gemm g{SW, SW, SW}; TripleOrder S; S.base.init(M, D, G, bid, ACONV, CW, WCP, CW); S.A1 = (const char*)ASSM; S.B1 = (const char*)WGLU; S.tsA = (size_t)256 * SW * 2; S.tsB = (size_t)256 * SW * 2;
        EpiMix E{SGC, SGS, MG};
        GEMM_CALL(EpiMix, TripleOrder)(lds, g, S, E);
    }
    SEAM(4);

    if (IN(5)) REPS(5) { if (rep_) GRID_SYNC();
        pg8::Gemm g{D, D, D}; pg8::StaticOrder S; S.init(M, D, G, bid, MG, D, WOUT, D);
        EpiOut E{x, MOD, n2g, X1B, H1, RSS1};
        GEMM_CALL(EpiOut, pg8::StaticOrder)(lds, g, S, E);
    }
    SEAM(5);

    if (IN(6)) REPS(6) { if (rep_) GRID_SYNC();
        pg8::Gemm g{D, D, D}; pg8::StaticOrder S; S.init(M, 2 * FH, G, bid, H1, D, WFI, D);
        EpiFfnIn E{RSS1, SHW, HID};
        GEMM_CALL(EpiFfnIn, pg8::StaticOrder)(lds, g, S, E);
        {
            constexpr int NU = (M / 256) * (2 * FH / 256), I_FO = (FH / 64) * (D / 32);
            int first = NU % G, nhelp = G - first; if (first == 0) nhelp = G;
            if (bid >= first) {
                LAS float* scr = (LAS float*)(lds + wave * 16384);
                for (int it = (bid - first) * NWAVES + wave; it < I_FO; it += nhelp * NWAVES) transpose_item(w_ffn_out, FH, D, WFO, 0, scr, it, lane);
            }
        }
    }
    SEAM(6);

    if (IN(7)) REPS(7) { if (rep_) GRID_SYNC();
        pg8::Gemm g{FH, FH, FH}; pg8::StaticOrder S; S.init(M, D, G, bid, HID, FH, WFO, FH);
        EpiFfnOut E{MOD, final_g, n2g, H1, out, RSS2, (unsigned*)(ws + WS_PCNT)};
        GEMM_CALL(EpiFfnOut, pg8::StaticOrder)(lds, g, S, E);
    }

#undef IN
#undef SEAM
}

extern "C" void kernel_launch(void* const* d_in, const int* in_sizes, int n_in, void* d_out, int out_size, void* d_ws, size_t ws_size, hipStream_t stream) {
    static int grid = 0;
    if (grid == 0) {
        if (n_in != 25 || out_size != M * D || ws_size < WS_END) { fprintf(stderr, "kernel_launch: unexpected shapes (n_in %d out %d ws %zu)\n", n_in, out_size, ws_size); grid = -1; return; }
        int dev = 0, cus = 0, per_cu = 0;
        (void)hipGetDevice(&dev); (void)hipDeviceGetAttribute(&cus, hipDeviceAttributeMultiprocessorCount, dev);
        if (hipFuncSetAttribute((const void*)fwd_megakernel, hipFuncAttributeMaxDynamicSharedMemorySize, LDS_BYTES) != hipSuccess) { fprintf(stderr, "kernel_launch: hipFuncSetAttribute failed\n"); grid = -1; return; }
        if (hipOccupancyMaxActiveBlocksPerMultiprocessor(&per_cu, (const void*)fwd_megakernel, NTHR, LDS_BYTES) != hipSuccess || per_cu < 1) { fprintf(stderr, "kernel_launch: occupancy query failed (%d)\n", per_cu); (void)hipGetLastError(); per_cu = 1; }
        grid = cus * (per_cu > 1 ? 1 : per_cu);
        if (grid <= 0) grid = 256;
    }
    if (grid < 0) return;
    (void)hipMemsetAsync((char*)d_ws + WS_BAR, 0, BAR_BYTES, stream);
    Args a{};
    for (int i = 0; i < 25; ++i) a.in[i] = (const float*)d_in[i];
    a.out = (float*)d_out; a.ws = (unsigned char*)d_ws;
#if MK_PER_PHASE
    for (int ph = 0; ph < NPHASE; ++ph) { a.ph_lo = ph; a.ph_hi = ph + 1; hipLaunchKernelGGL(fwd_megakernel, dim3(grid), dim3(NTHR), LDS_BYTES, stream, a); }
#else
    a.ph_lo = 0; a.ph_hi = NPHASE;
    void* kargs[] = {&a};
    hipError_t e = hipLaunchCooperativeKernel((const void*)fwd_megakernel, dim3(grid), dim3(NTHR), kargs, LDS_BYTES, stream);
    if (e != hipSuccess) fprintf(stderr, "kernel_launch: cooperative launch failed: %s (grid %d)\n", hipGetErrorString(e), grid);
#endif
}
```

```cpp
#include <hip/hip_runtime.h>
#include <hip/hip_cooperative_groups.h>
#include <cstdio>
#include <cstdint>
namespace cg = cooperative_groups;
#define PG8_ALIGN true
#define PG8_SP2 true
#ifndef DUP_MASK
#define DUP_MASK 0x000
#endif
#ifndef EXTRA_SYNCS
#define EXTRA_SYNCS 0
#endif
#ifndef GEMM_SIMPLE
#define GEMM_SIMPLE 0
#endif
#if GEMM_SIMPLE
#define GEMM_CALL(E_, S_) pg8::gemm_simple<E_, S_>
#else
#define GEMM_CALL(E_, S_) pg8::gemm_phase<E_, S_, PG8_ALIGN, PG8_SP2>
#endif
#ifndef MK_PER_PHASE
#define MK_PER_PHASE 0
#endif
namespace pg8 {
#define PG8_LAS __attribute__((address_space(3)))
typedef unsigned short bf16_t;
typedef short bf16x8 __attribute__((ext_vector_type(8)));
typedef float f32x4 __attribute__((ext_vector_type(4)));
typedef unsigned u32x4 __attribute__((ext_vector_type(4)));
constexpr int BM = 256, BK = 64, HALF = 128, HTB = HALF * BK * 2  , STAGE_BYTES = 8 * HTB, NXCD = 8, WGM = 8;

__host__ __device__ __forceinline__ int lds_byte(int r, int c) { const int st = (r >> 4) * 2 + (c >> 5), rr = r & 15, cc = c & 31, ob = rr * 64 + cc * 2; return st * 1024 + (ob ^ (((ob >> 9) & 1) << 5)); }
__host__ __device__ __forceinline__ void stage_rc(int b, int& R, int& C) { const int st = b / 1024, sb = b % 1024, swz = sb ^ (((sb >> 9) & 1) << 5); R = (st >> 1) * 16 + swz / 64; C = (st & 1) * 32 + (swz % 64) / 2; }
__host__ __device__ __forceinline__ int perm32(int rho) { const int n = rho >> 4, i = rho & 15; return 8 * (i >> 2) + 4 * n + (i & 3); }

struct Unit { int pm, pn, z; };
struct Gemm { int K, lda, ldb; };

struct StaticOrder {
    int nM, nN, nwg, G, c; const char* A; const char* B; size_t tsA, tsB;
    __host__ __device__ void init(int M, int N, int G_, int c_, const void* A_, int lda, const void* B_, int ldb) { nM = M / BM; nN = N / BM; nwg = nM * nN; G = G_; c = c_; A = (const char*)A_; B = (const char*)B_; tsA = (size_t)BM * lda * 2; tsB = (size_t)BM * ldb * 2; }
    __device__ __forceinline__ const char* pa(const Unit& u) const { return A + (size_t)u.pm * tsA; }
    __device__ __forceinline__ const char* pb(const Unit& u) const { return B + (size_t)u.pn * tsB; }
    __host__ __device__ bool next(int i, Unit& u) const {
        const long L = (long)i * G + c; if (L >= nwg) return false;
        int wgid = (int)L; { const int q = nwg / NXCD, r = nwg % NXCD, xcd = wgid % NXCD, off = wgid / NXCD; wgid = (xcd < r ? xcd * (q + 1) : r * (q + 1) + (xcd - r) * q) + off; }
        const int nig = WGM * nN, gid = wgid / nig, fm = gid * WGM, gsz = (nM - fm) < WGM ? (nM - fm) : WGM;
        u.pm = fm + ((wgid % nig) % gsz); u.pn = (wgid % nig) / gsz; u.z = 0; return true;
    }
    __device__ __forceinline__ void a_ready(const Unit&) const {}
    __device__ __forceinline__ void done(const Unit&) const {}
};

__device__ __forceinline__ unsigned cvt_pk_bf16(float lo, float hi) { unsigned r; asm volatile("s_nop 1\n\tv_cvt_pk_bf16_f32 %0, %1, %2" : "=v"(r) : "v"(lo), "v"(hi)); return r; }
template <class Epi, class Sched, bool ALIGN_EPI = false, bool SP2 = false>
__device__ __forceinline__ void gemm_phase(PG8_LAS unsigned char* lds, const Gemm g, const Sched& S, const Epi& E) {
    const int tid = threadIdx.x, wid = __builtin_amdgcn_readfirstlane(tid >> 6), lane = tid & 63, wr = wid >> 2, wc = wid & 3, fr = lane & 15, fq = lane >> 4;
    const int K = g.K, nt = K / BK;
    unsigned voffA[2], voffB[2];
#pragma unroll
    for (int i = 0; i < 2; ++i) { int R, C; stage_rc(tid * 16 + i * 8192, R, C); const int Rb = Epi::PERM ? ((R & ~31) + perm32(R & 31)) : R;
        voffA[i] = (unsigned)(R * g.lda + C) * 2u; voffB[i] = (unsigned)(Rb * g.ldb + C) * 2u; }
    const size_t kstep = (size_t)(BK * 2);
    const size_t hstepA = (size_t)HALF * g.lda * 2, hstepB = (size_t)HALF * g.ldb * 2;
    const unsigned ldsw = (unsigned)wid * 1024u;
    const int aoff = lds_byte(wr * 64 + fr, fq * 8), boff = lds_byte(wc * 32 + fr, fq * 8);
#define PG8_SA(b, h) (((b) * 2 + (h)) * HTB)
#define PG8_SB(b, h) ((4 + (b) * 2 + (h)) * HTB)
#define PG8_STAGE(bufoff, gbase, voff) do { _Pragma("unroll") for (int _i = 0; _i < 2; ++_i) \
        __builtin_amdgcn_global_load_lds((const unsigned*)((const char*)(gbase) + (voff)[_i]), (PG8_LAS unsigned*)(lds + (bufoff) + ldsw + _i * 8192), 16, 0, 0); } while (0)
#define PG8_LDA(dst, b, h) do { _Pragma("unroll") for (int m = 0; m < 4; ++m) _Pragma("unroll") for (int k = 0; k < 2; ++k) dst[m][k] = *(const PG8_LAS bf16x8*)(lds + PG8_SA(b, h) + aoff + m * 2048 + k * 1024); } while (0)
#define PG8_LDB(dst, b, h) do { _Pragma("unroll") for (int n = 0; n < 2; ++n) _Pragma("unroll") for (int k = 0; k < 2; ++k) dst[n][k] = *(const PG8_LAS bf16x8*)(lds + PG8_SB(b, h) + boff + n * 2048 + k * 1024); } while (0)
#define PG8_MMA(ai, bj, At, Bt) do { __builtin_amdgcn_s_setprio(1); _Pragma("unroll") for (int m = 0; m < 4; ++m) _Pragma("unroll") for (int n = 0; n < 2; ++n) _Pragma("unroll") for (int k = 0; k < 2; ++k) \
        acc[ai][bj][m][n] = __builtin_amdgcn_mfma_f32_16x16x32_bf16(Bt[n][k], At[m][k], acc[ai][bj][m][n], 0, 0, 0); __builtin_amdgcn_s_setprio(0); } while (0)
#define PG8_WAIT_V(n) asm volatile("s_waitcnt vmcnt(" #n ")" ::: "memory")
#define PG8_WAIT_L(n) asm volatile("s_waitcnt lgkmcnt(" #n ")" ::: "memory")
#define PG8_BAR __builtin_amdgcn_s_barrier()
#define PG8_SCHED __builtin_amdgcn_sched_barrier(0)
    Unit cur, nxt; int ui = 0;
    if (!S.next(0, cur)) return;
    f32x4 acc[2][2][4][2];
#pragma unroll
    for (int a = 0; a < 2; ++a)
#pragma unroll
        for (int b = 0; b < 2; ++b)
#pragma unroll
            for (int m = 0; m < 4; ++m)
#pragma unroll
                for (int n = 0; n < 2; ++n) acc[a][b][m][n] = (f32x4){0.f, 0.f, 0.f, 0.f};
    bf16x8 At[4][2], B0[2][2], B1[2][2];
    const char* cA = S.pa(cur); const char* cB = S.pb(cur);
    S.a_ready(cur);
    if constexpr (SP2) {
        PG8_STAGE(PG8_SB(0, 0), cB, voffB); PG8_STAGE(PG8_SB(0, 1), cB + hstepB, voffB); PG8_STAGE(PG8_SA(0, 0), cA, voffA); PG8_STAGE(PG8_SA(0, 1), cA + hstepA, voffA);
        if (wr == 1) PG8_BAR;
        PG8_WAIT_V(2); PG8_BAR;
        PG8_STAGE(PG8_SB(1, 0), cB + kstep, voffB); PG8_STAGE(PG8_SA(1, 0), cA + kstep, voffA); PG8_STAGE(PG8_SB(1, 1), cB + hstepB + kstep, voffB);
        PG8_WAIT_V(6); PG8_BAR;
    } else {
        PG8_STAGE(PG8_SB(0, 0), cB, voffB); PG8_STAGE(PG8_SA(0, 0), cA, voffA); PG8_STAGE(PG8_SB(0, 1), cB + hstepB, voffB); PG8_STAGE(PG8_SA(0, 1), cA + hstepA, voffA);
        if (wr == 1) PG8_BAR;
        PG8_WAIT_V(4); PG8_BAR;
        PG8_STAGE(PG8_SB(1, 0), cB + kstep, voffB); PG8_STAGE(PG8_SA(1, 0), cA + kstep, voffA); PG8_STAGE(PG8_SB(1, 1), cB + hstepB + kstep, voffB);
        PG8_WAIT_V(6); PG8_BAR;
    }
    for (;;) {
        const bool has_next = S.next(ui + 1, nxt);
        const char* nA = has_next ? S.pa(nxt) : cA; const char* nB = has_next ? S.pb(nxt) : cB;
#pragma unroll 1
        for (int t = 0; t < nt; t += 2) {
            const bool last = (t == nt - 2);
            const char* a1 = cA + (size_t)(t + 1) * kstep;
            const char* a2 = last ? nA : cA + (size_t)(t + 2) * kstep; const char* b2 = last ? nB : cB + (size_t)(t + 2) * kstep;
            const char* a3 = a2 + kstep; const char* b3 = b2 + kstep;
            if (last && has_next) S.a_ready(nxt);
            if constexpr (SP2) {
            PG8_LDB(B0, 0, 0); PG8_LDB(B1, 0, 1); PG8_SCHED; PG8_LDA(At, 0, 0); PG8_STAGE(PG8_SA(1, 1), a1 + hstepA, voffA);
            PG8_WAIT_V(8); PG8_WAIT_L(0); PG8_BAR; PG8_MMA(0, 0, At, B0); if constexpr (!Epi::HALF_N) PG8_MMA(0, 1, At, B1); PG8_BAR; PG8_SCHED;
            PG8_LDA(At, 0, 1); PG8_STAGE(PG8_SB(0, 0), b2, voffB); PG8_STAGE(PG8_SB(0, 1), b2 + hstepB, voffB); PG8_STAGE(PG8_SA(0, 0), a2, voffA);
            PG8_WAIT_V(8); PG8_WAIT_L(0); PG8_BAR; PG8_MMA(1, 0, At, B0); if constexpr (!Epi::HALF_N) PG8_MMA(1, 1, At, B1); PG8_BAR; PG8_SCHED;
            PG8_LDB(B0, 1, 0); PG8_LDB(B1, 1, 1); PG8_SCHED; PG8_LDA(At, 1, 0); PG8_STAGE(PG8_SA(0, 1), a2 + hstepA, voffA);
            PG8_WAIT_V(8); PG8_WAIT_L(0); PG8_BAR; PG8_MMA(0, 0, At, B0); if constexpr (!Epi::HALF_N) PG8_MMA(0, 1, At, B1); PG8_BAR; PG8_SCHED;
            PG8_LDA(At, 1, 1); PG8_STAGE(PG8_SB(1, 0), b3, voffB); PG8_STAGE(PG8_SB(1, 1), b3 + hstepB, voffB); PG8_STAGE(PG8_SA(1, 0), a3, voffA);
            PG8_WAIT_V(8); PG8_WAIT_L(0); PG8_BAR; PG8_MMA(1, 0, At, B0); if constexpr (!Epi::HALF_N) PG8_MMA(1, 1, At, B1); PG8_BAR; PG8_SCHED;
            } else {
            PG8_LDB(B0, 0, 0); PG8_SCHED; PG8_LDA(At, 0, 0); PG8_STAGE(PG8_SA(1, 1), a1 + hstepA, voffA);
            PG8_WAIT_L(8); PG8_BAR; PG8_WAIT_L(0); PG8_MMA(0, 0, At, B0); PG8_BAR; PG8_SCHED;
            PG8_LDB(B1, 0, 1); PG8_STAGE(PG8_SB(0, 0), b2, voffB);
            PG8_BAR; PG8_WAIT_L(0); PG8_MMA(0, 1, At, B1); PG8_BAR;
            PG8_LDA(At, 0, 1); PG8_STAGE(PG8_SA(0, 0), a2, voffA);
            PG8_BAR; PG8_WAIT_L(0); PG8_MMA(1, 0, At, B0); PG8_BAR; PG8_SCHED;
            PG8_STAGE(PG8_SB(0, 1), b2 + hstepB, voffB);
            PG8_WAIT_V(6); PG8_BAR; PG8_MMA(1, 1, At, B1); PG8_BAR;
            PG8_LDB(B0, 1, 0); PG8_SCHED; PG8_LDA(At, 1, 0); PG8_STAGE(PG8_SA(0, 1), a2 + hstepA, voffA);
            PG8_WAIT_L(8); PG8_BAR; PG8_WAIT_L(0); PG8_MMA(0, 0, At, B0); PG8_BAR; PG8_SCHED;
            PG8_LDB(B1, 1, 1); PG8_STAGE(PG8_SB(1, 0), b3, voffB);
            PG8_BAR; PG8_WAIT_L(0); PG8_MMA(0, 1, At, B1); PG8_BAR;
            PG8_LDA(At, 1, 1); PG8_STAGE(PG8_SA(1, 0), a3, voffA);
            PG8_BAR; PG8_WAIT_L(0); PG8_MMA(1, 0, At, B0); PG8_BAR; PG8_SCHED;
            PG8_STAGE(PG8_SB(1, 1), b3 + hstepB, voffB);
            PG8_WAIT_V(6); PG8_BAR; PG8_MMA(1, 1, At, B1); PG8_BAR;
            }
        }
        if constexpr (ALIGN_EPI) { if (wr == 0) PG8_BAR; }
        if constexpr (!Epi::AFTER_DRAIN) { E(acc, cur, wr, wc, fr, fq); S.done(cur); }
        if (!has_next) break;
#pragma unroll
        for (int a = 0; a < 2; ++a)
#pragma unroll
            for (int b = 0; b < 2; ++b)
#pragma unroll
                for (int m = 0; m < 4; ++m)
#pragma unroll
                    for (int n = 0; n < 2; ++n) acc[a][b][m][n] = (f32x4){0.f, 0.f, 0.f, 0.f};
        cur = nxt; cA = nA; cB = nB; ++ui;
        if constexpr (ALIGN_EPI) { if (wr == 1) PG8_BAR; }
    }
    PG8_WAIT_V(0);
    if constexpr (!ALIGN_EPI) { if (wr == 0) PG8_BAR; }
    PG8_BAR;
    if constexpr (Epi::AFTER_DRAIN) { E.fused(acc, cur, wr, wc, fr, fq, lds, wid, lane); S.done(cur); }
#undef PG8_SA
#undef PG8_SB
#undef PG8_STAGE
#undef PG8_LDA
#undef PG8_LDB
#undef PG8_MMA
#undef PG8_WAIT_V
#undef PG8_WAIT_L
#undef PG8_BAR
#undef PG8_SCHED
}

template <class Epi, class Sched>
__device__ __forceinline__ void gemm_simple(PG8_LAS unsigned char* lds, const Gemm g, const Sched& S, const Epi& E) {
    const int tid = threadIdx.x, wid = __builtin_amdgcn_readfirstlane(tid >> 6), lane = tid & 63, wr = wid >> 2, wc = wid & 3, fr = lane & 15, fq = lane >> 4;
    const int nt = g.K / BK;
    unsigned voffA[2], voffB[2];
#pragma unroll
    for (int i = 0; i < 2; ++i) { int R, C; stage_rc(tid * 16 + i * 8192, R, C); const int Rb = Epi::PERM ? ((R & ~31) + perm32(R & 31)) : R;
        voffA[i] = (unsigned)(R * g.lda + C) * 2u; voffB[i] = (unsigned)(Rb * g.ldb + C) * 2u; }
    const size_t kstep = (size_t)(BK * 2), hstepA = (size_t)HALF * g.lda * 2, hstepB = (size_t)HALF * g.ldb * 2;
    const unsigned ldst = (unsigned)tid * 16u;
    const int aoff = lds_byte(wr * 64 + fr, fq * 8), boff = lds_byte(wc * 32 + fr, fq * 8);
#define SG_SA(b, h) (((b) * 2 + (h)) * HTB)
#define SG_SB(b, h) ((4 + (b) * 2 + (h)) * HTB)
#define SG_LDB(dst, b, h) do { _Pragma("unroll") for (int n = 0; n < 2; ++n) _Pragma("unroll") for (int k = 0; k < 2; ++k) dst[n][k] = *(const PG8_LAS bf16x8*)(lds + SG_SB(b, h) + boff + n * 2048 + k * 1024); } while (0)
#define SG_AFRAG(b, st, k) (*(const PG8_LAS bf16x8*)(lds + SG_SA(b, (st) >> 2) + aoff + ((st) & 3) * 2048 + (k) * 1024))
#define SG_AHALF(b, ai) do { bf16x8 c0 = SG_AFRAG(b, (ai) * 4, 0), c1 = SG_AFRAG(b, (ai) * 4, 1); \
        _Pragma("unroll") for (int m = 0; m < 4; ++m) { bf16x8 n0 = c0, n1 = c1; \
            if (m < 3) { n0 = SG_AFRAG(b, (ai) * 4 + m + 1, 0); n1 = SG_AFRAG(b, (ai) * 4 + m + 1, 1); } \
            __builtin_amdgcn_sched_barrier(0); \
            _Pragma("unroll") for (int n = 0; n < 2; ++n) { \
                acc[ai][0][m][n] = __builtin_amdgcn_mfma_f32_16x16x32_bf16(B0[n][0], c0, acc[ai][0][m][n], 0, 0, 0); acc[ai][0][m][n] = __builtin_amdgcn_mfma_f32_16x16x32_bf16(B0[n][1], c1, acc[ai][0][m][n], 0, 0, 0); \
                acc[ai][1][m][n] = __builtin_amdgcn_mfma_f32_16x16x32_bf16(B1[n][0], c0, acc[ai][1][m][n], 0, 0, 0); acc[ai][1][m][n] = __builtin_amdgcn_mfma_f32_16x16x32_bf16(B1[n][1], c1, acc[ai][1][m][n], 0, 0, 0); } \
            __builtin_amdgcn_sched_barrier(0); c0 = n0; c1 = n1; } } while (0)
#define SG_LOADA(t) do { _Pragma("unroll") for (int h = 0; h < 2; ++h) _Pragma("unroll") for (int i = 0; i < 2; ++i) rr[h][i] = *(const u32x4*)(cA + h * hstepA + (size_t)(t) * kstep + voffA[i]); } while (0)
#define SG_LOADB(t) do { _Pragma("unroll") for (int h = 0; h < 2; ++h) _Pragma("unroll") for (int i = 0; i < 2; ++i) rr[h][i] = *(const u32x4*)(cB + h * hstepB + (size_t)(t) * kstep + voffB[i]); } while (0)
#define SG_STOREA(b) do { _Pragma("unroll") for (int h = 0; h < 2; ++h) _Pragma("unroll") for (int i = 0; i < 2; ++i) *(PG8_LAS u32x4*)(lds + SG_SA(b, h) + i * 8192 + ldst) = rr[h][i]; } while (0)
#define SG_STOREB(b) do { _Pragma("unroll") for (int h = 0; h < 2; ++h) _Pragma("unroll") for (int i = 0; i < 2; ++i) *(PG8_LAS u32x4*)(lds + SG_SB(b, h) + i * 8192 + ldst) = rr[h][i]; } while (0)
#define SG_KTILE(b, tn, more) do { bf16x8 B0[2][2], B1[2][2]; if (more) SG_LOADA(tn); SG_LDB(B0, b, 0); SG_LDB(B1, b, 1); SG_AHALF(b, 0); \
        if (more) { SG_STOREA((b) ^ 1); SG_LOADB(tn); } SG_AHALF(b, 1); if (more) SG_STOREB((b) ^ 1); __syncthreads(); } while (0)
    Unit cur;
    for (int ui = 0; S.next(ui, cur); ++ui) {
        f32x4 acc[2][2][4][2];
#pragma unroll
        for (int a = 0; a < 2; ++a)
#pragma unroll
            for (int b = 0; b < 2; ++b)
#pragma unroll
                for (int m = 0; m < 4; ++m)
#pragma unroll
                    for (int n = 0; n < 2; ++n) acc[a][b][m][n] = (f32x4){0.f, 0.f, 0.f, 0.f};
        const char* cA = S.pa(cur); const char* cB = S.pb(cur);
        u32x4 rr[2][2];
        __syncthreads();
        SG_LOADA(0); SG_STOREA(0); SG_LOADB(0); SG_STOREB(0);
        __syncthreads();
#pragma unroll 1
        for (int t = 0; t < nt; t += 2) {
            SG_KTILE(0, t + 1, true);
            const bool more = (t + 2 < nt);
            SG_KTILE(1, t + 2, more);
        }
        E(acc, cur, wr, wc, fr, fq);
    }
#undef SG_SA
#undef SG_SB
#undef SG_LDB
#undef SG_AFRAG
#undef SG_AHALF
#undef SG_LOADA
#undef SG_LOADB
#undef SG_STOREA
#undef SG_STOREB
#undef SG_KTILE
}
}

constexpr int BATCH = 4, SEQ = 4096, D = 1024, M = BATCH * SEQ;
constexpr int CW = 512, CK = 31, SW = 512, NG = 32, SP = 64, FH = 2816, INC = 3584, NMOD6 = 6 * D;
constexpr int LC = 16, NCH = M / LC, CPB = SEQ / LC, KA2 = 384;
constexpr float EPS = 1e-6f;
constexpr int NWAVES = 8, NTHR = 512;
constexpr int NPHASE = 8;

constexpr size_t MiB = 1u << 20;
constexpr size_t WS_CTL = 0, CTL_ZERO_BYTES = 1 * MiB;
constexpr size_t WS_BAR = 512 * 1024, WS_PCNT = 512 * 1024 + 16384, WS_GCNT = 512 * 1024 + 32768, BAR_BYTES = 32768 + 256;
constexpr size_t WS_MOD = 0, WS_RSS1 = 30 * MiB, WS_RSS2 = 31 * MiB;
constexpr size_t WS_WIN = 1 * MiB, WS_WCP = 8 * MiB, WS_WGLU = 9 * MiB, WS_WOUT = 11 * MiB, WS_WFI = 13 * MiB, WS_WFO = 24 * MiB;
constexpr size_t WS_SHW = 29 * MiB + 512 * 1024;
constexpr size_t WS_W1 = 30 * MiB, WS_B2 = 34 * MiB;
constexpr size_t WS_H1 = 40 * MiB;
constexpr size_t WS_UCONV = 72 * MiB, WS_A2S = 88 * MiB, WS_SGC = 112 * MiB, WS_SGS = 144 * MiB, WS_ACONV = 176 * MiB, WS_ASSM = 192 * MiB, WS_S = 208 * MiB, WS_MERGED = 224 * MiB;
constexpr size_t WS_X1B = 72 * MiB;
constexpr size_t WS_HID = 136 * MiB;
constexpr size_t WS_END = 256 * MiB;
static_assert(WS_HID + (size_t)M * FH * 2 <= WS_MERGED && WS_WFO + (size_t)D * FH * 2 <= WS_SHW && WS_B2 + (size_t)NG * 256 * KA2 * 2 <= WS_H1, "ws map");

constexpr int RING_BYTES = 131072, LDS_BYTES = 147456;

#define GAS __attribute__((address_space(1)))
#define LAS __attribute__((address_space(3)))
typedef unsigned short bf16;
typedef unsigned v4u __attribute__((ext_vector_type(4)));
typedef unsigned v2u __attribute__((ext_vector_type(2)));
typedef float f32x4 __attribute__((ext_vector_type(4)));
typedef float f32x2 __attribute__((ext_vector_type(2)));
using pg8::cvt_pk_bf16;
__device__ __forceinline__ float bf_lo(unsigned w) { return __uint_as_float(w << 16); }
__device__ __forceinline__ float bf_hi(unsigned w) { return __uint_as_float(w & 0xffff0000u); }
__device__ __forceinline__ float sigm(float x) { return __builtin_amdgcn_rcpf(1.0f + __expf(-x)); }
__device__ __forceinline__ float silu_f(float x) { return x * sigm(x); }
__device__ __forceinline__ float gelu_tanh(float x) { return x * sigm(1.5957691216057308f * (x + 0.044715f * x * x * x)); }
__device__ __forceinline__ float wave_sum(float v) {
#pragma unroll
    for (int o = 1; o < 64; o <<= 1) v += __shfl_xor(v, o);
    return v;
}
__device__ __forceinline__ v4u pack8(const f32x4 a, const f32x4 b) { v4u w; w.x = cvt_pk_bf16(a[0], a[1]); w.y = cvt_pk_bf16(a[2], a[3]); w.z = cvt_pk_bf16(b[0], b[1]); w.w = cvt_pk_bf16(b[2], b[3]); return w; }
__device__ __forceinline__ void unpack8(const v4u w, f32x4& a, f32x4& b) { a = (f32x4){bf_lo(w.x), bf_hi(w.x), bf_lo(w.y), bf_hi(w.y)}; b = (f32x4){bf_lo(w.z), bf_hi(w.z), bf_lo(w.w), bf_hi(w.w)}; }

struct BatchOrder {
    int nM, nwg, G, c; const char* A; const char* B; size_t zsA, tsA, zsB;
    __device__ __forceinline__ bool next(int i, pg8::Unit& u) const { const int L = i * G + c; if (L >= nwg) return false; u.z = L / nM; u.pm = L % nM; u.pn = 0; return true; }
    __device__ __forceinline__ const char* pa(const pg8::Unit& u) const { return A + (size_t)u.z * zsA + (size_t)u.pm * tsA; }
    __device__ __forceinline__ const char* pb(const pg8::Unit& u) const { return B + (size_t)u.z * zsB; }
    __device__ __forceinline__ void a_ready(const pg8::Unit&) const {}
    __device__ __forceinline__ void done(const pg8::Unit&) const {}
};

#define EPI_HEAD static constexpr bool PERM = true, AFTER_DRAIN = false, HALF_N = false
typedef f32x4 AccT[2][2][4][2];

struct EpiIn {
    EPI_HEAD; bf16* uconv; bf16* a2s; bf16* sgc; bf16* sgs;
    __device__ __forceinline__ void operator()(const AccT& acc, const pg8::Unit& u, int wr, int wc, int fr, int fq) const {
        const int row0 = u.pm * 256 + wr * 64 + fr;
        if (u.pn < 4) {
            const int col = u.pn * 128 + wc * 32 + 8 * fq;
#pragma unroll
            for (int ai = 0; ai < 2; ++ai)
#pragma unroll
                for (int m = 0; m < 4; ++m) { const int row = row0 + ai * 128 + m * 16; f32x4 o0, o1;
#pragma unroll
                    for (int e = 0; e < 4; ++e) { o0[e] = acc[ai][0][m][0][e] * sigm(acc[ai][1][m][0][e]); o1[e] = acc[ai][0][m][1][e] * sigm(acc[ai][1][m][1][e]); }
                    *(v4u*)(uconv + (size_t)row * CW + col) = pack8(o0, o1); }
        } else if (u.pn < 6) {
#pragma unroll
            for (int bj = 0; bj < 2; ++bj) { const int cc = (u.pn - 4) * 256 + bj * 128 + wc * 32 + 8 * fq, g = cc >> 4, h0 = cc & 15;
#pragma unroll
                for (int ai = 0; ai < 2; ++ai)
#pragma unroll
                    for (int m = 0; m < 4; ++m) { const int row = row0 + ai * 128 + m * 16;
                        *(v4u*)(a2s + ((size_t)(g * NCH + (row >> 4)) * KA2 + (row & 15) * 16 + h0)) = pack8(acc[ai][bj][m][0], acc[ai][bj][m][1]); } }
        } else {
#pragma unroll
            for (int bj = 0; bj < 2; ++bj) { const int gc = (u.pn - 6) * 256 + bj * 128 + wc * 32 + 8 * fq; bf16* dst = gc < D ? sgc + gc : sgs + (gc - D);
#pragma unroll
                for (int ai = 0; ai < 2; ++ai)
#pragma unroll
                    for (int m = 0; m < 4; ++m) { const int row = row0 + ai * 128 + m * 16; f32x4 o0, o1;
#pragma unroll
                        for (int e = 0; e < 4; ++e) { o0[e] = sigm(acc[ai][bj][m][0][e]); o1[e] = sigm(acc[ai][bj][m][1][e]); }
                        *(v4u*)(dst + (size_t)row * D) = pack8(o0, o1); } }
        }
    }
};
struct EpiState {
    EPI_HEAD; float* S;
    __device__ __forceinline__ void operator()(const AccT& acc, const pg8::Unit& u, int wr, int wc, int fr, int fq) const {
        const int col = wc * 32 + 8 * fq;
#pragma unroll
        for (int ai = 0; ai < 2; ++ai)
#pragma unroll
            for (int m = 0; m < 4; ++m) { const int rr = u.pm * 256 + ai * 128 + wr * 64 + m * 16 + fr; float* p = S + ((size_t)(u.z * NCH + rr)) * 128 + col;
                *(f32x4*)p = acc[ai][0][m][0]; *(f32x4*)(p + 4) = acc[ai][0][m][1]; }
    }
};
struct EpiStateLds {
    static constexpr bool PERM = true, AFTER_DRAIN = true, HALF_N = true;
    __device__ __forceinline__ void fused(const AccT& acc, const pg8::Unit& u, int wr, int wc, int fr, int fq, LAS unsigned char* lds, int wid, int lane) const {
        const int col = wc * 32 + 8 * fq;
#pragma unroll
        for (int ai = 0; ai < 2; ++ai)
#pragma unroll
            for (int m = 0; m < 4; ++m) { LAS float* p = (LAS float*)lds + (ai * 128 + wr * 64 + m * 16 + fr) * 128 + col;
                *(LAS f32x4*)p = acc[ai][0][m][0]; *(LAS f32x4*)(p + 4) = acc[ai][0][m][1]; }
    }
};
struct EpiSsmOut {
    EPI_HEAD; const bf16* a2s; const float* dvec; bf16* assm;
    __device__ __forceinline__ void operator()(const AccT& acc, const pg8::Unit& u, int wr, int wc, int fr, int fq) const {
        const int g = u.z; asm volatile("" : "+v"(fq), "+v"(fr));
#pragma unroll
        for (int bj = 0; bj < 2; ++bj) { const int c = bj * 128 + wc * 32 + 8 * fq, t = c >> 4, h0 = c & 15;
            const f32x4 d0 = *(const f32x4*)(dvec + g * 16 + h0), d1 = *(const f32x4*)(dvec + g * 16 + h0 + 4);
            v4u uu[2][4];
#pragma unroll
            for (int ai = 0; ai < 2; ++ai)
#pragma unroll
                for (int m = 0; m < 4; ++m) uu[ai][m] = *(const v4u*)(a2s + ((size_t)(g * NCH + u.pm * 256 + ai * 128 + wr * 64 + m * 16 + fr) * KA2 + c));
#pragma unroll
            for (int ai = 0; ai < 2; ++ai)
#pragma unroll
                for (int m = 0; m < 4; ++m) { const int rr = u.pm * 256 + ai * 128 + wr * 64 + m * 16 + fr;
                    f32x4 u0, u1; unpack8(uu[ai][m], u0, u1);
                    f32x4 y0 = acc[ai][bj][m][0] + d0 * u0, y1 = acc[ai][bj][m][1] + d1 * u1;
#pragma unroll
                    for (int e = 0; e < 4; ++e) { y0[e] = gelu_tanh(y0[e]); y1[e] = gelu_tanh(y1[e]); }
                    *(v4u*)(assm + ((size_t)(rr * LC + t) * SW + g * 16 + h0)) = pack8(y0, y1); }
            asm volatile("" ::: "memory"); }
    }
};
struct EpiConvProj {
    EPI_HEAD; const bf16* sgc; bf16* mg;
    __device__ __forceinline__ void operator()(const AccT& acc, const pg8::Unit& u, int wr, int wc, int fr, int fq) const {
#pragma unroll
        for (int bj = 0; bj < 2; ++bj) { const int col = u.pn * 256 + bj * 128 + wc * 32 + 8 * fq;
            v4u gg[2][4];
#pragma unroll
            for (int ai = 0; ai < 2; ++ai)
#pragma unroll
                for (int m = 0; m < 4; ++m) gg[ai][m] = *(const v4u*)(sgc + (size_t)(u.pm * 256 + ai * 128 + wr * 64 + m * 16 + fr) * D + col);
#pragma unroll
            for (int ai = 0; ai < 2; ++ai)
#pragma unroll
                for (int m = 0; m < 4; ++m) { const size_t off = (size_t)(u.pm * 256 + ai * 128 + wr * 64 + m * 16 + fr) * D + col;
                    f32x4 g0, g1; unpack8(gg[ai][m], g0, g1);
                    *(v4u*)(mg + off) = pack8(g0 * acc[ai][bj][m][0], g1 * acc[ai][bj][m][1]); }
            asm volatile("" ::: "memory"); }
    }
};
struct EpiSsmGlu {
    EPI_HEAD; const bf16* sgs; bf16* mg;
    __device__ __forceinline__ void operator()(const AccT& acc, const pg8::Unit& u, int wr, int wc, int fr, int fq) const {
        const int col = u.pn * 128 + wc * 32 + 8 * fq;
#pragma unroll
        for (int ai = 0; ai < 2; ++ai) {
            v4u gg[4], pp[4];
#pragma unroll
            for (int m = 0; m < 4; ++m) { const size_t off = (size_t)(u.pm * 256 + ai * 128 + wr * 64 + m * 16 + fr) * D + col; gg[m] = *(const v4u*)(sgs + off); pp[m] = *(const v4u*)(mg + off); }
#pragma unroll
            for (int m = 0; m < 4; ++m) { const size_t off = (size_t)(u.pm * 256 + ai * 128 + wr * 64 + m * 16 + fr) * D + col;
                f32x4 g0, g1, p0, p1; unpack8(gg[m], g0, g1); unpack8(pp[m], p0, p1);
#pragma unroll
                for (int e = 0; e < 4; ++e) { p0[e] += g0[e] * acc[ai][0][m][0][e] * sigm(acc[ai][1][m][0][e]); p1[e] += g1[e] * acc[ai][0][m][1][e] * sigm(acc[ai][1][m][1][e]); }
                *(v4u*)(mg + off) = pack8(p0, p1); }
            asm volatile("" ::: "memory"); }
    }
};
struct EpiOut {
    EPI_HEAD; const float* x; const float* mod; const float* n2g; bf16* x1; bf16* a2; float* rss;
    __device__ __forceinline__ void operator()(const AccT& acc, const pg8::Unit& u, int wr, int wc, int fr, int fq) const {
        const float* mb = mod + (u.pm >> 4) * NMOD6;
        float ss[2][4];
#pragma unroll
        for (int ai = 0; ai < 2; ++ai)
#pragma unroll
            for (int m = 0; m < 4; ++m) ss[ai][m] = 0.f;
#pragma unroll
        for (int bj = 0; bj < 2; ++bj) { const int col = u.pn * 256 + bj * 128 + wc * 32 + 8 * fq;
            const f32x4 gv0 = *(const f32x4*)(mb + 2 * D + col), gv1 = *(const f32x4*)(mb + 2 * D + col + 4);
            const f32x4 cs0 = *(const f32x4*)(n2g + col) * (*(const f32x4*)(mb + 4 * D + col) + 1.0f), cs1 = *(const f32x4*)(n2g + col + 4) * (*(const f32x4*)(mb + 4 * D + col + 4) + 1.0f);
#pragma unroll
            for (int ai = 0; ai < 2; ++ai) {
                f32x4 xx[4][2];
#pragma unroll
                for (int m = 0; m < 4; ++m) { const size_t off = (size_t)(u.pm * 256 + ai * 128 + wr * 64 + m * 16 + fr) * D + col;
                    xx[m][0] = __builtin_nontemporal_load((const f32x4*)(x + off)); xx[m][1] = __builtin_nontemporal_load((const f32x4*)(x + off + 4)); }
#pragma unroll
                for (int m = 0; m < 4; ++m) { const size_t off = (size_t)(u.pm * 256 + ai * 128 + wr * 64 + m * 16 + fr) * D + col;
                    const f32x4 v0 = xx[m][0] + gv0 * acc[ai][bj][m][0], v1 = xx[m][1] + gv1 * acc[ai][bj][m][1];
                    *(v4u*)(a2 + off) = pack8(v0 * cs0, v1 * cs1);
                    ss[ai][m] += (v0[0] * v0[0] + v0[1] * v0[1]) + (v0[2] * v0[2] + v0[3] * v0[3]) + (v1[0] * v1[0] + v1[1] * v1[1]) + (v1[2] * v1[2] + v1[3] * v1[3]); }
                asm volatile("" ::: "memory"); } }
#pragma unroll
        for (int ai = 0; ai < 2; ++ai)
#pragma unroll
            for (int m = 0; m < 4; ++m) { float t = ss[ai][m]; t += __shfl_xor(t, 16); t += __shfl_xor(t, 32);
                if (fq == 0) rss[(u.pm * 256 + ai * 128 + wr * 64 + m * 16 + fr) * 16 + u.pn * 4 + wc] = t; }
    }
};
struct EpiFfnIn {
    EPI_HEAD; const float* rss; const float* shw; bf16* hid;
    __device__ __forceinline__ void operator()(const AccT& acc, const pg8::Unit& u, int wr, int wc, int fr, int fq) const {
        const float* sb = shw + (u.pm >> 4) * (2 * FH) + u.pn * 256 + wc * 32 + 8 * fq;
        const f32x4 sg0 = *(const f32x4*)sb, sg1 = *(const f32x4*)(sb + 4), su0 = *(const f32x4*)(sb + 128), su1 = *(const f32x4*)(sb + 132);
        f32x4 qq[2][4];
#pragma unroll
        for (int ai = 0; ai < 2; ++ai)
#pragma unroll
            for (int m = 0; m < 4; ++m) qq[ai][m] = *(const f32x4*)(rss + (u.pm * 256 + ai * 128 + wr * 64 + m * 16 + fr) * 16 + 4 * fq);
#pragma unroll
        for (int ai = 0; ai < 2; ++ai)
#pragma unroll
            for (int m = 0; m < 4; ++m) { const int row = u.pm * 256 + ai * 128 + wr * 64 + m * 16 + fr;
                float t = (qq[ai][m][0] + qq[ai][m][1]) + (qq[ai][m][2] + qq[ai][m][3]); t += __shfl_xor(t, 16); t += __shfl_xor(t, 32);
                const float inv = rsqrtf(t * (1.0f / D) + EPS);
                const f32x4 g0 = acc[ai][0][m][0] * inv + sg0, g1 = acc[ai][0][m][1] * inv + sg1, u0 = acc[ai][1][m][0] * inv + su0, u1 = acc[ai][1][m][1] * inv + su1; f32x4 o0, o1;
#pragma unroll
                for (int e = 0; e < 4; ++e) { o0[e] = silu_f(g0[e]) * u0[e]; o1[e] = silu_f(g1[e]) * u1[e]; }
                *(v4u*)(hid + (size_t)row * FH + u.pn * 128 + wc * 32 + 8 * fq) = pack8(o0, o1); }
    }
};
struct EpiFfnOut {
    EPI_HEAD; const float* mod; const float* fg; const float* n2g; const bf16* x1; float* xo; float* rss; unsigned* cnt;
    __device__ __forceinline__ void operator()(AccT& acc, const pg8::Unit& u, int wr, int wc, int fr, int fq) const {
        const float* mb = mod + (u.pm >> 4) * NMOD6;
        {
            f32x4 gv[2][2], rc[2][2];
#pragma unroll
            for (int bj = 0; bj < 2; ++bj)
#pragma unroll
                for (int n = 0; n < 2; ++n) { const int col = u.pn * 256 + bj * 128 + wc * 32 + 8 * fq + 4 * n; gv[bj][n] = *(const f32x4*)(mb + 5 * D + col);
                    const f32x4 cs = *(const f32x4*)(n2g + col) * (*(const f32x4*)(mb + 4 * D + col) + 1.0f); rc[bj][n] = (f32x4){1.0f / cs[0], 1.0f / cs[1], 1.0f / cs[2], 1.0f / cs[3]}; }
#pragma unroll
            for (int ai = 0; ai < 2; ++ai)
#pragma unroll
                for (int m = 0; m < 4; ++m) { const int row = u.pm * 256 + ai * 128 + wr * 64 + m * 16 + fr; float ss = 0.f;
#pragma unroll
                    for (int bj = 0; bj < 2; ++bj) { const size_t off = (size_t)row * D + u.pn * 256 + bj * 128 + wc * 32 + 8 * fq;
                        f32x4 r0, r1; unpack8(*(const v4u*)(x1 + off), r0, r1);
                        const f32x4 v0 = r0 * rc[bj][0] + gv[bj][0] * acc[ai][bj][m][0], v1 = r1 * rc[bj][1] + gv[bj][1] * acc[ai][bj][m][1];
                        acc[ai][bj][m][0] = v0; acc[ai][bj][m][1] = v1;
                        ss += (v0[0] * v0[0] + v0[1] * v0[1]) + (v0[2] * v0[2] + v0[3] * v0[3]) + (v1[0] * v1[0] + v1[1] * v1[1]) + (v1[2] * v1[2] + v1[3] * v1[3]); }
                    ss += __shfl_xor(ss, 16); ss += __shfl_xor(ss, 32);
                    if (fq == 0) __hip_atomic_store(rss + row * 16 + u.pn * 4 + wc, ss, __ATOMIC_RELAXED, __HIP_MEMORY_SCOPE_AGENT); }
        }
        asm volatile("s_waitcnt vmcnt(0)" ::: "memory");
        unsigned* cw = cnt + 64 * u.pm;
        if (fr == 0 && fq == 0) __hip_atomic_fetch_add(cw, 1u, __ATOMIC_RELAXED, __HIP_MEMORY_SCOPE_AGENT);
        { unsigned sp = 0; while ((unsigned)__builtin_amdgcn_readfirstlane(__hip_atomic_load(cw, __ATOMIC_RELAXED, __HIP_MEMORY_SCOPE_AGENT)) < 32u) { __builtin_amdgcn_s_sleep(2); if (++sp > (1u << 22)) break; } }
        asm volatile("" ::: "memory");
        f32x4 fv[2][2];
#pragma unroll
        for (int bj = 0; bj < 2; ++bj)
#pragma unroll
            for (int n = 0; n < 2; ++n) fv[bj][n] = *(const f32x4*)(fg + u.pn * 256 + bj * 128 + wc * 32 + 8 * fq + 4 * n);
#pragma unroll
        for (int ai = 0; ai < 2; ++ai)
#pragma unroll
            for (int m = 0; m < 4; ++m) { const int row = u.pm * 256 + ai * 128 + wr * 64 + m * 16 + fr;
                const unsigned long long* pp = (const unsigned long long*)(rss + row * 16 + 4 * fq);
                const unsigned long long w0 = __hip_atomic_load(pp, __ATOMIC_RELAXED, __HIP_MEMORY_SCOPE_AGENT), w1 = __hip_atomic_load(pp + 1, __ATOMIC_RELAXED, __HIP_MEMORY_SCOPE_AGENT);
                float t = (__uint_as_float((unsigned)w0) + __uint_as_float((unsigned)(w0 >> 32))) + (__uint_as_float((unsigned)w1) + __uint_as_float((unsigned)(w1 >> 32)));
                t += __shfl_xor(t, 16); t += __shfl_xor(t, 32);
                const float inv = rsqrtf(t * (1.0f / D) + EPS);
#pragma unroll
                for (int bj = 0; bj < 2; ++bj) { const size_t off = (size_t)row * D + u.pn * 256 + bj * 128 + wc * 32 + 8 * fq;
                    __builtin_nontemporal_store(acc[ai][bj][m][0] * inv * fv[bj][0], (f32x4*)(xo + off)); __builtin_nontemporal_store(acc[ai][bj][m][1] * inv * fv[bj][1], (f32x4*)(xo + off + 4)); } }
    }
};

struct TripleOrder {
    pg8::StaticOrder base; const char* A1; const char* B1; size_t tsA, tsB;
    __device__ __forceinline__ bool next(int i, pg8::Unit& u) const { pg8::Unit t; if (!base.next(i / 3, t)) return false; const int sub = i % 3; u.pm = t.pm;
        if (sub == 0) { u.pn = t.pn; u.z = 0; } else { u.pn = 2 * t.pn + (sub - 1); u.z = 1; } return true; }
    __device__ __forceinline__ const char* pa(const pg8::Unit& u) const { return u.z ? A1 + (size_t)u.pm * tsA : base.pa(u); }
    __device__ __forceinline__ const char* pb(const pg8::Unit& u) const { return u.z ? B1 + (size_t)u.pn * tsB : base.pb(u); }
    __device__ __forceinline__ void a_ready(const pg8::Unit&) const {}
    __device__ __forceinline__ void done(const pg8::Unit&) const {}
};
struct EpiMix {
    EPI_HEAD; const bf16* sgc; const bf16* sgs; bf16* mg;
    __device__ __forceinline__ void operator()(const AccT& acc, const pg8::Unit& u, int wr, int wc, int fr, int fq) const {
        if (u.z == 0) { const EpiConvProj e{sgc, mg}; e(acc, u, wr, wc, fr, fq); } else { const EpiSsmGlu e{sgs, mg}; e(acc, u, wr, wc, fr, fq); }
    }
};

__device__ __forceinline__ int ileave(int n0, int half) { return n0 < half ? 256 * (n0 >> 7) + (n0 & 127) : 256 * ((n0 - half) >> 7) + 128 + ((n0 - half) & 127); }
__device__ __forceinline__ void tr_fetch(const float* W, int N, int item, int lane, float (&tv)[32]) {
    const int nblk = N / 32, kb = item / nblk, nb = item % nblk, k0 = 64 * kb, n0 = 32 * nb;
#pragma unroll
    for (int i = 0; i < 32; ++i) tv[i] = __builtin_nontemporal_load(W + (size_t)(k0 + 2 * i + (lane >> 5)) * N + n0 + (lane & 31));
}
__device__ __forceinline__ void tr_emit(const float (&tv)[32], int K, int N, bf16* WT, int mode, LAS float* scr, int item, int lane) {
    const int nblk = N / 32, kb = item / nblk, nb = item % nblk, k0 = 64 * kb, n0 = 32 * nb;
    int r0 = n0;
    if (mode == 1) r0 = n0 < 1024 ? ileave(n0, 512) : n0;
    else if (mode == 2) r0 = ileave(n0, 1024);
    else if (mode == 3) r0 = ileave(n0, FH);
#pragma unroll
    for (int i = 0; i < 32; ++i) scr[(2 * i + (lane >> 5)) * 33 + (lane & 31)] = tv[i];
    asm volatile("s_waitcnt lgkmcnt(0)" ::: "memory");
    const int c = lane & 7;
#pragma unroll
    for (int j = 0; j < 4; ++j) { const int n = (lane >> 3) + 8 * j; const LAS float* s = scr + (8 * c) * 33 + n;
        v4u o; o.x = cvt_pk_bf16(s[0 * 33], s[1 * 33]); o.y = cvt_pk_bf16(s[2 * 33], s[3 * 33]); o.z = cvt_pk_bf16(s[4 * 33], s[5 * 33]); o.w = cvt_pk_bf16(s[6 * 33], s[7 * 33]);
        *(v4u*)(WT + (size_t)(r0 + n) * K + k0 + 8 * c) = o; }
    asm volatile("s_waitcnt lgkmcnt(0)" ::: "memory");
}
__device__ __forceinline__ void transpose_item(const float* W, int K, int N, bf16* WT, int mode, LAS float* scr, int item, int lane) {
    const int nblk = N / 32, kb = item / nblk, nb = item % nblk, k0 = 64 * kb, n0 = 32 * nb;
    int r0 = n0;
    if (mode == 1) r0 = n0 < 1024 ? ileave(n0, 512) : n0;
    else if (mode == 2) r0 = ileave(n0, 1024);
    else if (mode == 3) r0 = ileave(n0, FH);
    float tv[32];
#pragma unroll
    for (int i = 0; i < 32; ++i) tv[i] = __builtin_nontemporal_load(W + (size_t)(k0 + 2 * i + (lane >> 5)) * N + n0 + (lane & 31));
#pragma unroll
    for (int i = 0; i < 32; ++i) scr[(2 * i + (lane >> 5)) * 33 + (lane & 31)] = tv[i];
    asm volatile("s_waitcnt lgkmcnt(0)" ::: "memory");
    const int c = lane & 7;
#pragma unroll
    for (int j = 0; j < 4; ++j) { const int n = (lane >> 3) + 8 * j; const LAS float* s = scr + (8 * c) * 33 + n;
        v4u o; o.x = cvt_pk_bf16(s[0 * 33], s[1 * 33]); o.y = cvt_pk_bf16(s[2 * 33], s[3 * 33]); o.z = cvt_pk_bf16(s[4 * 33], s[5 * 33]); o.w = cvt_pk_bf16(s[6 * 33], s[7 * 33]);
        *(v4u*)(WT + (size_t)(r0 + n) * K + k0 + 8 * c) = o; }
    asm volatile("s_waitcnt lgkmcnt(0)" ::: "memory");
}
__device__ __forceinline__ void sincos_d(double x, double& s, double& c) {
    const double k = rint(x * 0.63661977236758134308);
    double r = fma(-k, 1.57079632679489655800e+00, x); r = fma(-k, 6.12323399573676603587e-17, r);
    const int q = ((int)k) & 3; const double r2 = r * r;
    double sp = -1.0 / 1307674368000.0; sp = fma(sp, r2, 1.0 / 6227020800.0); sp = fma(sp, r2, -1.0 / 39916800.0); sp = fma(sp, r2, 1.0 / 362880.0); sp = fma(sp, r2, -1.0 / 5040.0); sp = fma(sp, r2, 1.0 / 120.0); sp = fma(sp, r2, -1.0 / 6.0); sp = fma(sp * r2, r, r);
    double cp = 1.0 / 20922789888000.0; cp = fma(cp, r2, -1.0 / 87178291200.0); cp = fma(cp, r2, 1.0 / 479001600.0); cp = fma(cp, r2, -1.0 / 3628800.0); cp = fma(cp, r2, 1.0 / 40320.0); cp = fma(cp, r2, -1.0 / 720.0); cp = fma(cp, r2, 1.0 / 24.0); cp = fma(cp, r2, -0.5); cp = fma(cp, r2, 1.0);
    s = (q == 0) ? sp : (q == 1) ? cp : (q == 2) ? -sp : -cp;
    c = (q == 0) ? cp : (q == 1) ? -sp : (q == 2) ? -cp : sp;
}
__device__ __forceinline__ void ssm_abar(const float* a_re, const float* a_im, const float* log_dt, int g, int p, double& er, double& ei, double& ar, double& ai) {
    const double dt = (double)expf(log_dt[g]); ar = (double)a_re[g * SP + p]; ai = (double)a_im[g * SP + p];
    const double x = dt * ar;
    double mag = 1.0 / 362880.0; mag = fma(mag, x, 1.0 / 40320.0); mag = fma(mag, x, 1.0 / 5040.0); mag = fma(mag, x, 1.0 / 720.0); mag = fma(mag, x, 1.0 / 120.0); mag = fma(mag, x, 1.0 / 24.0); mag = fma(mag, x, 1.0 / 6.0); mag = fma(mag, x, 0.5); mag = fma(mag, x, 1.0); mag = fma(mag, x, 1.0);
    double s, c; sincos_d(dt * ai, s, c); er = mag * c; ei = mag * s;
}

#define XB_TMO      128
#define XB_XCNT(j)  (256  + 64 * (j))
#define XB_XSUB(j)  (1280 + 64 * (j))
#define XB_XGEN(j)  (2304 + 64 * (j))
#define XB_TOP      3328
#define XB_TOPGEN   3392
#define XCD_BAR_WORDS 3456
#define XB_SPIN_CAP (1u << 18)

__device__ __forceinline__ unsigned xb_ld(unsigned* p)              { return __hip_atomic_load(p, __ATOMIC_RELAXED, __HIP_MEMORY_SCOPE_AGENT); }
__device__ __forceinline__ unsigned xb_add(unsigned* p, unsigned v) { return __hip_atomic_fetch_add(p, v, __ATOMIC_RELAXED, __HIP_MEMORY_SCOPE_AGENT); }
__device__ __forceinline__ unsigned xb_xcc_id() { return (unsigned)__builtin_amdgcn_s_getreg((3 << 11) | 20) & 0xFu; }
#define XB_SPIN(cond, bar) do { unsigned _sp = 0; while (cond) { __builtin_amdgcn_s_sleep(1); \
    if ((++_sp & 255u) == 0u) { if (xb_ld(&(bar)[XB_TMO])) break; if (_sp > XB_SPIN_CAP) { atomicAdd(&(bar)[XB_TMO], 1u); break; } } } } while (0)

struct XcdBarrier {
    unsigned* bar; unsigned x;
    volatile LAS unsigned* st;
};

__device__ __forceinline__ XcdBarrier xcd_barrier_post(unsigned* bar, volatile LAS unsigned* st) {
    XcdBarrier b; b.bar = bar; b.x = xb_xcc_id(); b.st = st;
    if (threadIdx.x == 0) (void)xb_add(&bar[XB_XCNT(b.x)], 1u);
    return b;
}
__device__ __forceinline__ void xcd_barrier_complete(unsigned* bar, unsigned x, unsigned& nloc, unsigned& nx) {
    const unsigned G = gridDim.x * gridDim.y * gridDim.z;
    unsigned sum, cnt, mine, sp = 0u;
    for (;;) {
        sum = 0u; cnt = 0u; mine = 0u;
#pragma unroll
        for (unsigned j = 0; j < 16; ++j) { const unsigned c = xb_ld(&bar[XB_XCNT(j)]); sum += c; cnt += (c > 0u) ? 1u : 0u; mine = (j == x) ? c : mine; }
        if (sum == G) break;
        __builtin_amdgcn_s_sleep(1);
        if ((++sp & 255u) == 0u) { if (xb_ld(&bar[XB_TMO])) break; if (sp > XB_SPIN_CAP) { atomicAdd(&bar[XB_TMO], 1u); break; } }
    }
    nloc = mine > 0u ? mine : 1u; nx = cnt > 0u ? cnt : 1u;
}

__device__ __forceinline__ void xcd_barrier(const XcdBarrier& b) {
    asm volatile("s_waitcnt vmcnt(0)" ::: "memory");
    __syncthreads();
    if (threadIdx.x == 0) {
        unsigned* bar = b.bar;
        __builtin_amdgcn_s_waitcnt(0);
        unsigned nloc = b.st[0], nx = b.st[1];
        if (nloc == 0u) { xcd_barrier_complete(bar, b.x, nloc, nx); b.st[0] = nloc; b.st[1] = nx; }
        const unsigned old = xb_add(&bar[XB_XSUB(b.x)], 1u);
        const unsigned gen = old / nloc;
        if (old + 1u == (gen + 1u) * nloc) {
            __builtin_amdgcn_fence(__ATOMIC_RELEASE, "agent");
            asm volatile("s_waitcnt vmcnt(0)" ::: "memory");
            const unsigned og = xb_add(&bar[XB_TOP], 1u);
            const unsigned tg = og / nx;
            if (og + 1u == (tg + 1u) * nx) xb_add(&bar[XB_TOPGEN], 1u);
            else XB_SPIN(xb_ld(&bar[XB_TOPGEN]) == tg, bar);
            __builtin_amdgcn_fence(__ATOMIC_ACQUIRE, "agent");
            xb_add(&bar[XB_XGEN(b.x)], 1u);
            asm volatile("s_waitcnt vmcnt(0)" ::: "memory");
        } else {
            XB_SPIN(xb_ld(&bar[XB_TOPGEN]) == gen, bar);
            __builtin_amdgcn_fence(__ATOMIC_ACQUIRE, "agent");
            asm volatile("s_waitcnt vmcnt(0)" ::: "memory");
        }
    }
    __syncthreads();
}

struct Args { const float* in[25]; float* out; unsigned char* ws; int ph_lo, ph_hi; };
static_assert(sizeof(Args) == 25 * 8 + 8 + 8 + 8, "Args has no padding");

__global__ void __launch_bounds__(NTHR, 2) fwd_megakernel(Args args) {
    extern __shared__ __attribute__((aligned(16))) unsigned char lds_raw[];
    LAS unsigned char* lds = (LAS unsigned char*)lds_raw;
    const int tid = threadIdx.x, lane = tid & 63, wave = __builtin_amdgcn_readfirstlane(tid >> 6);
    const int G = gridDim.x, bid = blockIdx.x;
    const int gw = bid * NWAVES + wave, NGW = G * NWAVES;
    unsigned char* ws = args.ws;
    const float* x = args.in[0]; const float* cvec = args.in[1]; const float* w_ada = args.in[2]; const float* b_ada = args.in[3]; const float* n1g = args.in[4];
    const float* w_in = args.in[5]; const float* conv_w = args.in[6]; const float* conv_b = args.in[7]; const float* cln_g = args.in[8]; const float* cln_b = args.in[9];
    const float* conv_proj = args.in[10]; const float* a_re = args.in[11]; const float* a_im = args.in[12]; const float* b_re = args.in[13]; const float* b_im = args.in[14];
    const float* c_re = args.in[15]; const float* c_im = args.in[16]; const float* ssm_d = args.in[17]; const float* log_dt = args.in[18]; const float* ssm_glu = args.in[19];
    const float* w_out = args.in[20]; const float* n2g = args.in[21]; const float* w_ffn_in = args.in[22]; const float* w_ffn_out = args.in[23]; const float* final_g = args.in[24];
    float* out = args.out;
    float* MOD = (float*)(ws + WS_MOD); float* RSS1 = (float*)(ws + WS_RSS1); float* RSS2 = (float*)(ws + WS_RSS2); float* SHW = (float*)(ws + WS_SHW);
    bf16* WIN = (bf16*)(ws + WS_WIN); bf16* WCP = (bf16*)(ws + WS_WCP); bf16* WGLU = (bf16*)(ws + WS_WGLU); bf16* WOUT = (bf16*)(ws + WS_WOUT); bf16* WFI = (bf16*)(ws + WS_WFI); bf16* WFO = (bf16*)(ws + WS_WFO);
    bf16* W1T = (bf16*)(ws + WS_W1); bf16* B2T = (bf16*)(ws + WS_B2); bf16* H1 = (bf16*)(ws + WS_H1);
    bf16* UCONV = (bf16*)(ws + WS_UCONV); bf16* A2S = (bf16*)(ws + WS_A2S); bf16* SGC = (bf16*)(ws + WS_SGC); bf16* SGS = (bf16*)(ws + WS_SGS);
    bf16* ACONV = (bf16*)(ws + WS_ACONV); bf16* ASSM = (bf16*)(ws + WS_ASSM); float* SST = (float*)(ws + WS_S); bf16* MG = (bf16*)(ws + WS_MERGED); bf16* HID = (bf16*)(ws + WS_HID); bf16* X1B = (bf16*)(ws + WS_X1B);
    cg::grid_group grid = cg::this_grid();
    const int lo = args.ph_lo, hi = args.ph_hi;
    volatile LAS unsigned* bst = (volatile LAS unsigned*)(lds + RING_BYTES + 1024);
    if (tid < 2) bst[tid] = 0u;
    __syncthreads();
    XcdBarrier xbar = xcd_barrier_post((unsigned*)(ws + WS_BAR), bst);
    if (lo == 0x7fffffff) grid.sync();
#ifndef PHMASK
#define PHMASK 0xFF
#endif
#define IN(k) ((((PHMASK) >> (k)) & 1) && lo <= (k) && (k) < hi)
#define GRID_SYNC() do { xcd_barrier(xbar); } while (0)
#define SEAM(k) do { if (IN(k) && IN((k) + 1)) GRID_SYNC(); } while (0)
#define REPS(k) _Pragma("unroll 1") for (int rep_ = 0; rep_ < ((((DUP_MASK) >> (k)) & 1) ? 2 : 1); ++rep_)

    if (IN(0)) REPS(0) { if (rep_) GRID_SYNC();
        {
            LAS float* scr = (LAS float*)(lds + wave * 16384);
            constexpr int I_IN = (D / 64) * (INC / 32), I_CP = (CW / 64) * (D / 32), I_GLU = (SW / 64) * (2 * D / 32), I_OUT = (D / 64) * (D / 32), I_FI = (D / 64) * (2 * FH / 32), I_FO = (FH / 64) * (D / 32);
            constexpr int NITEMS = I_IN + I_FI;
            const int ngv = NMOD6 / 64;
            const int tw0 = (G >= 2 * ngv) ? (bid - ngv) * NWAVES + wave : gw, tnw = (G >= 2 * ngv) ? (G - ngv) * NWAVES : NGW;
            {
                float cur[32], nxt[32];
                int it = (tw0 >= 0 ? tw0 : NITEMS);
                if (it < NITEMS) { if (it < I_FI) tr_fetch(w_ffn_in, 2 * FH, it, lane, cur); else tr_fetch(w_in, INC, it - I_FI, lane, cur); }
                while (it < NITEMS) {
                    const int itn = it + tnw;
                    if (itn < NITEMS) { if (itn < I_FI) tr_fetch(w_ffn_in, 2 * FH, itn, lane, nxt); else tr_fetch(w_in, INC, itn - I_FI, lane, nxt); }
                    if (it < I_FI) tr_emit(cur, D, 2 * FH, WFI, 3, scr, it, lane); else tr_emit(cur, D, INC, WIN, 1, scr, it - I_FI, lane);
#pragma unroll
                    for (int i = 0; i < 32; ++i) cur[i] = nxt[i];
                    it = itn;
                }
            }
        }
        {
            __syncthreads();
            LAS float* red = (LAS float*)lds;
            LAS float* sc = (LAS float*)(lds + 8192);
            if (bid < NMOD6 / 64) { for (int e = tid; e < BATCH * D; e += NTHR) sc[e] = silu_f(cvec[e]); }
            __syncthreads();
            for (int it = bid; it < NMOD6 / 64; it += G) {
                const int col = it * 64 + lane; float a0 = 0.f, a1 = 0.f, a2 = 0.f, a3 = 0.f;
#pragma unroll 1
                for (int k0 = wave * 128; k0 < wave * 128 + 128; k0 += 32) { float wv[32];
#pragma unroll
                    for (int j = 0; j < 32; ++j) wv[j] = __builtin_nontemporal_load(w_ada + (size_t)(k0 + j) * NMOD6 + col);
#pragma unroll
                    for (int j = 0; j < 32; ++j) { a0 += wv[j] * sc[k0 + j]; a1 += wv[j] * sc[D + k0 + j]; a2 += wv[j] * sc[2 * D + k0 + j]; a3 += wv[j] * sc[3 * D + k0 + j]; } }
                red[(wave * 4 + 0) * 64 + lane] = a0; red[(wave * 4 + 1) * 64 + lane] = a1; red[(wave * 4 + 2) * 64 + lane] = a2; red[(wave * 4 + 3) * 64 + lane] = a3;
                __syncthreads();
                if (tid < 256) { const int b = tid >> 6, c = tid & 63; float t = b_ada[it * 64 + c];
#pragma unroll
                    for (int w = 0; w < 8; ++w) t += red[(w * 4 + b) * 64 + c];
                    __hip_atomic_store(MOD + b * NMOD6 + it * 64 + c, t, __ATOMIC_RELAXED, __HIP_MEMORY_SCOPE_AGENT); }
                asm volatile("s_waitcnt vmcnt(0)" ::: "memory");
                __syncthreads();
                if (tid == 0) __hip_atomic_fetch_add((unsigned*)(ws + WS_GCNT), 1u, __ATOMIC_RELAXED, __HIP_MEMORY_SCOPE_AGENT);
            }
        }
        {
            LAS f32x2* PW = (LAS f32x2*)(lds);
            LAS f32x2* QQ = (LAS f32x2*)(lds + 8704);
            LAS f32x2* BB = (LAS f32x2*)(lds + 9216);
            LAS f32x2* CC = (LAS f32x2*)(lds + 17408);
            LAS float* KT = (LAS float*)(lds + 25600);
            for (int it = bid; it < NG * 8; it += G) {
                const int g = it >> 3, rb = it & 7;
                __syncthreads();
                if (tid < 64) {
                    double er, ei, ar, ai; ssm_abar(a_re, a_im, log_dt, g, tid, er, ei, ar, ai);
                    const double nr = er - 1.0, ni = ei, den = ar * ar + ai * ai;
                    QQ[tid] = (f32x2){(float)((nr * ar + ni * ai) / den), (float)((ni * ar - nr * ai) / den)};
                    double pr = 1.0, pi = 0.0;
                    for (int j = 0; j <= 16; ++j) { PW[j * 64 + tid] = (f32x2){(float)pr, (float)pi}; const double t = pr * er - pi * ei; pi = pr * ei + pi * er; pr = t; }
                }
                for (int e = tid; e < 1024; e += NTHR) CC[e] = (f32x2){c_re[g * 1024 + e], c_im[g * 1024 + e]};
                __syncthreads();
                for (int e = tid; e < 1024; e += NTHR) { const f32x2 q = QQ[e >> 4]; const float br = b_re[g * 1024 + e], bi = b_im[g * 1024 + e]; BB[e] = (f32x2){q.x * br - q.y * bi, q.x * bi + q.y * br}; }
                __syncthreads();
                if (rb < 4) {
                    const int nl = 4 * rb + 4, pair = tid & 255, ho = pair >> 4, hi = pair & 15;
                    for (int j = tid >> 8; j < nl; j += 2) {
                        float s = 0.f;
                        for (int p = 0; p < 64; ++p) { const f32x2 c = CC[ho * 64 + p], w = PW[j * 64 + p], b = BB[p * 16 + hi];
                            const float cr = c.x * w.x - c.y * w.y, ci = c.x * w.y + c.y * w.x; s += cr * b.x - ci * b.y; }
                        KT[j * 256 + pair] = s;
                    }
                    __syncthreads();
                    for (int r = wave * 8; r < wave * 8 + 8; ++r) { const int n = 64 * rb + r, t = n >> 4, ho = n & 15;
#pragma unroll
                        for (int i = 0; i < 3; ++i) { const int kp = lane + 64 * i; float v[2];
#pragma unroll
                            for (int h = 0; h < 2; ++h) { const int k = 2 * kp + h;
                                if (k < 256) { const int s = k >> 4, hi = k & 15; v[h] = (s <= t) ? KT[(t - s) * 256 + ho * 16 + hi] : 0.f; }
                                else { const int p = (k - 256) & 63; const f32x2 c = CC[ho * 64 + p], w = PW[(t + 1) * 64 + p]; v[h] = (k < 320) ? (c.x * w.x - c.y * w.y) : -(c.x * w.y + c.y * w.x); } }
                            *(unsigned*)(B2T + ((size_t)(g * 256 + n) * KA2 + 2 * kp)) = cvt_pk_bf16(v[0], v[1]); } }
                } else {
                    for (int r = wave * 8; r < wave * 8 + 8; ++r) { const int n = 64 * (rb - 4) + r, p = n & 63;
#pragma unroll
                        for (int i = 0; i < 2; ++i) { const int kp = lane + 64 * i; float v[2];
#pragma unroll
                            for (int h = 0; h < 2; ++h) { const int k = 2 * kp + h, s = k >> 4, hi = k & 15; const f32x2 w = PW[(15 - s) * 64 + p], b = BB[p * 16 + hi];
                                v[h] = (n < 64) ? (w.x * b.x - w.y * b.y) : (n < 128) ? (w.x * b.y + w.y * b.x) : 0.f; }
                            *(unsigned*)(W1T + ((size_t)(g * 256 + n) * 256 + 2 * kp)) = cvt_pk_bf16(v[0], v[1]); } }
                }
            }
            __syncthreads();
        }
    }
    if (IN(0) && IN(1)) {
        if (tid == 0) { unsigned sp = 0; while (__hip_atomic_load((unsigned*)(ws + WS_GCNT), __ATOMIC_RELAXED, __HIP_MEMORY_SCOPE_AGENT) < (unsigned)(NMOD6 / 64)) { __builtin_amdgcn_s_sleep(2); if (++sp > (1u << 22)) break; }
            __builtin_amdgcn_fence(__ATOMIC_ACQUIRE, "agent"); asm volatile("s_waitcnt vmcnt(0)" ::: "memory"); }
        __syncthreads();
    }
    for (int xs_ = 0; xs_ < EXTRA_SYNCS; ++xs_) GRID_SYNC();

    if (IN(1)) REPS(1) { if (rep_) GRID_SYNC();
        for (int rb = gw * 8; rb < M; rb += NGW * 8) {
            const float* mb = MOD + (rb >> 12) * NMOD6;
            f32x4 v[8][4]; float inv[8];
#pragma unroll
            for (int q = 0; q < 8; ++q) { const f32x4* xr = (const f32x4*)(x + (size_t)(rb + q) * D) + lane;
#pragma unroll
                for (int j = 0; j < 4; ++j) v[q][j] = __builtin_nontemporal_load(xr + 64 * j); }
#pragma unroll
            for (int q = 0; q < 8; ++q) { float s = 0.f;
#pragma unroll
                for (int j = 0; j < 4; ++j) s += (v[q][j][0] * v[q][j][0] + v[q][j][1] * v[q][j][1]) + (v[q][j][2] * v[q][j][2] + v[q][j][3] * v[q][j][3]);
                inv[q] = rsqrtf(wave_sum(s) * (1.0f / D) + EPS); }
#pragma unroll
            for (int j = 0; j < 4; ++j) { const int col = lane * 4 + 256 * j;
                const f32x4 gsc = (*(const f32x4*)(n1g + col)) * (*(const f32x4*)(mb + D + col) + 1.0f), sh = *(const f32x4*)(mb + col);
#pragma unroll
                for (int q = 0; q < 8; ++q) { const f32x4 h = v[q][j] * inv[q] * gsc + sh;
                    v2u o; o.x = cvt_pk_bf16(h[0], h[1]); o.y = cvt_pk_bf16(h[2], h[3]); *(v2u*)(H1 + (size_t)(rb + q) * D + col) = o; } }
        }
    }
    SEAM(1);

    if (IN(2)) REPS(2) { if (rep_) GRID_SYNC();
        pg8::Gemm g{D, D, D}; pg8::StaticOrder S; S.init(M, INC, G, bid, H1, D, WIN, D);
        EpiIn E{UCONV, A2S, SGC, SGS};
        GEMM_CALL(EpiIn, pg8::StaticOrder)(lds, g, S, E);
        {
            constexpr int NU = (M / 256) * (INC / 256), I_CP = (CW / 64) * (D / 32), I_GLU = (SW / 64) * (2 * D / 32), I_OUT = (D / 64) * (D / 32);
            int first = NU % G, nhelp = G - first; if (first == 0) nhelp = G;
            if (bid >= first) {
                LAS float* scr = (LAS float*)(lds + wave * 16384);
                const int hw0 = (bid - first) * NWAVES + wave, hnw = nhelp * NWAVES;
                for (int it = hw0; it < I_GLU + I_OUT + I_CP; it += hnw) {
                    if (it < I_GLU) transpose_item(ssm_glu, SW, 2 * D, WGLU, 2, scr, it, lane);
                    else if (it < I_GLU + I_OUT) transpose_item(w_out, D, D, WOUT, 0, scr, it - I_GLU, lane);
                    else transpose_item(conv_proj, CW, D, WCP, 0, scr, it - I_GLU - I_OUT, lane);
                }
                for (int v = hw0; v < 2 * FH; v += hnw) {
                    const v4u w0 = *(const v4u*)(WFI + (size_t)v * D + lane * 8), w1 = *(const v4u*)(WFI + (size_t)v * D + 512 + lane * 8);
                    f32x4 a0, a1, b0, b1; unpack8(w0, a0, a1); unpack8(w1, b0, b1);
        #pragma unroll
                    for (int b = 0; b < BATCH; ++b) { const float* sh = MOD + b * NMOD6 + 3 * D;
                        const f32x4 s0 = *(const f32x4*)(sh + lane * 8), s1 = *(const f32x4*)(sh + lane * 8 + 4), s2 = *(const f32x4*)(sh + 512 + lane * 8), s3 = *(const f32x4*)(sh + 512 + lane * 8 + 4);
                        const f32x4 pr = a0 * s0 + a1 * s1 + b0 * s2 + b1 * s3; const float t = wave_sum((pr[0] + pr[1]) + (pr[2] + pr[3]));
                        if (lane == 0) SHW[b * (2 * FH) + v] = t; }
                }
            }
        }
    }
    SEAM(2);

    if (IN(3)) REPS(3) { if (rep_) GRID_SYNC();
        {
            const int cp = tid & 255, th = tid >> 8;
            LAS float* OUTT = (LAS float*)(lds + 65536);
            const bool bal = (G == 256);
            const int nmine = bal ? (bid < NG * 4 ? 0 : 4) : (M / 32 - bid + G - 1) / G;
            f32x2 w[CK];
#pragma unroll
            for (int j = 0; j < CK; ++j) w[j] = *(const f32x2*)(conv_w + j * CW + 2 * cp);
            const f32x2 bias = *(const f32x2*)(conv_b + 2 * cp);
#define CONV_ITEM(ii_) (bal ? (bid - NG * 4) * 4 + (ii_) : bid + (ii_) * G)
#define CONV_FETCH(dst, it_) do { const int t0_ = (it_) * 32, pos0_ = t0_ & (SEQ - 1); _Pragma("unroll") for (int k_ = 0; k_ < 8; ++k_) { const int e_ = tid + k_ * NTHR, r_ = e_ >> 6, ch_ = e_ & 63; v4u v_ = {0u, 0u, 0u, 0u}; \
                if (e_ < 62 * 64 && pos0_ - 30 + r_ >= 0) v_ = *(const v4u*)(UCONV + (size_t)(t0_ - 30 + r_) * CW + ch_ * 8); dst[k_] = v_; } } while (0)
            v4u pre[8];
            if (nmine > 0) CONV_FETCH(pre, CONV_ITEM(0));
            for (int ii = 0; ii < nmine; ++ii) {
                const int item = CONV_ITEM(ii);
                const int t0 = item * 32;
                __syncthreads();
#pragma unroll
                for (int k = 0; k < 8; ++k) { const int e = tid + k * NTHR; if (e < 62 * 64) *(LAS v4u*)(lds + (e >> 6) * 1024 + (e & 63) * 16) = pre[k]; }
                if (ii + 1 < nmine) CONV_FETCH(pre, CONV_ITEM(ii + 1));
                f32x2 acc[16];
#pragma unroll
                for (int q = 0; q < 16; ++q) acc[q] = bias;
                __syncthreads();
#pragma unroll
                for (int i = 0; i < 46; ++i) { const unsigned uv = *(const LAS unsigned*)(lds + (th * 16 + i) * 1024 + cp * 4); const f32x2 vv = {bf_lo(uv), bf_hi(uv)};
#pragma unroll
                    for (int q = 0; q < 16; ++q) { const int j = i - q; if (j >= 0 && j < CK) acc[q] += vv * w[j]; } }
#pragma unroll
                for (int q = 0; q < 16; ++q) *(LAS f32x2*)(OUTT + (th * 16 + q) * 512 + 2 * cp) = acc[q];
                __syncthreads();
#pragma unroll
                for (int q = 0; q < 4; ++q) { const int tt = wave * 4 + q; const LAS float* rowp = OUTT + tt * 512;
                    f32x4 a = *(const LAS f32x4*)(rowp + lane * 4), b = *(const LAS f32x4*)(rowp + 256 + lane * 4);
                    const float mu = wave_sum((a[0] + a[1]) + (a[2] + a[3]) + (b[0] + b[1]) + (b[2] + b[3])) * (1.0f / CW);
                    a -= mu; b -= mu;
                    const float var = wave_sum((a[0] * a[0] + a[1] * a[1]) + (a[2] * a[2] + a[3] * a[3]) + (b[0] * b[0] + b[1] * b[1]) + (b[2] * b[2] + b[3] * b[3])) * (1.0f / CW);
                    const float rstd = rsqrtf(var + EPS);
                    a = a * rstd * (*(const f32x4*)(cln_g + lane * 4)) + *(const f32x4*)(cln_b + lane * 4);
                    b = b * rstd * (*(const f32x4*)(cln_g + 256 + lane * 4)) + *(const f32x4*)(cln_b + 256 + lane * 4);
                    v2u o0, o1; o0.x = cvt_pk_bf16(silu_f(a[0]), silu_f(a[1])); o0.y = cvt_pk_bf16(silu_f(a[2]), silu_f(a[3])); o1.x = cvt_pk_bf16(silu_f(b[0]), silu_f(b[1])); o1.y = cvt_pk_bf16(silu_f(b[2]), silu_f(b[3]));
                    bf16* dst = ACONV + (size_t)(t0 + tt) * CW; *(v2u*)(dst + lane * 4) = o0; *(v2u*)(dst + 256 + lane * 4) = o1; }
            }
            __syncthreads();
        }
        if (bid < NG * 4) {
            const int L = bid, g = L >> 2, b = L & 3;
            {
                pg8::Gemm gg{256, KA2, 256}; BatchOrder S{4, NG * 4, 1 << 20, L, (const char*)A2S, (const char*)W1T, (size_t)NCH * KA2 * 2, (size_t)256 * KA2 * 2, (size_t)256 * 256 * 2};
                EpiStateLds E{};
                GEMM_CALL(EpiStateLds, BatchOrder)(lds, gg, S, E);
            }
            __syncthreads();
            {
                double er, ei, ar, ai; ssm_abar(a_re, a_im, log_dt, g, lane, er, ei, ar, ai);
#pragma unroll
                for (int j = 0; j < 4; ++j) { const double t = er * er - ei * ei; ei = 2.0 * er * ei; er = t; }
                const float alr = (float)er, ali = (float)ei;
#pragma unroll
                for (int j = 0; j < 5; ++j) { const double t = er * er - ei * ei; ei = 2.0 * er * ei; er = t; }
                const float a32r = (float)er, a32i = (float)ei;
                const LAS float* sl = (const LAS float*)lds + wave * 32 * 128; LAS f32x2* EE = (LAS f32x2*)(lds + RING_BYTES + 2048);
                float xr = 0.f, xi = 0.f;
#pragma unroll 8
                for (int c = 0; c < 32; ++c) { const float sr = sl[c * 128 + lane], si = sl[c * 128 + 64 + lane]; const float nr = alr * xr - ali * xi + sr, ni = alr * xi + ali * xr + si; xr = nr; xi = ni; }
                EE[wave * 64 + lane] = (f32x2){xr, xi};
                __syncthreads();
                xr = 0.f; xi = 0.f;
                for (int v = 0; v < wave; ++v) { const f32x2 e = EE[v * 64 + lane]; const float nr = a32r * xr - a32i * xi + e.x, ni = a32r * xi + a32i * xr + e.y; xr = nr; xi = ni; }
                bf16* dst = A2S + (size_t)(g * NCH + b * CPB + wave * 32) * KA2 + 256 + lane;
#pragma unroll 8
                for (int c = 0; c < 32; ++c) {
                    const unsigned pk = cvt_pk_bf16(xr, xi); dst[(size_t)c * KA2] = (bf16)(pk & 0xffffu); dst[(size_t)c * KA2 + 64] = (bf16)(pk >> 16);
                    const float sr = sl[c * 128 + lane], si = sl[c * 128 + 64 + lane];
                    const float nr = alr * xr - ali * xi + sr, ni = alr * xi + ali * xr + si; xr = nr; xi = ni;
                }
            }
            asm volatile("s_waitcnt vmcnt(0)" ::: "memory");
            __syncthreads();
            {
                pg8::Gemm gg{KA2, KA2, KA2}; BatchOrder S{4, NG * 4, 1 << 20, L, (const char*)A2S, (const char*)B2T, (size_t)NCH * KA2 * 2, (size_t)256 * KA2 * 2, (size_t)256 * KA2 * 2};
                EpiSsmOut E{A2S, ssm_d, ASSM};
                GEMM_CALL(EpiSsmOut, BatchOrder)(lds, gg, S, E);
            }
        }
    }
    SEAM(3);

    if (IN(4)) REPS(4) { if (rep_) GRID_SYNC();
        pg8::Gemm g{SW, SW, SW}; TripleOrder S; S.base.init(M, D, G, bid, ACONV, CW, WCP, CW); S.A1 = (const char*)ASSM; S.B1 = (const char*)WGLU; S.tsA = (size_t)256 * SW * 2; S.tsB = (size_t)256 * SW * 2;
        EpiMix E{SGC, SGS, MG};
        GEMM_CALL(EpiMix, TripleOrder)(lds, g, S, E);
    }
    SEAM(4);

    if (IN(5)) REPS(5) { if (rep_) GRID_SYNC();
        pg8::Gemm g{D, D, D}; pg8::StaticOrder S; S.init(M, D, G, bid, MG, D, WOUT, D);
        EpiOut E{x, MOD, n2g, X1B, H1, RSS1};
        GEMM_CALL(EpiOut, pg8::StaticOrder)(lds, g, S, E);
    }
    SEAM(5);

    if (IN(6)) REPS(6) { if (rep_) GRID_SYNC();
        pg8::Gemm g{D, D, D}; pg8::StaticOrder S; S.init(M, 2 * FH, G, bid, H1, D, WFI, D);
        EpiFfnIn E{RSS1, SHW, HID};
        GEMM_CALL(EpiFfnIn, pg8::StaticOrder)(lds, g, S, E);
        {
            constexpr int NU = (M / 256) * (2 * FH / 256), I_FO = (FH / 64) * (D / 32);
            int first = NU % G, nhelp = G - first; if (first == 0) nhelp = G;
            if (bid >= first) {
                LAS float* scr = (LAS float*)(lds + wave * 16384);
                for (int it = (bid - first) * NWAVES + wave; it < I_FO; it += nhelp * NWAVES) transpose_item(w_ffn_out, FH, D, WFO, 0, scr, it, lane);
            }
        }
    }
    SEAM(6);

    if (IN(7)) REPS(7) { if (rep_) GRID_SYNC();
        pg8::Gemm g{FH, FH, FH}; pg8::StaticOrder S; S.init(M, D, G, bid, HID, FH, WFO, FH);
        EpiFfnOut E{MOD, final_g, n2g, H1, out, RSS2, (unsigned*)(ws + WS_PCNT)};
        GEMM_CALL(EpiFfnOut, pg8::StaticOrder)(lds, g, S, E);
    }

#undef IN
#undef SEAM
}

extern "C" void kernel_launch(void* const* d_in, const int* in_sizes, int n_in, void* d_out, int out_size, void* d_ws, size_t ws_size, hipStream_t stream) {
    static int grid = 0;
    if (grid == 0) {
        if (n_in != 25 || out_size != M * D || ws_size < WS_END) { fprintf(stderr, "kernel_launch: unexpected shapes (n_in %d out %d ws %zu)\n", n_in, out_size, ws_size); grid = -1; return; }
        int dev = 0, cus = 0, per_cu = 0;
        (void)hipGetDevice(&dev); (void)hipDeviceGetAttribute(&cus, hipDeviceAttributeMultiprocessorCount, dev);
        if (hipFuncSetAttribute((const void*)fwd_megakernel, hipFuncAttributeMaxDynamicSharedMemorySize, LDS_BYTES) != hipSuccess) { fprintf(stderr, "kernel_launch: hipFuncSetAttribute failed\n"); grid = -1; return; }
        if (hipOccupancyMaxActiveBlocksPerMultiprocessor(&per_cu, (const void*)fwd_megakernel, NTHR, LDS_BYTES) != hipSuccess || per_cu < 1) { fprintf(stderr, "kernel_launch: occupancy query failed (%d)\n", per_cu); (void)hipGetLastError(); per_cu = 1; }
        grid = cus * (per_cu > 1 ? 1 : per_cu);
        if (grid <= 0) grid = 256;
    }
    if (grid < 0) return;
    (void)hipMemsetAsync((char*)d_ws + WS_BAR, 0, BAR_BYTES, stream);
    Args a{};
    for (int i = 0; i < 25; ++i) a.in[i] = (const float*)d_in[i];
    a.out = (float*)d_out; a.ws = (unsigned char*)d_ws;
#if MK_PER_PHASE
    for (int ph = 0; ph < NPHASE; ++ph) { a.ph_lo = ph; a.ph_hi = ph + 1; hipLaunchKernelGGL(fwd_megakernel, dim3(grid), dim3(NTHR), LDS_BYTES, stream, a); }
#else
    a.ph_lo = 0; a.ph_hi = NPHASE;
    void* kargs[] = {&a};
    hipError_t e = hipLaunchCooperativeKernel((const void*)fwd_megakernel, dim3(grid), dim3(NTHR), kargs, LDS_BYTES, stream);
    if (e != hipSuccess) fprintf(stderr, "kernel_launch: cooperative launch failed: %s (grid %d)\n", hipGetErrorString(e), grid);
#endif
}
```
